# Optimizing an MI355X kernel written in HIP

```python
import math
import jax, jax.numpy as jnp
from jax import lax
import numpy as np

D_MODEL = 1024
BATCH = 4
SEQ = 4096
DEPTH = 4

HEAD_DIM = 64
DIL_GROUPS = ((128, 1), (512, 4), (2048, 16))
A_HEADS_PER_GROUP = 4
A_HEADS = A_HEADS_PER_GROUP * len(DIL_GROUPS)
A_OUT = A_HEADS_PER_GROUP * HEAD_DIM
B_HEADS = 4
B_V_DIM = 2 * HEAD_DIM
B_OUT = B_HEADS * B_V_DIM
C_HEADS = 4
C_OUT = C_HEADS * HEAD_DIM
IDX_HEADS = 8
IDX_DIM = 64
TOPK_MAX = 256
D_FF = 2816
NUM_BUCKETS = 32
MAX_DISTANCE = 2048
BIAS_HEADS = A_HEADS + B_HEADS + C_HEADS
Q_BLOCK = 128
RMS_EPS = 1e-6

A_QKV_COLS = 3 * A_HEADS * HEAD_DIM
B_QK_COLS = 4 * B_HEADS * HEAD_DIM
B_V_COLS = B_HEADS * B_V_DIM
C_COLS = C_HEADS * HEAD_DIM + 2 * HEAD_DIM
IDX_COLS = IDX_HEADS * IDX_DIM + IDX_DIM + IDX_HEADS
GATE_COLS = 3 * D_MODEL
N_IN = A_QKV_COLS + B_QK_COLS + B_V_COLS + C_COLS + IDX_COLS + GATE_COLS
SPLIT_POINTS = [A_QKV_COLS,
                A_QKV_COLS + B_QK_COLS,
                A_QKV_COLS + B_QK_COLS + B_V_COLS,
                A_QKV_COLS + B_QK_COLS + B_V_COLS + C_COLS,
                A_QKV_COLS + B_QK_COLS + B_V_COLS + C_COLS + IDX_COLS]

kernel_name = "hybrid_gated_dilated_diff_dsa_macaron"


def rms_norm(x, g):
    xf = x.astype(jnp.float32)
    y = xf * lax.rsqrt(jnp.mean(xf * xf, axis=-1, keepdims=True) + RMS_EPS)
    return (y * g.astype(jnp.float32)).astype(x.dtype)


def swiglu(x, w_gate, w_up, w_down):
    return (jax.nn.silu(x @ w_gate) * (x @ w_up)) @ w_down


def rel_bucket(dist):
    n = jnp.maximum(dist, 0)
    max_exact = NUM_BUCKETS // 2
    nf = jnp.maximum(n, 1).astype(jnp.float32)
    large = max_exact + (jnp.log(nf / max_exact) / math.log(MAX_DISTANCE / max_exact)
                         * (NUM_BUCKETS - max_exact)).astype(jnp.int32)
    large = jnp.minimum(large, NUM_BUCKETS - 1)
    return jnp.where(n < max_exact, n, large)


def dilated_window_group(q, k, v, window, dilation, bias_table):
    b, t, h, dh = q.shape
    n = t // dilation
    wn = window // dilation
    nb = -(-n // wn)
    pad = nb * wn - n

    def to_sub(z):
        z = z.reshape(b, n, dilation, h, dh).transpose(0, 2, 1, 3, 4)
        return jnp.pad(z, ((0, 0), (0, 0), (0, pad), (0, 0), (0, 0)))

    qs, ks, vs = to_sub(q), to_sub(k), to_sub(v)
    qb = qs.reshape(b, dilation, nb, wn, h, dh)

    def band(z):
        zp = jnp.pad(z, ((0, 0), (0, 0), (wn, 0), (0, 0), (0, 0))).reshape(b, dilation, nb + 1, wn, h, dh)
        return jnp.concatenate([zp[:, :, :-1], zp[:, :, 1:]], axis=3)

    kb, vb = band(ks), band(vs)
    logits = jnp.einsum('brnqhe,brnkhe->brnhqk', qb, kb).astype(jnp.float32) * (dh ** -0.5)
    a = jnp.arange(wn)[:, None]
    c = jnp.arange(2 * wn)[None, :]
    sub_dist = wn + a - c
    bias = bias_table[rel_bucket(sub_dist * dilation)].astype(jnp.float32)
    logits = logits + bias.transpose(2, 0, 1)
    key_pos = (jnp.arange(nb)[:, None] - 1) * wn + c
    mask = ((sub_dist >= 0) & (sub_dist <= wn))[None] & (key_pos >= 0)[:, None, :]
    logits = jnp.where(mask[:, None], logits, -jnp.inf)
    m = jnp.max(logits, axis=-1)
    p = jnp.exp(logits - m[..., None])
    s = jnp.sum(p, axis=-1)
    o = jnp.einsum('brnhqk,brnkhe->brnqhe', p, vb.astype(jnp.float32))

    def from_sub(z):
        z = z.reshape((b, dilation, nb * wn) + z.shape[4:])[:, :, :n]
        z = jnp.moveaxis(z, 1, 2)
        return z.reshape((b, t) + z.shape[3:])

    return from_sub(o), from_sub(jnp.swapaxes(m, 3, 4)), from_sub(jnp.swapaxes(s, 3, 4))


def dilated_attention(q, k, v, bias_table):
    outs = []
    for g, (w, d) in enumerate(DIL_GROUPS):
        sl = slice(g * A_HEADS_PER_GROUP, (g + 1) * A_HEADS_PER_GROUP)
        outs.append(dilated_window_group(q[:, :, sl], k[:, :, sl], v[:, :, sl], w, d, bias_table[:, sl]))
    m_all = jnp.stack([m for _, m, _ in outs])
    scale = jnp.exp(m_all - jnp.max(m_all, axis=0))
    num = sum(scale[g][..., None] * outs[g][0] for g in range(len(DIL_GROUPS)))
    den = sum(scale[g] * outs[g][2] for g in range(len(DIL_GROUPS)))
    return num / den[..., None]


def diff_attention(qs, ks, v, lam, bias_table):
    t = qs.shape[1]
    dh = qs.shape[-1]
    outs = []
    for start in range(0, t, Q_BLOCK):
        end = start + Q_BLOCK
        logits = jnp.einsum('bqmhe,bkmhe->bmhqk', qs[:, start:end], ks[:, :end]).astype(jnp.float32) * (dh ** -0.5)
        dist = jnp.arange(start, end)[:, None] - jnp.arange(end)[None, :]
        bias = bias_table[rel_bucket(dist)].astype(jnp.float32).transpose(2, 0, 1)
        logits = jnp.where(dist >= 0, logits + bias, -jnp.inf)
        p = jax.nn.softmax(logits, axis=-1)
        w = p[:, 0] - lam * p[:, 1]
        outs.append(jnp.einsum('bhqk,bkhe->bqhe', w, v[:, :end].astype(jnp.float32)))
    return jnp.concatenate(outs, axis=1)


def dsa_attention(q, k, v, q_idx, k_idx, w_idx, bias_table):
    t = q.shape[1]
    dh = q.shape[-1]
    k_sel = min(TOPK_MAX, t // 4)
    gather = jax.vmap(lambda z, i: z[i])
    outs = []
    for start in range(0, t, Q_BLOCK):
        end = start + Q_BLOCK
        n_sel = min(k_sel, end)
        qpos = jnp.arange(start, end)
        raw = jnp.einsum('bqhe,bke->bqhk', q_idx[:, start:end], k_idx[:, :end]).astype(jnp.float32) * (IDX_DIM ** -0.5)
        score = jnp.einsum('bqh,bqhk->bqk', w_idx[:, start:end].astype(jnp.float32) * (IDX_HEADS ** -0.5),
                           jax.nn.relu(raw))
        score = jnp.where(jnp.arange(end)[None, :] <= qpos[:, None], score, -jnp.inf)
        top_val, top_idx = lax.top_k(score, n_sel)
        valid = jnp.isfinite(top_val)
        k_g = gather(k[:, :end], top_idx)
        v_g = gather(v[:, :end], top_idx)
        logits = jnp.einsum('bqhe,bqne->bhqn', q[:, start:end], k_g).astype(jnp.float32) * (dh ** -0.5)
        bias = bias_table[rel_bucket(qpos[None, :, None] - top_idx)].astype(jnp.float32)
        logits = jnp.where(valid[:, None], logits + jnp.moveaxis(bias, 3, 1), -jnp.inf)
        p = jax.nn.softmax(logits, axis=-1)
        outs.append(jnp.einsum('bhqn,bqne->bqhe', p, v_g.astype(jnp.float32)))
    return jnp.concatenate(outs, axis=1)


def token_mixer(h, w_in, qk_gain, diff_lambda, diff_out_norm, w_branch_a, w_branch_b, w_branch_c,
                w_out, rel_bias, layer_idx):
    b, t, _ = h.shape
    proj = h @ w_in
    a_qkv, b_qk, b_v, c_qkv, ix, gates = jnp.split(proj, SPLIT_POINTS, axis=-1)

    a_qkv = a_qkv.reshape(b, t, 3, A_HEADS, HEAD_DIM)
    qa = rms_norm(a_qkv[:, :, 0], qk_gain[0, 0])
    ka = rms_norm(a_qkv[:, :, 1], qk_gain[0, 1])
    o_a = dilated_attention(qa, ka, a_qkv[:, :, 2], rel_bias[:, :A_HEADS])
    o_a = o_a.reshape(b, t, A_OUT).astype(h.dtype)

    b_qk = b_qk.reshape(b, t, 4, B_HEADS, HEAD_DIM)
    qb = rms_norm(b_qk[:, :, 0:2], qk_gain[1, 0])
    kb = rms_norm(b_qk[:, :, 2:4], qk_gain[1, 1])
    lam_init = 0.8 - 0.6 * math.exp(-0.3 * layer_idx)
    lv = diff_lambda.astype(jnp.float32)
    lam = jnp.exp(jnp.sum(lv[0] * lv[1])) - jnp.exp(jnp.sum(lv[2] * lv[3])) + lam_init
    o_b = diff_attention(qb, kb, b_v.reshape(b, t, B_HEADS, B_V_DIM), lam, rel_bias[:, A_HEADS:A_HEADS + B_HEADS])
    o_b = rms_norm(o_b, diff_out_norm) * (1.0 - lam_init)
    o_b = o_b.reshape(b, t, B_OUT).astype(h.dtype)

    qc = rms_norm(c_qkv[..., :C_HEADS * HEAD_DIM].reshape(b, t, C_HEADS, HEAD_DIM), qk_gain[2, 0])
    kc = rms_norm(c_qkv[..., C_HEADS * HEAD_DIM:C_HEADS * HEAD_DIM + HEAD_DIM], qk_gain[2, 1])
    vc = c_qkv[..., C_HEADS * HEAD_DIM + HEAD_DIM:]
    q_idx = ix[..., :IDX_HEADS * IDX_DIM].reshape(b, t, IDX_HEADS, IDX_DIM)
    k_idx = ix[..., IDX_HEADS * IDX_DIM:IDX_HEADS * IDX_DIM + IDX_DIM]
    w_idx = ix[..., IDX_HEADS * IDX_DIM + IDX_DIM:]
    o_c = dsa_attention(qc, kc, vc, q_idx, k_idx, w_idx, rel_bias[:, A_HEADS + B_HEADS:])
    o_c = o_c.reshape(b, t, C_OUT).astype(h.dtype)

    g = jax.nn.sigmoid(gates.reshape(b, t, 3, D_MODEL))
    y = (g[:, :, 0] * (o_a @ w_branch_a) + g[:, :, 1] * (o_b @ w_branch_b)
         + g[:, :, 2] * (o_c @ w_branch_c))
    return y @ w_out


def setup_inputs(seed: int = 0) -> dict:
    key = jax.random.key(seed)
    ks = jax.random.split(key, 20)
    f32 = jnp.float32

    def dense(k, shape, fan_in):
        return jax.random.normal(k, shape, f32) * fan_in ** -0.5

    def gain(k, shape):
        return 1.0 + 0.05 * jax.random.normal(k, shape, f32)

    return {
        "x": jax.random.normal(ks[0], (BATCH, SEQ, D_MODEL), f32),
        "rel_bias": 0.5 * jax.random.normal(ks[1], (NUM_BUCKETS, BIAS_HEADS), f32),
        "ffn1_norm": gain(ks[2], (DEPTH, D_MODEL)),
        "ffn1_w_gate": dense(ks[3], (DEPTH, D_MODEL, D_FF), D_MODEL),
        "ffn1_w_up": dense(ks[4], (DEPTH, D_MODEL, D_FF), D_MODEL),
        "ffn1_w_down": dense(ks[5], (DEPTH, D_FF, D_MODEL), D_FF),
        "mix_norm": gain(ks[6], (DEPTH, D_MODEL)),
        "w_in": dense(ks[7], (DEPTH, D_MODEL, N_IN), D_MODEL),
        "qk_gain": gain(ks[8], (DEPTH, 3, 2, HEAD_DIM)),
        "diff_lambda": 0.1 * jax.random.normal(ks[9], (DEPTH, 4, HEAD_DIM), f32),
        "diff_out_norm": gain(ks[10], (DEPTH, B_V_DIM)),
        "w_branch_a": dense(ks[11], (DEPTH, A_OUT, D_MODEL), A_OUT),
        "w_branch_b": dense(ks[12], (DEPTH, B_OUT, D_MODEL), B_OUT),
        "w_branch_c": dense(ks[13], (DEPTH, C_OUT, D_MODEL), C_OUT),
        "w_out": dense(ks[14], (DEPTH, D_MODEL, D_MODEL), D_MODEL),
        "ffn2_norm": gain(ks[15], (DEPTH, D_MODEL)),
        "ffn2_w_gate": dense(ks[16], (DEPTH, D_MODEL, D_FF), D_MODEL),
        "ffn2_w_up": dense(ks[17], (DEPTH, D_MODEL, D_FF), D_MODEL),
        "ffn2_w_down": dense(ks[18], (DEPTH, D_FF, D_MODEL), D_FF),
    }


def reference(x, rel_bias, ffn1_norm, ffn1_w_gate, ffn1_w_up, ffn1_w_down, mix_norm, w_in, qk_gain,
              diff_lambda, diff_out_norm, w_branch_a, w_branch_b, w_branch_c, w_out,
              ffn2_norm, ffn2_w_gate, ffn2_w_up, ffn2_w_down):
    for i in range(DEPTH):
        x = x + 0.5 * swiglu(rms_norm(x, ffn1_norm[i]), ffn1_w_gate[i], ffn1_w_up[i], ffn1_w_down[i])
        x = x + token_mixer(rms_norm(x, mix_norm[i]), w_in[i], qk_gain[i], diff_lambda[i], diff_out_norm[i],
                            w_branch_a[i], w_branch_b[i], w_branch_c[i], w_out[i], rel_bias, i)
        x = x + 0.5 * swiglu(rms_norm(x, ffn2_norm[i]), ffn2_w_gate[i], ffn2_w_up[i], ffn2_w_down[i])
    return x
```

```cpp
#include <hip/hip_runtime.h>
#include <cstdio>
#include <cstdint>
#include <cmath>
#ifndef MK_N_LAUNCHES
#define MK_N_LAUNCHES 0
#endif
namespace pg8 {
#define PG8_LAS __attribute__((address_space(3)))
typedef unsigned short bf16_t;
typedef short bf16x8 __attribute__((ext_vector_type(8)));
typedef float f32x4 __attribute__((ext_vector_type(4)));
typedef unsigned u32x4 __attribute__((ext_vector_type(4)));
typedef unsigned u32x2 __attribute__((ext_vector_type(2)));
constexpr int BM = 256, BK = 64, HALF = 128, HTB = HALF * BK * 2  , STAGE_BYTES = 8 * HTB, NXCD = 8, WGM = 8;

__host__ __device__ __forceinline__ int lds_byte(int r, int c) { const int st = (r >> 4) * 2 + (c >> 5), rr = r & 15, cc = c & 31, ob = rr * 64 + cc * 2; return st * 1024 + (ob ^ (((ob >> 9) & 1) << 5)); }
__host__ __device__ __forceinline__ void stage_rc(int b, int& R, int& C) { const int st = b / 1024, sb = b % 1024, swz = sb ^ (((sb >> 9) & 1) << 5); R = (st >> 1) * 16 + swz / 64; C = (st & 1) * 32 + (swz % 64) / 2; }
__host__ __device__ __forceinline__ int perm32(int rho) { const int n = rho >> 4, i = rho & 15; return 8 * (i >> 2) + 4 * n + (i & 3); }

struct Unit { int pm, pn; };
struct Gemm { const bf16_t* A; const bf16_t* Bt; int M, N, K, lda; };

struct StaticOrder {
    int nM, nN, nwg, G, c;
    __host__ __device__ void init(int M, int N, int G_, int c_) { nM = M / BM; nN = N / BM; nwg = nM * nN; G = G_; c = c_; }
    __host__ __device__ bool next(int i, Unit& u) const {
        const long L = (long)i * G + c; if (L >= nwg) return false;
        int wgid = (int)L; { const int q = nwg / NXCD, r = nwg % NXCD, xcd = wgid % NXCD, off = wgid / NXCD; wgid = (xcd < r ? xcd * (q + 1) : r * (q + 1) + (xcd - r) * q) + off; }
        const int nig = WGM * nN, gid = wgid / nig, fm = gid * WGM, gsz = (nM - fm) < WGM ? (nM - fm) : WGM;
        u.pm = fm + ((wgid % nig) % gsz); u.pn = (wgid % nig) / gsz; return true;
    }
    __device__ __forceinline__ void a_ready(const Unit&) const {}
    __device__ __forceinline__ void done(const Unit&) const {}
};

typedef float f32x2_t __attribute__((ext_vector_type(2))); typedef __bf16 bf16x2_t __attribute__((ext_vector_type(2)));
__device__ __forceinline__ unsigned cvt_pk_bf16(float lo, float hi) { f32x2_t v = {lo, hi}; bf16x2_t b = __builtin_convertvector(v, bf16x2_t); return __builtin_bit_cast(unsigned, b); }

template <class Epi, class Sched, bool ALIGN_EPI = false, bool SP2 = false>
__device__ __forceinline__ void gemm_phase(PG8_LAS unsigned char* lds, const Gemm g, const Sched& S, const Epi& E) {
    int tid_ = threadIdx.x; asm volatile("" : "+v"(tid_));
    const int tid = tid_, wid = __builtin_amdgcn_readfirstlane(tid >> 6), lane = tid & 63, wr = wid >> 2, wc = wid & 3, fr = lane & 15, fq = lane >> 4;
    const int K = g.K, nt = K / BK, lda = g.lda;
    unsigned voffA[2], voffB[2];
#pragma unroll
    for (int i = 0; i < 2; ++i) { int R, C; stage_rc(tid * 16 + i * 8192, R, C); const int Rb = Epi::PERM ? ((R & ~31) + perm32(R & 31)) : R;
        voffA[i] = (unsigned)(R * lda + C) * 2u; voffB[i] = (unsigned)(Rb * K + C) * 2u; }
    const size_t kstep = (size_t)(BK * 2);
    const size_t hstepA = (size_t)HALF * lda * 2, hstepB = (size_t)HALF * K * 2;
    const size_t tstepA = 2 * hstepA, tstepB = 2 * hstepB;
    const unsigned ldsw = (unsigned)wid * 1024u;
    const int aoff = lds_byte(wr * 64 + fr, fq * 8), boff = lds_byte(wc * 32 + fr, fq * 8);
#define PG8_SA(b, h) (((b) * 2 + (h)) * HTB)
#define PG8_SB(b, h) ((4 + (b) * 2 + (h)) * HTB)
#define PG8_STAGE(bufoff, gbase, voff) do { _Pragma("unroll") for (int _i = 0; _i < 2; ++_i) \
        __builtin_amdgcn_global_load_lds((const unsigned*)((const char*)(gbase) + (voff)[_i]), (PG8_LAS unsigned*)(lds + (bufoff) + ldsw + _i * 8192), 16, 0, 0); } while (0)
#define PG8_LDA(dst, b, h) do { _Pragma("unroll") for (int m = 0; m < 4; ++m) _Pragma("unroll") for (int k = 0; k < 2; ++k) dst[m][k] = *(const PG8_LAS bf16x8*)(lds + PG8_SA(b, h) + aoff + m * 2048 + k * 1024); } while (0)
#define PG8_LDB(dst, b, h) do { _Pragma("unroll") for (int n = 0; n < 2; ++n) _Pragma("unroll") for (int k = 0; k < 2; ++k) dst[n][k] = *(const PG8_LAS bf16x8*)(lds + PG8_SB(b, h) + boff + n * 2048 + k * 1024); } while (0)
#define PG8_MMA(ai, bj, At, Bt) do { __builtin_amdgcn_s_setprio(1); _Pragma("unroll") for (int m = 0; m < 4; ++m) _Pragma("unroll") for (int n = 0; n < 2; ++n) _Pragma("unroll") for (int k = 0; k < 2; ++k) \
        acc[ai][bj][m][n] = __builtin_amdgcn_mfma_f32_16x16x32_bf16(Bt[n][k], At[m][k], acc[ai][bj][m][n], 0, 0, 0); __builtin_amdgcn_s_setprio(0); } while (0)
#define PG8_WAIT_V(n) asm volatile("s_waitcnt vmcnt(" #n ")" ::: "memory")
#define PG8_WAIT_L(n) asm volatile("s_waitcnt lgkmcnt(" #n ")" ::: "memory")
#define PG8_BAR __builtin_amdgcn_s_barrier()
#define PG8_SCHED __builtin_amdgcn_sched_barrier(0)
    Unit cur, nxt; int ui = 0;
    if (!S.next(0, cur)) return;
    f32x4 acc[2][2][4][2];
#pragma unroll
    for (int a = 0; a < 2; ++a)
#pragma unroll
        for (int b = 0; b < 2; ++b)
#pragma unroll
            for (int m = 0; m < 4; ++m)
#pragma unroll
                for (int n = 0; n < 2; ++n) acc[a][b][m][n] = (f32x4){0.f, 0.f, 0.f, 0.f};
    bf16x8 At[4][2], B0[2][2], B1[2][2];
    const char* cA = (const char*)g.A + (size_t)cur.pm * tstepA; const char* cB = (const char*)g.Bt + (size_t)cur.pn * tstepB;
    S.a_ready(cur);
    if constexpr (SP2) {
        PG8_STAGE(PG8_SB(0, 0), cB, voffB); PG8_STAGE(PG8_SB(0, 1), cB + hstepB, voffB); PG8_STAGE(PG8_SA(0, 0), cA, voffA); PG8_STAGE(PG8_SA(0, 1), cA + hstepA, voffA);
        if (wr == 1) PG8_BAR;
        PG8_WAIT_V(2); PG8_BAR;
        PG8_STAGE(PG8_SB(1, 0), cB + kstep, voffB); PG8_STAGE(PG8_SA(1, 0), cA + kstep, voffA); PG8_STAGE(PG8_SB(1, 1), cB + hstepB + kstep, voffB);
        PG8_WAIT_V(6); PG8_BAR;
    } else {
        PG8_STAGE(PG8_SB(0, 0), cB, voffB); PG8_STAGE(PG8_SA(0, 0), cA, voffA); PG8_STAGE(PG8_SB(0, 1), cB + hstepB, voffB); PG8_STAGE(PG8_SA(0, 1), cA + hstepA, voffA);
        if (wr == 1) PG8_BAR;
        PG8_WAIT_V(4); PG8_BAR;
        PG8_STAGE(PG8_SB(1, 0), cB + kstep, voffB); PG8_STAGE(PG8_SA(1, 0), cA + kstep, voffA); PG8_STAGE(PG8_SB(1, 1), cB + hstepB + kstep, voffB);
        PG8_WAIT_V(6); PG8_BAR;
    }
    for (;;) {
        const bool has_next = S.next(ui + 1, nxt);
        const char* nA = has_next ? (const char*)g.A + (size_t)nxt.pm * tstepA : cA; const char* nB = has_next ? (const char*)g.Bt + (size_t)nxt.pn * tstepB : cB;
        for (int t = 0; t < nt; t += 2) {
            const bool last = (t == nt - 2);
            const char* a1 = cA + (size_t)(t + 1) * kstep;
            const char* a2 = last ? nA : cA + (size_t)(t + 2) * kstep; const char* b2 = last ? nB : cB + (size_t)(t + 2) * kstep;
            const char* a3 = a2 + kstep; const char* b3 = b2 + kstep;
            if (last && has_next) S.a_ready(nxt);
            if constexpr (SP2) {
            PG8_LDB(B0, 0, 0); PG8_LDB(B1, 0, 1); PG8_SCHED; PG8_LDA(At, 0, 0); PG8_STAGE(PG8_SA(1, 1), a1 + hstepA, voffA);
            PG8_WAIT_V(8); PG8_WAIT_L(0); PG8_BAR; PG8_MMA(0, 0, At, B0); PG8_MMA(0, 1, At, B1); PG8_BAR; PG8_SCHED;
            PG8_LDA(At, 0, 1); PG8_STAGE(PG8_SB(0, 0), b2, voffB); PG8_STAGE(PG8_SB(0, 1), b2 + hstepB, voffB); PG8_STAGE(PG8_SA(0, 0), a2, voffA);
            PG8_WAIT_V(8); PG8_WAIT_L(0); PG8_BAR; PG8_MMA(1, 0, At, B0); PG8_MMA(1, 1, At, B1); PG8_BAR; PG8_SCHED;
            PG8_LDB(B0, 1, 0); PG8_LDB(B1, 1, 1); PG8_SCHED; PG8_LDA(At, 1, 0); PG8_STAGE(PG8_SA(0, 1), a2 + hstepA, voffA);
            PG8_WAIT_V(8); PG8_WAIT_L(0); PG8_BAR; PG8_MMA(0, 0, At, B0); PG8_MMA(0, 1, At, B1); PG8_BAR; PG8_SCHED;
            PG8_LDA(At, 1, 1); PG8_STAGE(PG8_SB(1, 0), b3, voffB); PG8_STAGE(PG8_SB(1, 1), b3 + hstepB, voffB); PG8_STAGE(PG8_SA(1, 0), a3, voffA);
            PG8_WAIT_V(8); PG8_WAIT_L(0); PG8_BAR; PG8_MMA(1, 0, At, B0); PG8_MMA(1, 1, At, B1); PG8_BAR; PG8_SCHED;
            } else {
            PG8_LDB(B0, 0, 0); PG8_SCHED; PG8_LDA(At, 0, 0); PG8_STAGE(PG8_SA(1, 1), a1 + hstepA, voffA);
            PG8_WAIT_L(8); PG8_BAR; PG8_WAIT_L(0); PG8_MMA(0, 0, At, B0); PG8_BAR; PG8_SCHED;
            PG8_LDB(B1, 0, 1); PG8_STAGE(PG8_SB(0, 0), b2, voffB);
            PG8_BAR; PG8_WAIT_L(0); PG8_MMA(0, 1, At, B1); PG8_BAR;
            PG8_LDA(At, 0, 1); PG8_STAGE(PG8_SA(0, 0), a2, voffA);
            PG8_BAR; PG8_WAIT_L(0); PG8_MMA(1, 0, At, B0); PG8_BAR; PG8_SCHED;
            PG8_STAGE(PG8_SB(0, 1), b2 + hstepB, voffB);
            PG8_WAIT_V(6); PG8_BAR; PG8_MMA(1, 1, At, B1); PG8_BAR;
            PG8_LDB(B0, 1, 0); PG8_SCHED; PG8_LDA(At, 1, 0); PG8_STAGE(PG8_SA(0, 1), a2 + hstepA, voffA);
            PG8_WAIT_L(8); PG8_BAR; PG8_WAIT_L(0); PG8_MMA(0, 0, At, B0); PG8_BAR; PG8_SCHED;
            PG8_LDB(B1, 1, 1); PG8_STAGE(PG8_SB(1, 0), b3, voffB);
            PG8_BAR; PG8_WAIT_L(0); PG8_MMA(0, 1, At, B1); PG8_BAR;
            PG8_LDA(At, 1, 1); PG8_STAGE(PG8_SA(1, 0), a3, voffA);
            PG8_BAR; PG8_WAIT_L(0); PG8_MMA(1, 0, At, B0); PG8_BAR; PG8_SCHED;
            PG8_STAGE(PG8_SB(1, 1), b3 + hstepB, voffB);
            PG8_WAIT_V(6); PG8_BAR; PG8_MMA(1, 1, At, B1); PG8_BAR;
            }
        }
        if constexpr (ALIGN_EPI) { if (wr == 0) PG8_BAR; }
        E(acc, cur, wr, wc, fr, fq); S.done(cur);
        if (!has_next) break;
#pragma unroll
        for (int a = 0; a < 2; ++a)
#pragma unroll
            for (int b = 0; b < 2; ++b)
#pragma unroll
                for (int m = 0; m < 4; ++m)
#pragma unroll
                    for (int n = 0; n < 2; ++n) acc[a][b][m][n] = (f32x4){0.f, 0.f, 0.f, 0.f};
        cur = nxt; cA = nA; cB = nB; ++ui;
        if constexpr (ALIGN_EPI) { if (wr == 1) PG8_BAR; }
    }
    PG8_WAIT_V(0);
    if constexpr (!ALIGN_EPI) { if (wr == 0) PG8_BAR; }
    PG8_BAR;
#undef PG8_SA
#undef PG8_SB
#undef PG8_STAGE
#undef PG8_LDA
#undef PG8_LDB
#undef PG8_MMA
#undef PG8_WAIT_V
#undef PG8_WAIT_L
#undef PG8_BAR
#undef PG8_SCHED
}
}
namespace epi {
using pg8::f32x4; using pg8::u32x4; using pg8::u32x2; using pg8::Unit; using pg8::bf16_t; using pg8::cvt_pk_bf16;
constexpr int MROWS = 16384;
constexpr float RMS_EPS = 1e-6f;
__device__ __forceinline__ float bflo(unsigned u) { return __uint_as_float(u << 16); }
__device__ __forceinline__ float bfhi(unsigned u) { return __uint_as_float(u & 0xffff0000u); }
__device__ __forceinline__ float row_rs(const float* rowss, int row, int fq) {
    float s = 0.f;
#pragma unroll
    for (int j = 0; j < 4; ++j) s += rowss[(size_t)(4 * fq + j) * MROWS + row];
    s += __shfl_xor(s, 16); s += __shfl_xor(s, 32);
    return __builtin_amdgcn_rsqf(s * (1.0f / 1024.0f) + RMS_EPS);
}
__device__ __forceinline__ float sigmoidf_(float v) { return __builtin_amdgcn_rcpf(1.0f + __builtin_amdgcn_exp2f(-1.4426950408889634f * v)); }

struct EpiSwiGLU {
    static constexpr bool PERM = true;
    bf16_t* H; int ldh; const float* rowss;
    __device__ __forceinline__ void operator()(const f32x4 (&acc)[2][2][4][2], const Unit& u, int wr, int wc, int fr, int fq) const {
        const int row0 = u.pm * 256 + wr * 64 + fr, col0 = u.pn * 128 + wc * 32 + 8 * fq;
#pragma unroll
        for (int ai = 0; ai < 2; ++ai)
#pragma unroll
            for (int m = 0; m < 4; ++m) { const int row = row0 + ai * 128 + m * 16; const float r = row_rs(rowss, row, fq);
                float h[8];
#pragma unroll
                for (int n = 0; n < 2; ++n)
#pragma unroll
                    for (int i = 0; i < 4; ++i) { const float g = acc[ai][0][m][n][i] * r, up = acc[ai][1][m][n][i] * r; h[n * 4 + i] = g * sigmoidf_(g) * up; }
                u32x4 w; w.x = cvt_pk_bf16(h[0], h[1]); w.y = cvt_pk_bf16(h[2], h[3]); w.z = cvt_pk_bf16(h[4], h[5]); w.w = cvt_pk_bf16(h[6], h[7]);
                *(u32x4*)(H + (size_t)row * ldh + col0) = w; asm volatile("" ::: "memory"); }
    }
};

struct EpiResidual {
    static constexpr bool PERM = false;
    const float* base; float* out; bf16_t* xb; float* rowss; float scale;
    __device__ __forceinline__ void operator()(const f32x4 (&acc)[2][2][4][2], const Unit& u, int wr, int wc, int fr, int fq) const {
        const int row0 = u.pm * 256 + wr * 64 + fr, col0 = u.pn * 256 + wc * 32 + 4 * fq;
#pragma unroll
        for (int ai = 0; ai < 2; ++ai)
#pragma unroll
            for (int m = 0; m < 4; ++m) { const int row = row0 + ai * 128 + m * 16; const size_t off = (size_t)row * 1024 + col0; float ss = 0.f;
#pragma unroll
                for (int bj = 0; bj < 2; ++bj)
#pragma unroll
                    for (int n = 0; n < 2; ++n) { const f32x4 b = *(const f32x4*)(base + off + bj * 128 + n * 16); const f32x4 o = b + acc[ai][bj][m][n] * scale;
                        *(f32x4*)(out + off + bj * 128 + n * 16) = o; u32x2 w; w.x = cvt_pk_bf16(o[0], o[1]); w.y = cvt_pk_bf16(o[2], o[3]);
                        *(u32x2*)(xb + off + bj * 128 + n * 16) = w; ss += (o[0] * o[0] + o[1] * o[1]) + (o[2] * o[2] + o[3] * o[3]); }
                ss += __shfl_xor(ss, 16); ss += __shfl_xor(ss, 32);
                if (fq == 0) rowss[(size_t)(u.pn * 4 + wc) * MROWS + row] = ss; asm volatile("" ::: "memory"); }
    }
};

struct EpiQKV {
    static constexpr bool PERM = true;
    bf16_t* P; int ldp; const float* rowss; const float* qk_gain  ; float* widx;
    __device__ __forceinline__ void operator()(const f32x4 (&acc)[2][2][4][2], const Unit& u, int wr, int wc, int fr, int fq) const {
        const int hidx = 4 * u.pn + wc;
        int gi = -1; float post = 1.0f;
        constexpr float C2 = 0.125f * 1.4426950408889634f;
        if (hidx < 12) { gi = 0; post = C2; } else if (hidx < 24) { gi = 1; } else if (hidx < 36) { }
        else if (hidx < 44) { gi = 2; post = C2; } else if (hidx < 52) { gi = 3; } else if (hidx < 60) { }
        else if (hidx < 64) { gi = 4; post = C2; } else if (hidx == 64) { gi = 5; } else if (hidx == 65) { }
        else if (hidx < 74) { post = 0.125f; }
        f32x4 gn[2][2];
#pragma unroll
        for (int bj = 0; bj < 2; ++bj)
#pragma unroll
            for (int n = 0; n < 2; ++n) gn[bj][n] = (gi >= 0) ? *(const f32x4*)(qk_gain + gi * 64 + 32 * bj + 8 * fq + 4 * n) : (f32x4){1.f, 1.f, 1.f, 1.f};
        const int row0 = u.pm * 256 + wr * 64 + fr, col0 = 64 * hidx + 8 * fq;
#pragma unroll
        for (int ai = 0; ai < 2; ++ai)
#pragma unroll
            for (int m = 0; m < 4; ++m) { const int row = row0 + ai * 128 + m * 16; const float r = row_rs(rowss, row, fq);
                f32x4 v[2][2]; float ss = 0.f;
#pragma unroll
                for (int bj = 0; bj < 2; ++bj)
#pragma unroll
                    for (int n = 0; n < 2; ++n) { v[bj][n] = acc[ai][bj][m][n] * r; const f32x4 t = v[bj][n]; ss += (t[0] * t[0] + t[1] * t[1]) + (t[2] * t[2] + t[3] * t[3]); }
                float mul = post;
                if (gi >= 0) { ss += __shfl_xor(ss, 16); ss += __shfl_xor(ss, 32); mul = post * __builtin_amdgcn_rsqf(ss * (1.0f / 64.0f) + RMS_EPS); }
#pragma unroll
                for (int bj = 0; bj < 2; ++bj) { const f32x4 a = v[bj][0] * gn[bj][0] * mul, b = v[bj][1] * gn[bj][1] * mul;
                    u32x4 w; w.x = cvt_pk_bf16(a[0], a[1]); w.y = cvt_pk_bf16(a[2], a[3]); w.z = cvt_pk_bf16(b[0], b[1]); w.w = cvt_pk_bf16(b[2], b[3]);
                    *(u32x4*)(P + (size_t)row * ldp + col0 + 32 * bj) = w; }
                if (hidx == 75 && fq == 0) { *(f32x4*)(widx + (size_t)row * 8) = v[0][0]; *(f32x4*)(widx + (size_t)row * 8 + 4) = v[0][1]; } asm volatile("" ::: "memory"); }
    }
};

struct EpiSigmoid {
    static constexpr bool PERM = true;
    bf16_t* G; int ldg; const float* rowss;
    __device__ __forceinline__ void operator()(const f32x4 (&acc)[2][2][4][2], const Unit& u, int wr, int wc, int fr, int fq) const {
        const int row0 = u.pm * 256 + wr * 64 + fr, col0 = u.pn * 256 + wc * 32 + 8 * fq;
#pragma unroll
        for (int ai = 0; ai < 2; ++ai)
#pragma unroll
            for (int m = 0; m < 4; ++m) { const int row = row0 + ai * 128 + m * 16; const float r = row_rs(rowss, row, fq);
#pragma unroll
                for (int bj = 0; bj < 2; ++bj) { float h[8];
#pragma unroll
                    for (int n = 0; n < 2; ++n)
#pragma unroll
                        for (int i = 0; i < 4; ++i) h[n * 4 + i] = sigmoidf_(acc[ai][bj][m][n][i] * r);
                    u32x4 w; w.x = cvt_pk_bf16(h[0], h[1]); w.y = cvt_pk_bf16(h[2], h[3]); w.z = cvt_pk_bf16(h[4], h[5]); w.w = cvt_pk_bf16(h[6], h[7]);
                    *(u32x4*)(G + (size_t)row * ldg + col0 + bj * 128) = w; } asm volatile("" ::: "memory"); }
    }
};

struct EpiMerge {
    static constexpr bool PERM = true;
    bf16_t* Y; const bf16_t* G  ; int ldg; int accum;
    __device__ __forceinline__ void operator()(const f32x4 (&acc)[2][2][4][2], const Unit& u, int wr, int wc, int fr, int fq) const {
        const int row0 = u.pm * 256 + wr * 64 + fr, col0 = u.pn * 256 + wc * 32 + 8 * fq;
#pragma unroll
        for (int ai = 0; ai < 2; ++ai)
#pragma unroll
            for (int m = 0; m < 4; ++m) { const int row = row0 + ai * 128 + m * 16;
#pragma unroll
                for (int bj = 0; bj < 2; ++bj) { const u32x4 gv = *(const u32x4*)(G + (size_t)row * ldg + col0 + bj * 128);
                    bf16_t* yp = Y + (size_t)row * 1024 + col0 + bj * 128;
                    u32x4 yo = (u32x4){0u, 0u, 0u, 0u}; if (accum) yo = *(const u32x4*)yp;
                    const f32x4 a = acc[ai][bj][m][0], b = acc[ai][bj][m][1];
                    float h[8];
                    h[0] = bflo(yo.x) + bflo(gv.x) * a[0]; h[1] = bfhi(yo.x) + bfhi(gv.x) * a[1]; h[2] = bflo(yo.y) + bflo(gv.y) * a[2]; h[3] = bfhi(yo.y) + bfhi(gv.y) * a[3];
                    h[4] = bflo(yo.z) + bflo(gv.z) * b[0]; h[5] = bfhi(yo.z) + bfhi(gv.z) * b[1]; h[6] = bflo(yo.w) + bflo(gv.w) * b[2]; h[7] = bfhi(yo.w) + bfhi(gv.w) * b[3];
                    u32x4 w; w.x = cvt_pk_bf16(h[0], h[1]); w.y = cvt_pk_bf16(h[2], h[3]); w.z = cvt_pk_bf16(h[4], h[5]); w.w = cvt_pk_bf16(h[6], h[7]);
                    *(u32x4*)yp = w; } asm volatile("" ::: "memory"); }
    }
};
}
constexpr int NWAVES = 8;
constexpr int M = 16384, D = 1024, FF = 2816, T = 4096, NLAYER = 4;
constexpr int NIN = 7880, PP = 4864  , NGATE = 3072, GATE_COL0 = 4808;
constexpr float LOG2E = 1.4426950408889634f;
constexpr size_t MiB = 1u << 20;
constexpr size_t WS_CTL = 0, CTL_ZERO_BYTES = 1 * MiB;
constexpr size_t WS_BIASD = 1 * MiB;
constexpr size_t WS_ROWSS = 1 * MiB + 512 * 1024;
constexpr size_t WS_WIDX = 2 * MiB + 512 * 1024;
constexpr size_t WS_W = 4 * MiB;
constexpr size_t O_GU1 = 0, O_DN1 = 11534336, O_QKV = 17301504, O_GATE = 27262976, O_BA = 33554432, O_BB = 34078720, O_BC = 35127296, O_OUT = 35651584, O_GU2 = 37748736, O_DN2 = 49283072, O_WEND = 55050240;
constexpr size_t WS_XB = 57 * MiB, WS_OATT = 89 * MiB, WS_Y = 121 * MiB, WS_PROJ = 153 * MiB, WS_HMID = WS_PROJ, WS_GATES = 305 * MiB, WS_END = 401 * MiB;
static_assert(WS_W + O_WEND <= WS_XB && WS_PROJ + (size_t)M * PP * 2 <= WS_GATES && WS_GATES + (size_t)M * NGATE * 2 <= WS_END, "ws map");
constexpr int CW_TMO = 0, CW_CODE = 1, CW_BAR = 4096;

constexpr int RING_OFF = 0, RING_BYTES = 131072;
constexpr int MISC_OFF = 160768, LDS_BYTES = 161792;

#define GAS __attribute__((address_space(1)))
#define LAS __attribute__((address_space(3)))
typedef unsigned short bf16;
typedef unsigned v4u __attribute__((ext_vector_type(4)));
typedef unsigned v2u __attribute__((ext_vector_type(2)));
typedef float f32x4 __attribute__((ext_vector_type(4)));
typedef GAS unsigned gu32;
#define RLX_AGENT __ATOMIC_RELAXED, __HIP_MEMORY_SCOPE_AGENT
#define LDS_WAIT() asm volatile("s_waitcnt lgkmcnt(0)" ::: "memory")
#define VM_WAIT() asm volatile("s_waitcnt vmcnt(0)" ::: "memory")
__device__ __forceinline__ float bflo(unsigned u) { return __uint_as_float(u << 16); }
__device__ __forceinline__ float bfhi(unsigned u) { return __uint_as_float(u & 0xffff0000u); }
__device__ __forceinline__ unsigned f2bf(float f) { unsigned u = __builtin_bit_cast(unsigned, f); return (u + 0x7fffu + ((u >> 16) & 1u)) >> 16; }
__device__ __forceinline__ unsigned pk2(float lo, float hi) { return f2bf(lo) | (f2bf(hi) << 16); }
__device__ __forceinline__ float wave_sum(float v) {
#pragma unroll
    for (int o = 1; o < 64; o <<= 1) v += __shfl_xor(v, o);
    return v;
}
__device__ __forceinline__ float wave_max(float v) {
#pragma unroll
    for (int o = 1; o < 64; o <<= 1) v = fmaxf(v, __shfl_xor(v, o));
    return v;
}
__device__ __forceinline__ float dot8(v4u a, v4u b) {
    return ((bflo(a.x) * bflo(b.x) + bfhi(a.x) * bfhi(b.x)) + (bflo(a.y) * bflo(b.y) + bfhi(a.y) * bfhi(b.y))) + ((bflo(a.z) * bflo(b.z) + bfhi(a.z) * bfhi(b.z)) + (bflo(a.w) * bflo(b.w) + bfhi(a.w) * bfhi(b.w)));
}
__device__ __forceinline__ float dot64(const v4u (&q)[8], const bf16* kp) {
    const v4u* k = (const v4u*)kp; float s = 0.f;
#pragma unroll
    for (int i = 0; i < 8; ++i) s += dot8(q[i], k[i]);
    return s;
}
__device__ __forceinline__ int rel_bucket(int n) {
    if (n < 16) return n;
    int b = 16 + (int)(logf((float)n / 16.0f) / logf(128.0f) * 16.0f);
    return b < 31 ? b : 31;
}

struct Args { const float* in[19]; float* out; unsigned char* ws; int lo, hi; };
struct Frame {
    LAS unsigned char* lds;
    volatile LAS unsigned* MISC;
    int tid, lane, wave, G, bx;
};

__device__ __forceinline__ void phase_prologue(Frame& F, const Args& A) {
    float* biasd = (float*)(A.ws + WS_BIASD); const float* rel_bias = A.in[1];
    for (int i = F.bx * 512 + F.tid; i < 20 * 4096; i += F.G * 512) { const int h = i >> 12, d = i & 4095; biasd[i] = rel_bias[rel_bucket(d) * 20 + h] * LOG2E; }
    const float* x = A.in[0]; bf16* xb = (bf16*)(A.ws + WS_XB); float* rowss = (float*)(A.ws + WS_ROWSS);
    const int gw = F.bx * NWAVES + F.wave, NGW = F.G * NWAVES;
    for (int m = gw; m < M; m += NGW) {
        const f32x4* xr = (const f32x4*)(x + (size_t)m * D) + F.lane; float s = 0.f;
        unsigned long long* o8 = (unsigned long long*)(xb + (size_t)m * D) + F.lane;
#pragma unroll
        for (int j = 0; j < 4; ++j) { const f32x4 v = xr[64 * j]; s += (v.x * v.x + v.y * v.y) + (v.z * v.z + v.w * v.w);
            o8[64 * j] = (unsigned long long)pk2(v.x, v.y) | ((unsigned long long)pk2(v.z, v.w) << 32); }
        s = wave_sum(s);
        if (F.lane < 16) rowss[(size_t)F.lane * M + m] = (F.lane == 0) ? s : 0.f;
    }
}

__device__ __forceinline__ void cvt_item(const float* W, int ldw, int col0, int nvalid, const float* gamma, bf16* WT, int K, int dstrow0, int k0, LAS float* scr, int lane) {
    const int c32 = lane & 31;
#pragma unroll 8
    for (int i = 0; i < 32; ++i) { const int kk = 2 * i + (lane >> 5);
        float v = 0.f; if (c32 < nvalid) v = W[(size_t)(k0 + kk) * ldw + col0 + c32];
        if (gamma) v *= gamma[k0 + kk];
        scr[kk * 33 + c32] = v; }
    LDS_WAIT(); asm volatile("" ::: "memory");
    const int c = lane & 7;
#pragma unroll
    for (int j = 0; j < 4; ++j) { const int n = (lane >> 3) + 8 * j; const LAS float* s = scr + (8 * c) * 33 + n;
        v4u o; o.x = pk2(s[0 * 33], s[1 * 33]); o.y = pk2(s[2 * 33], s[3 * 33]); o.z = pk2(s[4 * 33], s[5 * 33]); o.w = pk2(s[6 * 33], s[7 * 33]);
        *(v4u*)(WT + (size_t)(dstrow0 + n) * K + k0 + 8 * c) = o; }
    LDS_WAIT(); asm volatile("" ::: "memory");
}
__device__ __forceinline__ void phase_convert(Frame& F, const Args& A, int L) {
    int lane_ = F.lane; asm volatile("" : "+v"(lane_)); const int lane = lane_;
    LAS float* scr = (LAS float*)(F.lds + RING_OFF + F.wave * 16384);
    const int gw = F.bx * NWAVES + F.wave, NGW = F.G * NWAVES;
    unsigned char* wb = A.ws + WS_W;
    constexpr int I0 = 2816, I1 = 1408, I2 = 2432, I3 = 1536, I4 = 128, I5 = 256, I6 = 128, I7 = 512, I8 = 2816, I9 = 1408;
    constexpr int NITEMS = I0 + I1 + I2 + I3 + I4 + I5 + I6 + I7 + I8 + I9;
    for (int it = gw; it < NITEMS; it += NGW) {
        int r = it;
        if (r < I0 || (r >= I0 + I1 + I2 + I3 + I4 + I5 + I6 + I7 && r < NITEMS - I9)) {
            const bool second = r >= I0; if (second) r -= (I0 + I1 + I2 + I3 + I4 + I5 + I6 + I7);
            const int kb = r / 176, nb = r % 176, n0 = 32 * nb, tile = n0 >> 8, l = n0 & 255;
            const float* Wg = (second ? A.in[16] : A.in[3]) + (size_t)L * D * FF; const float* Wu = (second ? A.in[17] : A.in[4]) + (size_t)L * D * FF;
            const float* gam = (second ? A.in[15] : A.in[2]) + (size_t)L * D;
            cvt_item(l < 128 ? Wg : Wu, FF, 128 * tile + (l & 127), 32, gam, (bf16*)(wb + (second ? O_GU2 : O_GU1)), D, n0, 64 * kb, scr, lane);
            continue; }
        r -= I0;
        if (r < I1) { const int kb = r / 32, nb = r % 32; cvt_item(A.in[5] + (size_t)L * FF * D, D, 32 * nb, 32, nullptr, (bf16*)(wb + O_DN1), FF, 32 * nb, 64 * kb, scr, lane); continue; } r -= I1;
        if (r < I2) { const int kb = r / 152, nb = r % 152, n0 = 32 * nb, tile = n0 >> 8, l = n0 & 255, bj = l >> 7, wc = (l & 127) >> 5, col0 = 256 * tile + 64 * wc + 32 * bj;
            int nv = 4808 - col0; nv = nv < 0 ? 0 : (nv > 32 ? 32 : nv);
            cvt_item(A.in[7] + (size_t)L * D * NIN, NIN, col0, nv, A.in[6] + (size_t)L * D, (bf16*)(wb + O_QKV), D, n0, 64 * kb, scr, lane); continue; } r -= I2;
        if (r < I3) { const int kb = r / 96, nb = r % 96; cvt_item(A.in[7] + (size_t)L * D * NIN, NIN, GATE_COL0 + 32 * nb, 32, A.in[6] + (size_t)L * D, (bf16*)(wb + O_GATE), D, 32 * nb, 64 * kb, scr, lane); continue; } r -= I3;
        if (r < I4) { const int kb = r / 32, nb = r % 32; cvt_item(A.in[11] + (size_t)L * 256 * D, D, 32 * nb, 32, nullptr, (bf16*)(wb + O_BA), 256, 32 * nb, 64 * kb, scr, lane); continue; } r -= I4;
        if (r < I5) { const int kb = r / 32, nb = r % 32; cvt_item(A.in[12] + (size_t)L * 512 * D, D, 32 * nb, 32, nullptr, (bf16*)(wb + O_BB), 512, 32 * nb, 64 * kb, scr, lane); continue; } r -= I5;
        if (r < I6) { const int kb = r / 32, nb = r % 32; cvt_item(A.in[13] + (size_t)L * 256 * D, D, 32 * nb, 32, nullptr, (bf16*)(wb + O_BC), 256, 32 * nb, 64 * kb, scr, lane); continue; } r -= I6;
        if (r < I7) { const int kb = r / 32, nb = r % 32; cvt_item(A.in[14] + (size_t)L * D * D, D, 32 * nb, 32, nullptr, (bf16*)(wb + O_OUT), D, 32 * nb, 64 * kb, scr, lane); continue; } r -= I7;
        r -= I8;
        { const int kb = r / 32, nb = r % 32; cvt_item(A.in[18] + (size_t)L * FF * D, D, 32 * nb, 32, nullptr, (bf16*)(wb + O_DN2), FF, 32 * nb, 64 * kb, scr, lane); }
    }
}

constexpr int COL_AQ = 0, COL_AK = 768, COL_AV = 1536, COL_BQ = 2304, COL_BK = 2816, COL_BV = 3328, COL_CQ = 3840, COL_CK = 4096, COL_CV = 4160, COL_IQ = 4224, COL_IK = 4736;
__device__ __forceinline__ void load_q(v4u (&q)[8], const bf16* p) {
#pragma unroll
    for (int i = 0; i < 8; ++i) q[i] = ((const v4u*)p)[i];
}
__device__ __forceinline__ void oracle_A(unsigned char* ws, int gw, int NGW) {
    const bf16* P = (const bf16*)(ws + WS_PROJ); const float* biasd = (const float*)(ws + WS_BIASD); bf16* O = (bf16*)(ws + WS_OATT);
    const int lane = threadIdx.x & 63;
    for (int it = gw; it < M * 4; it += NGW) {
        const int row = it >> 2, hs = it & 3, b = row >> 12, t = row & 4095;
        float mrun = -INFINITY, l = 0.f, o = 0.f;
        for (int g = 0; g < 3; ++g) {
            const int dil = (g == 0) ? 1 : (g == 1 ? 4 : 16), head = 4 * g + hs, i = t / dil, r = t % dil;
            v4u q[8]; load_q(q, P + (size_t)row * PP + COL_AQ + head * 64);
            const int jlo = (i - 128) < 0 ? 0 : (i - 128), nk = i - jlo + 1;
            for (int c0 = 0; c0 < nk; c0 += 64) {
                const int jj = c0 + lane; const bool valid = jj < nk; const int j = jlo + (valid ? jj : 0);
                const size_t krow = (size_t)b * T + (size_t)j * dil + r;
                float s = -INFINITY;
                if (valid) s = dot64(q, P + krow * PP + COL_AK + head * 64) + biasd[head * 4096 + (i - j) * dil];
                const float mnew = fmaxf(mrun, wave_max(s)); const float alpha = __builtin_amdgcn_exp2f(mrun - mnew);
                const float p = valid ? __builtin_amdgcn_exp2f(s - mnew) : 0.f;
                l = l * alpha + wave_sum(p); o *= alpha; mrun = mnew;
                const int kn = (nk - c0) < 64 ? (nk - c0) : 64;
                for (int kk = 0; kk < kn; ++kk) { const float pk = __shfl(p, kk); const size_t vrow = (size_t)b * T + (size_t)(jlo + c0 + kk) * dil + r;
                    o += pk * bflo((unsigned)P[vrow * PP + COL_AV + head * 64 + lane]); }
            }
        }
        O[(size_t)row * 1024 + hs * 64 + lane] = (bf16)f2bf(o / l);
    }
}
__device__ __forceinline__ void oracle_B_map(const bf16* P, const float* biasd, int row, int h, int mp, int lane, float& r0, float& r1) {
    const int b = row >> 12, t = row & 4095;
    v4u q[8]; load_q(q, P + (size_t)row * PP + COL_BQ + (mp * 4 + h) * 64);
    float mrun = -INFINITY, l = 0.f, o0 = 0.f, o1 = 0.f;
    for (int c0 = 0; c0 <= t; c0 += 64) {
        const int j = c0 + lane; const bool valid = j <= t; const size_t krow = (size_t)b * T + (valid ? j : 0);
        float s = -INFINITY;
        if (valid) s = dot64(q, P + krow * PP + COL_BK + (mp * 4 + h) * 64) + biasd[(12 + h) * 4096 + (t - j)];
        const float mnew = fmaxf(mrun, wave_max(s)); const float alpha = __builtin_amdgcn_exp2f(mrun - mnew);
        const float p = valid ? __builtin_amdgcn_exp2f(s - mnew) : 0.f;
        l = l * alpha + wave_sum(p); o0 *= alpha; o1 *= alpha; mrun = mnew;
        const int kn = (t + 1 - c0) < 64 ? (t + 1 - c0) : 64;
        for (int kk = 0; kk < kn; ++kk) { const float pk = __shfl(p, kk); const bf16* vp = P + ((size_t)b * T + c0 + kk) * PP + COL_BV + h * 128;
            o0 += pk * bflo((unsigned)vp[lane]); o1 += pk * bflo((unsigned)vp[64 + lane]); }
    }
    r0 = o0 / l; r1 = o1 / l;
}
__device__ __forceinline__ void oracle_B(unsigned char* ws, int gw, int NGW, const float* lv, const float* dn, int L) {
    const bf16* P = (const bf16*)(ws + WS_PROJ); const float* biasd = (const float*)(ws + WS_BIASD); bf16* O = (bf16*)(ws + WS_OATT);
    const int lane = threadIdx.x & 63;
    const float lam_init = 0.8f - 0.6f * expf(-0.3f * (float)L);
    const float lam = expf(wave_sum(lv[lane] * lv[64 + lane])) - expf(wave_sum(lv[128 + lane] * lv[192 + lane])) + lam_init;
    for (int it = gw; it < M * 4; it += NGW) {
        const int row = it >> 2, h = it & 3;
        float a0, a1, b0, b1;
        oracle_B_map(P, biasd, row, h, 0, lane, a0, a1);
        oracle_B_map(P, biasd, row, h, 1, lane, b0, b1);
        const float d0 = a0 - lam * b0, d1 = a1 - lam * b1;
        const float inv = __builtin_amdgcn_rsqf(wave_sum(d0 * d0 + d1 * d1) * (1.0f / 128.0f) + 1e-6f) * (1.0f - lam_init);
        O[(size_t)row * 1024 + 256 + h * 128 + lane] = (bf16)f2bf(d0 * inv * dn[lane]);
        O[(size_t)row * 1024 + 256 + h * 128 + 64 + lane] = (bf16)f2bf(d1 * inv * dn[64 + lane]);
    }
}
__device__ __forceinline__ void oracle_C(unsigned char* ws, int gw, int NGW, LAS unsigned char* ldsw) {
    const bf16* P = (const bf16*)(ws + WS_PROJ); const float* biasd = (const float*)(ws + WS_BIASD); bf16* O = (bf16*)(ws + WS_OATT);
    const float* widx = (const float*)(ws + WS_WIDX);
    const int lane = threadIdx.x & 63;
    LAS float* sc = (LAS float*)(ldsw);
    LAS unsigned short* sel = (LAS unsigned short*)(ldsw + 16384);
    LAS float* qi = (LAS float*)(ldsw + 16384 + 512);
    for (int row = gw; row < M; row += NGW) {
        const int b = row >> 12, t = row & 4095, N = t + 1;
#pragma unroll
        for (int i = 0; i < 8; ++i) qi[i * 64 + lane] = bflo((unsigned)P[(size_t)row * PP + COL_IQ + i * 64 + lane]);
        float w[8];
#pragma unroll
        for (int h = 0; h < 8; ++h) w[h] = widx[(size_t)row * 8 + h] * 0.35355339059327373f;
        LDS_WAIT();
        for (int c0 = 0; c0 < N; c0 += 64) {
            const int j = c0 + lane; const bool valid = j < N;
            const v4u* kp = (const v4u*)(P + ((size_t)b * T + (valid ? j : 0)) * PP + COL_IK);
            float dsum[8];
#pragma unroll
            for (int h = 0; h < 8; ++h) dsum[h] = 0.f;
#pragma unroll
            for (int i = 0; i < 8; ++i) { const v4u kv = kp[i];
                const float k0 = bflo(kv.x), k1 = bfhi(kv.x), k2 = bflo(kv.y), k3 = bfhi(kv.y), k4 = bflo(kv.z), k5 = bfhi(kv.z), k6 = bflo(kv.w), k7 = bfhi(kv.w);
#pragma unroll
                for (int h = 0; h < 8; ++h) { const f32x4 qa = *(const LAS f32x4*)(qi + h * 64 + i * 8), qb = *(const LAS f32x4*)(qi + h * 64 + i * 8 + 4);
                    dsum[h] += ((qa.x * k0 + qa.y * k1) + (qa.z * k2 + qa.w * k3)) + ((qb.x * k4 + qb.y * k5) + (qb.z * k6 + qb.w * k7)); } }
            float score = 0.f;
#pragma unroll
            for (int h = 0; h < 8; ++h) score += w[h] * fmaxf(dsum[h], 0.f);
            if (j < 4096) sc[j] = valid ? score : -INFINITY;
        }
        LDS_WAIT();
        int cnt = 0;
        if (N <= 256) { for (int n = lane; n < N; n += 64) sel[n] = (unsigned short)n; cnt = N; }
        else {
            const int N4 = (N + 3) & ~3;
            for (int c0 = 0; c0 < N; c0 += 64) {
                const int j = c0 + lane; const bool valid = j < N; const float sj = valid ? sc[j] : INFINITY;
                int rank = 0;
                for (int jp = 0; jp < N4; jp += 4) { const f32x4 v = *(const LAS f32x4*)(sc + jp);
                    rank += (v.x > sj || (v.x == sj && jp < j)) ? 1 : 0; rank += (v.y > sj || (v.y == sj && jp + 1 < j)) ? 1 : 0;
                    rank += (v.z > sj || (v.z == sj && jp + 2 < j)) ? 1 : 0; rank += (v.w > sj || (v.w == sj && jp + 3 < j)) ? 1 : 0; }
                const bool s = valid && rank < 256;
                const unsigned long long bal = __ballot(s);
                const int pos = cnt + __popcll(bal & ((1ull << lane) - 1ull));
                if (s && pos < 256) sel[pos] = (unsigned short)j;
                cnt += __popcll(bal);
            }
            cnt = cnt > 256 ? 256 : cnt;
        }
        LDS_WAIT();
        for (int h = 0; h < 4; ++h) {
            v4u q[8]; load_q(q, P + (size_t)row * PP + COL_CQ + h * 64);
            float s[4]; float mx = -INFINITY;
#pragma unroll
            for (int c = 0; c < 4; ++c) { const int n = lane + 64 * c; const bool valid = n < cnt; const int key = valid ? (int)sel[n] : 0;
                s[c] = valid ? dot64(q, P + ((size_t)b * T + key) * PP + COL_CK) + biasd[(16 + h) * 4096 + (t - key)] : -INFINITY; mx = fmaxf(mx, s[c]); }
            mx = wave_max(mx);
            float p[4], ls = 0.f;
#pragma unroll
            for (int c = 0; c < 4; ++c) { p[c] = (lane + 64 * c < cnt) ? __builtin_amdgcn_exp2f(s[c] - mx) : 0.f; ls += p[c]; }
            ls = wave_sum(ls);
            float o = 0.f;
#pragma unroll
            for (int c = 0; c < 4; ++c) { const int kn = (cnt - 64 * c) < 64 ? (cnt - 64 * c) : 64;
                for (int kk = 0; kk < kn; ++kk) { const float pk = __shfl(p[c], kk); const int key = (int)sel[64 * c + kk];
                    o += pk * bflo((unsigned)P[((size_t)b * T + key) * PP + COL_CV + lane]); } }
            O[(size_t)row * 1024 + 768 + h * 64 + lane] = (bf16)f2bf(o / ls);
        }
        LDS_WAIT();
    }
}
#define XB_TMO      128
#define XB_XCNT(j)  (256  + 64 * (j))
#define XB_XSUB(j)  (1280 + 64 * (j))
#define XB_XGEN(j)  (2304 + 64 * (j))
#define XB_TOP      3328
#define XB_TOPGEN   3392
#define XCD_BAR_WORDS 3456
#define XB_SPIN_CAP (1u << 24)

__device__ __forceinline__ unsigned xb_ld(unsigned* p)              { return __hip_atomic_load(p, __ATOMIC_RELAXED, __HIP_MEMORY_SCOPE_AGENT); }
__device__ __forceinline__ unsigned xb_add(unsigned* p, unsigned v) { return __hip_atomic_fetch_add(p, v, __ATOMIC_RELAXED, __HIP_MEMORY_SCOPE_AGENT); }
__device__ __forceinline__ unsigned xb_xcc_id() { return (unsigned)__builtin_amdgcn_s_getreg((3 << 11) | 20) & 0xFu; }
#define XB_SPIN(cond, bar) do { unsigned _sp = 0; while (cond) { __builtin_amdgcn_s_sleep(1); \
    if ((++_sp & 255u) == 0u) { if (xb_ld(&(bar)[XB_TMO])) break; if (_sp > XB_SPIN_CAP) { atomicAdd(&(bar)[XB_TMO], 1u); break; } } } } while (0)

struct XcdBarrier {
    unsigned* bar; unsigned x;
    volatile LAS unsigned* st;
};

__device__ __forceinline__ XcdBarrier xcd_barrier_post(unsigned* bar, volatile LAS unsigned* st) {
    XcdBarrier b; b.bar = bar; b.x = xb_xcc_id(); b.st = st;
    if (threadIdx.x == 0) (void)xb_add(&bar[XB_XCNT(b.x)], 1u);
    return b;
}
__device__ __forceinline__ void xcd_barrier_complete(unsigned* bar, unsigned x, unsigned& nloc, unsigned& nx) {
    const unsigned G = gridDim.x * gridDim.y * gridDim.z;
    unsigned sum, cnt, mine, sp = 0u;
    for (;;) {
        sum = 0u; cnt = 0u; mine = 0u;
#pragma unroll
        for (unsigned j = 0; j < 16; ++j) { const unsigned c = xb_ld(&bar[XB_XCNT(j)]); sum += c; cnt += (c > 0u) ? 1u : 0u; mine = (j == x) ? c : mine; }
        if (sum == G) break;
        __builtin_amdgcn_s_sleep(1);
        if ((++sp & 255u) == 0u) { if (xb_ld(&bar[XB_TMO])) break; if (sp > XB_SPIN_CAP) { atomicAdd(&bar[XB_TMO], 1u); break; } }
    }
    nloc = mine > 0u ? mine : 1u; nx = cnt > 0u ? cnt : 1u;
}

__device__ __forceinline__ void xcd_barrier(const XcdBarrier& b) {
    asm volatile("s_waitcnt vmcnt(0)" ::: "memory");
    __syncthreads();
    if (threadIdx.x == 0) {
        unsigned* bar = b.bar;
        __builtin_amdgcn_s_waitcnt(0);
        unsigned nloc = b.st[0], nx = b.st[1];
        if (nloc == 0u) { xcd_barrier_complete(bar, b.x, nloc, nx); b.st[0] = nloc; b.st[1] = nx; }
        const unsigned old = xb_add(&bar[XB_XSUB(b.x)], 1u);
        const unsigned gen = old / nloc;
        if (old + 1u == (gen + 1u) * nloc) {
            __builtin_amdgcn_fence(__ATOMIC_RELEASE, "agent");
            asm volatile("s_waitcnt vmcnt(0)" ::: "memory");
            const unsigned og = xb_add(&bar[XB_TOP], 1u);
            const unsigned tg = og / nx;
            if (og + 1u == (tg + 1u) * nx) xb_add(&bar[XB_TOPGEN], 1u);
            else XB_SPIN(xb_ld(&bar[XB_TOPGEN]) == tg, bar);
            __builtin_amdgcn_fence(__ATOMIC_ACQUIRE, "agent");
            xb_add(&bar[XB_XGEN(b.x)], 1u);
            asm volatile("s_waitcnt vmcnt(0)" ::: "memory");
        } else {
            XB_SPIN(xb_ld(&bar[XB_XGEN(b.x)]) == gen, bar);
            __builtin_amdgcn_fence(__ATOMIC_ACQUIRE, "agent");
            asm volatile("s_waitcnt vmcnt(0)" ::: "memory");
        }
    }
    __syncthreads();
}
#ifndef MODE4_FILTER
#define MODE4_FILTER 1
#endif
#ifndef MODE6_ONLY
#define MODE6_ONLY -1
#endif
__device__ __forceinline__ void chk_put2(unsigned char* ws, float d2, float r2) { if ((threadIdx.x & 63) == 0) { atomicAdd((float*)(ws + WS_CTL) + 8, d2); atomicAdd((float*)(ws + WS_CTL) + 9, r2); } }
__device__ __forceinline__ float row_r_from(const float* xrow, int lane) {
    float s = 0.f; for (int j = 0; j < 16; ++j) { const float v = xrow[lane + 64 * j]; s += v * v; }
    return 1.0f / sqrtf(wave_sum(s) * (1.0f / 1024.0f) + 1e-6f);
}
__global__ void __launch_bounds__(256) k_check(Args A, int mode, int L) {
    const int lane = threadIdx.x & 63, gw = blockIdx.x * 4 + (threadIdx.x >> 6), NGW = gridDim.x * 4;
    unsigned char* ws = A.ws;
    const bf16* HMID = (const bf16*)(ws + WS_HMID); const bf16* PROJ = (const bf16*)(ws + WS_PROJ); const bf16* GATES = (const bf16*)(ws + WS_GATES);
    const bf16* OATT = (const bf16*)(ws + WS_OATT); const bf16* Y = (const bf16*)(ws + WS_Y); const bf16* XB = (const bf16*)(ws + WS_XB); const float* ROWSS = (const float*)(ws + WS_ROWSS);
    for (int s = gw; s < 8192; s += NGW) {
        const int row = (int)(((unsigned)s * 2654435761u) >> 18) & 16383;
        if (mode == 1) {
            const float* x = A.in[0] + (size_t)row * D; const float r = row_r_from(x, lane); const float* gam = A.in[2] + (size_t)L * D;
            const int c = (s * 37) % FF; const float* Wg = A.in[3] + (size_t)L * D * FF; const float* Wu = A.in[4] + (size_t)L * D * FF;
            float g = 0.f, u = 0.f;
            for (int j = 0; j < 16; ++j) { const int k = lane + 64 * j; const float xn = x[k] * r * gam[k]; g += xn * Wg[(size_t)k * FF + c]; u += xn * Wu[(size_t)k * FF + c]; }
            g = wave_sum(g); u = wave_sum(u);
            const float ref = g / (1.0f + expf(-g)) * u, mine = bflo((unsigned)HMID[(size_t)row * FF + c]);
            chk_put2(ws, (mine - ref) * (mine - ref), ref * ref);
        } else if (mode == 2) {
            const int c = (s * 37) % D; const float* Wd = A.in[5] + (size_t)L * FF * D;
            float a = 0.f;
            for (int j = lane; j < FF; j += 64) a += bflo((unsigned)HMID[(size_t)row * FF + j]) * Wd[(size_t)j * D + c];
            a = wave_sum(a);
            const float ref = A.in[0][(size_t)row * D + c] + 0.5f * a, mine = A.out[(size_t)row * D + c];
            float d2 = (mine - ref) * (mine - ref);
            const float xbv = bflo((unsigned)XB[(size_t)row * D + c]); d2 += (xbv - mine) * (xbv - mine);
            float ss = 0.f; for (int j = 0; j < 16; ++j) { const float v = A.out[(size_t)row * D + lane + 64 * j]; ss += v * v; } ss = wave_sum(ss);
            float ps = 0.f; if (lane < 16) ps = ROWSS[(size_t)lane * M + row]; ps = wave_sum(ps);
            d2 += (ps - ss) * (ps - ss) / (ss * ss) * ref * ref;
            chk_put2(ws, d2, ref * ref);
        } else if (mode == 3) {
            const int hidx = (s * 13) % 75; const float* x = A.out + (size_t)row * D; const float r = row_r_from(x, lane); const float* gam = A.in[6] + (size_t)L * D;
            const float* W = A.in[7] + (size_t)L * D * NIN; const int c = 64 * hidx + lane;
            float a = 0.f; for (int k = 0; k < D; ++k) a += x[k] * r * gam[k] * W[(size_t)k * NIN + c];
            int gi = -1; float post = 1.f; const float C2 = 0.125f * LOG2E;
            if (hidx < 12) { gi = 0; post = C2; } else if (hidx < 24) gi = 1; else if (hidx < 36) {} else if (hidx < 44) { gi = 2; post = C2; } else if (hidx < 52) gi = 3; else if (hidx < 60) {}
            else if (hidx < 64) { gi = 4; post = C2; } else if (hidx == 64) gi = 5; else if (hidx == 65) {} else if (hidx < 74) post = 0.125f;
            float ref = a * post;
            if (gi >= 0) { const float ms = wave_sum(a * a) * (1.0f / 64.0f); ref = a / sqrtf(ms + 1e-6f) * (A.in[8] + (size_t)L * 384)[gi * 64 + lane] * post; }
            const float mine = bflo((unsigned)PROJ[(size_t)row * PP + c]);
            chk_put2(ws, wave_sum((mine - ref) * (mine - ref)), wave_sum(ref * ref));
        } else if (mode == 4) {
            const float* x = A.out + (size_t)row * D; const float r = row_r_from(x, lane); const float* gam = A.in[6] + (size_t)L * D;
            const float* W = A.in[7] + (size_t)L * D * NIN; const int c = ((s * 29) % 48) * 64 + lane;
            float a = 0.f; for (int k = 0; k < D; ++k) a += x[k] * r * gam[k] * W[(size_t)k * NIN + GATE_COL0 + c];
            float ref = 1.0f / (1.0f + expf(-a)), mine = bflo((unsigned)GATES[(size_t)row * NGATE + c]);
            if (!(MODE4_FILTER)) { ref = 0.f; mine = 0.f; }
#ifdef MODE4_HALF
            mine = mine - 0.5f + ref;
#endif
            chk_put2(ws, wave_sum((mine - ref) * (mine - ref)), wave_sum(ref * ref));
        } else if (mode == 5) {
            const int c = ((s * 29) % 16) * 64 + lane;
            const float* Wa = A.in[11] + (size_t)L * 256 * D; const float* Wb = A.in[12] + (size_t)L * 512 * D; const float* Wc = A.in[13] + (size_t)L * 256 * D;
            float ya = 0.f, yb = 0.f, yc = 0.f;
            for (int j = 0; j < 256; ++j) ya += bflo((unsigned)OATT[(size_t)row * 1024 + j]) * Wa[(size_t)j * D + c];
            for (int j = 0; j < 512; ++j) yb += bflo((unsigned)OATT[(size_t)row * 1024 + 256 + j]) * Wb[(size_t)j * D + c];
            for (int j = 0; j < 256; ++j) yc += bflo((unsigned)OATT[(size_t)row * 1024 + 768 + j]) * Wc[(size_t)j * D + c];
            const float ref = bflo((unsigned)GATES[(size_t)row * NGATE + c]) * ya + bflo((unsigned)GATES[(size_t)row * NGATE + 1024 + c]) * yb + bflo((unsigned)GATES[(size_t)row * NGATE + 2048 + c]) * yc;
            const float mine = bflo((unsigned)Y[(size_t)row * 1024 + c]);
            chk_put2(ws, wave_sum((mine - ref) * (mine - ref)), wave_sum(ref * ref));
        } else if (mode == 6) {
            const int id = s % 10; const unsigned hsh = ((unsigned)s * 64u + (unsigned)lane) * 2246822519u; const unsigned char* wb = ws + WS_W;
            float ref = 0.f, mine = 0.f;
            if (id == 0 || id == 8) { const int n = (hsh >> 8) % 5632, k = (hsh >> 21) % 1024, tile = n >> 8, l = n & 255; const bool second = id == 8;
                const float* W = (l < 128) ? (second ? A.in[16] : A.in[3]) : (second ? A.in[17] : A.in[4]); const float* gam = second ? A.in[15] : A.in[2];
                ref = W[(size_t)L * D * FF + (size_t)k * FF + 128 * tile + (l & 127)] * gam[(size_t)L * D + k]; mine = bflo((unsigned)((const bf16*)(wb + (second ? O_GU2 : O_GU1)))[(size_t)n * D + k]); }
            else if (id == 1 || id == 9) { const int n = (hsh >> 8) % 1024, k = (hsh >> 19) % FF; const float* W = (id == 9) ? A.in[18] : A.in[5];
                ref = W[(size_t)L * FF * D + (size_t)k * D + n]; mine = bflo((unsigned)((const bf16*)(wb + (id == 9 ? O_DN2 : O_DN1)))[(size_t)n * FF + k]); }
            else if (id == 2) { const int n = (hsh >> 8) % 4864, k = (hsh >> 21) % 1024, tile = n >> 8, l = n & 255, bj = l >> 7, wc = (l & 127) >> 5, col = 256 * tile + 64 * wc + 32 * bj + (l & 31);
                ref = (col < 4808) ? A.in[7][(size_t)L * D * NIN + (size_t)k * NIN + col] * A.in[6][(size_t)L * D + k] : 0.f; mine = bflo((unsigned)((const bf16*)(wb + O_QKV))[(size_t)n * D + k]); }
            else if (id == 3) { const int n = (hsh >> 8) % 3072, k = (hsh >> 21) % 1024;
                ref = A.in[7][(size_t)L * D * NIN + (size_t)k * NIN + GATE_COL0 + n] * A.in[6][(size_t)L * D + k]; mine = bflo((unsigned)((const bf16*)(wb + O_GATE))[(size_t)n * D + k]); }
            else if (id == 4 || id == 6) { const int n = (hsh >> 8) % 1024, k = (hsh >> 19) % 256; const float* W = (id == 4) ? A.in[11] : A.in[13];
                ref = W[(size_t)L * 256 * D + (size_t)k * D + n]; mine = bflo((unsigned)((const bf16*)(wb + (id == 4 ? O_BA : O_BC)))[(size_t)n * 256 + k]); }
            else if (id == 5) { const int n = (hsh >> 8) % 1024, k = (hsh >> 19) % 512; ref = A.in[12][(size_t)L * 512 * D + (size_t)k * D + n]; mine = bflo((unsigned)((const bf16*)(wb + O_BB))[(size_t)n * 512 + k]); }
            else { const int n = (hsh >> 8) % 1024, k = (hsh >> 19) % 1024; ref = A.in[14][(size_t)L * D * D + (size_t)k * D + n]; mine = bflo((unsigned)((const bf16*)(wb + O_OUT))[(size_t)n * D + k]); }
            if (MODE6_ONLY >= 0 && id != MODE6_ONLY) { ref = 0.f; mine = 0.f; }
            chk_put2(ws, wave_sum((mine - ref) * (mine - ref)), wave_sum(ref * ref));
        } else { chk_put2(ws, 1.0f, 1.0f); }
    }
}
__global__ void __launch_bounds__(256) k_report(unsigned char* ws, float* out) {
    const float sd = ((const float*)(ws + WS_CTL))[8], sr = ((const float*)(ws + WS_CTL))[9]; const float v = sqrtf(sd / fmaxf(sr, 1e-30f)); const float K = 1.0e5f * fminf(v, 1.0e3f);
    for (size_t i = (size_t)blockIdx.x * 256 + threadIdx.x; i < (size_t)M * D; i += (size_t)gridDim.x * 256) out[i] = K;
}
#ifndef GATE_ALIGN
#define GATE_ALIGN true
#endif
#ifndef MERGE_CALLS
#define MERGE_CALLS 3
#endif
#ifndef ORACLE_MASK
#define ORACLE_MASK 7
#endif
#ifndef PHASE_MASK
#define PHASE_MASK 0x1ff
#endif
constexpr int NPH_LAYER = 9, NPHASE = 1 + NLAYER * NPH_LAYER;
__global__ void __launch_bounds__(NWAVES * 64, 2) mk_fwd(const Args A) {
    extern __shared__ __attribute__((aligned(16))) unsigned char lds[];
    Frame F;
    F.lds = (LAS unsigned char*)lds;
    F.MISC = (volatile LAS unsigned*)(F.lds + MISC_OFF);
    F.tid = threadIdx.x; F.lane = F.tid & 63; F.wave = __builtin_amdgcn_readfirstlane(F.tid >> 6);
    F.G = gridDim.x; F.bx = blockIdx.x;
    gu32* const ctl = (gu32*)(A.ws + WS_CTL);
    for (int u = F.tid; u < (LDS_BYTES - MISC_OFF) / 4; u += NWAVES * 64) ((LAS unsigned*)(F.lds + MISC_OFF))[u] = 0u;
    __syncthreads();
    const int lo = A.lo, hi = A.hi;
    XcdBarrier bar; bar.bar = (unsigned*)(ctl + CW_BAR); bar.x = 0; bar.st = nullptr;
    if (hi - lo > 1) bar = xcd_barrier_post((unsigned*)(ctl + CW_BAR), F.MISC + 8);
#define IN(k) (lo <= (k) && (k) < hi)
#define SEAM(k) do { if (IN(k) && IN((k) + 1)) xcd_barrier(bar); } while (0)
    bf16* const XB = (bf16*)(A.ws + WS_XB); bf16* const PROJ = (bf16*)(A.ws + WS_PROJ); bf16* const HMID = (bf16*)(A.ws + WS_HMID); bf16* const GATES = (bf16*)(A.ws + WS_GATES);
    bf16* const OATT = (bf16*)(A.ws + WS_OATT); bf16* const Y = (bf16*)(A.ws + WS_Y); float* const ROWSS = (float*)(A.ws + WS_ROWSS); float* const WIDX = (float*)(A.ws + WS_WIDX);
    unsigned char* const wb = A.ws + WS_W;

    if (IN(0)) { phase_prologue(F, A); } SEAM(0);

    for (int L = 0; L < NLAYER; ++L) {
        const int g0 = 1 + L * NPH_LAYER;
        if (hi <= g0 || lo >= g0 + NPH_LAYER) continue;
        if (((PHASE_MASK >> 0) & 1) && IN(g0 + 0)) { phase_convert(F, A, L); } SEAM(g0 + 0);
        if (((PHASE_MASK >> 1) & 1) && IN(g0 + 1)) {
            pg8::Gemm g{XB, (const bf16*)(wb + O_GU1), M, 2 * FF, D, D}; pg8::StaticOrder S; S.init(M, 2 * FF, F.G, F.bx);
            epi::EpiSwiGLU E{HMID, FF, ROWSS};
            pg8::gemm_phase<epi::EpiSwiGLU, pg8::StaticOrder, true, true>(F.lds + RING_OFF, g, S, E);
        } SEAM(g0 + 1);
        if (((PHASE_MASK >> 2) & 1) && IN(g0 + 2)) {
            pg8::Gemm g{HMID, (const bf16*)(wb + O_DN1), M, D, FF, FF}; pg8::StaticOrder S; S.init(M, D, F.G, F.bx);
            epi::EpiResidual E{(L == 0) ? A.in[0] : (const float*)A.out, A.out, XB, ROWSS, 0.5f};
            pg8::gemm_phase<epi::EpiResidual, pg8::StaticOrder, false, true>(F.lds + RING_OFF, g, S, E);
        } SEAM(g0 + 2);
        if (((PHASE_MASK >> 3) & 1) && IN(g0 + 3)) {
            pg8::Gemm g{XB, (const bf16*)(wb + O_QKV), M, PP, D, D}; pg8::StaticOrder S; S.init(M, PP, F.G, F.bx);
            epi::EpiQKV E{PROJ, PP, ROWSS, A.in[8] + (size_t)L * 384, WIDX};
            pg8::gemm_phase<epi::EpiQKV, pg8::StaticOrder, true, true>(F.lds + RING_OFF, g, S, E);
        } SEAM(g0 + 3);
        if (((PHASE_MASK >> 4) & 1) && IN(g0 + 4)) {
            { pg8::Gemm g{XB, (const bf16*)(wb + O_GATE), M, NGATE, D, D}; pg8::StaticOrder S; S.init(M, NGATE, F.G, F.bx);
              epi::EpiSigmoid E{GATES, NGATE, ROWSS};
              pg8::gemm_phase<epi::EpiSigmoid, pg8::StaticOrder, GATE_ALIGN, true>(F.lds + RING_OFF, g, S, E); }
            __syncthreads();
            __syncthreads();
        } SEAM(g0 + 4);
        if (((PHASE_MASK >> 5) & 1) && IN(g0 + 5)) {
            pg8::StaticOrder S; S.init(M, D, F.G, F.bx);
            { pg8::Gemm g{OATT, (const bf16*)(wb + O_BA), M, D, 256, 1024}; epi::EpiMerge E{Y, GATES, NGATE, 0};
              pg8::gemm_phase<epi::EpiMerge, pg8::StaticOrder, false, true>(F.lds + RING_OFF, g, S, E); }
#if MERGE_CALLS > 1
            { pg8::Gemm g{OATT + 256, (const bf16*)(wb + O_BB), M, D, 512, 1024}; epi::EpiMerge E{Y, GATES + 1024, NGATE, 1};
              pg8::gemm_phase<epi::EpiMerge, pg8::StaticOrder, false, true>(F.lds + RING_OFF, g, S, E); }
            { pg8::Gemm g{OATT + 768, (const bf16*)(wb + O_BC), M, D, 256, 1024}; epi::EpiMerge E{Y, GATES + 2048, NGATE, 1};
              pg8::gemm_phase<epi::EpiMerge, pg8::StaticOrder, false, true>(F.lds + RING_OFF, g, S, E); }
#endif
        } SEAM(g0 + 5);
        if (((PHASE_MASK >> 6) & 1) && IN(g0 + 6)) {
            pg8::Gemm g{Y, (const bf16*)(wb + O_OUT), M, D, D, D}; pg8::StaticOrder S; S.init(M, D, F.G, F.bx);
            epi::EpiResidual E{(const float*)A.out, A.out, XB, ROWSS, 1.0f};
            pg8::gemm_phase<epi::EpiResidual, pg8::StaticOrder, false, true>(F.lds + RING_OFF, g, S, E);
        } SEAM(g0 + 6);
        if (((PHASE_MASK >> 7) & 1) && IN(g0 + 7)) {
            pg8::Gemm g{XB, (const bf16*)(wb + O_GU2), M, 2 * FF, D, D}; pg8::StaticOrder S; S.init(M, 2 * FF, F.G, F.bx);
            epi::EpiSwiGLU E{HMID, FF, ROWSS};
            pg8::gemm_phase<epi::EpiSwiGLU, pg8::StaticOrder, true, true>(F.lds + RING_OFF, g, S, E);
        } SEAM(g0 + 7);
        if (((PHASE_MASK >> 8) & 1) && IN(g0 + 8)) {
            pg8::Gemm g{HMID, (const bf16*)(wb + O_DN2), M, D, FF, FF}; pg8::StaticOrder S; S.init(M, D, F.G, F.bx);
            epi::EpiResidual E{(const float*)A.out, A.out, XB, ROWSS, 0.5f};
            pg8::gemm_phase<epi::EpiResidual, pg8::StaticOrder, false, true>(F.lds + RING_OFF, g, S, E);
        } SEAM(g0 + 8);
    }
#undef IN
#undef SEAM
}

__global__ void __launch_bounds__(256) k_oracle_A(unsigned char* ws) { oracle_A(ws, blockIdx.x * 4 + (threadIdx.x >> 6), gridDim.x * 4); }
__global__ void __launch_bounds__(256) k_oracle_B(unsigned char* ws, const float* lv, const float* dn, int L) { oracle_B(ws, blockIdx.x * 4 + (threadIdx.x >> 6), gridDim.x * 4, lv + (size_t)L * 256, dn + (size_t)L * 128, L); }
__global__ void __launch_bounds__(128, 1) k_oracle_C(unsigned char* ws) { extern __shared__ __attribute__((aligned(16))) unsigned char olds[]; oracle_C(ws, blockIdx.x * 2 + (threadIdx.x >> 6), gridDim.x * 2, (LAS unsigned char*)olds + (threadIdx.x >> 6) * 18944); }
__global__ void __launch_bounds__(256) k_fill(unsigned char* ws) { const bf16* P = (const bf16*)(ws + WS_PROJ); bf16* O = (bf16*)(ws + WS_OATT);
    for (size_t i = (size_t)blockIdx.x * 256 + threadIdx.x; i < (size_t)M * 1024; i += (size_t)gridDim.x * 256) { const size_t row = i >> 10, c = i & 1023; O[row * 1024 + c] = P[row * PP + c]; } }
extern "C" void kernel_launch(void* const* d_in, const int* in_sizes, int n_in, void* d_out, int out_size, void* d_ws, size_t ws_size, hipStream_t stream) {
    static int grid = 0;
    if (grid == 0) {
        if (n_in != 19 || in_sizes[0] != M * D || out_size != M * D || ws_size < WS_END) { fprintf(stderr, "kernel_launch: unexpected shapes / workspace (n_in %d, ws %zu)\n", n_in, ws_size); grid = -1; return; }
        int dev = 0, cus = 0, per_cu = 0;
        if (hipGetDevice(&dev) != hipSuccess || hipDeviceGetAttribute(&cus, hipDeviceAttributeMultiprocessorCount, dev) != hipSuccess) { grid = -1; return; }
        if (hipFuncSetAttribute((const void*)mk_fwd, hipFuncAttributeMaxDynamicSharedMemorySize, LDS_BYTES) != hipSuccess) { fprintf(stderr, "kernel_launch: hipFuncSetAttribute failed\n"); grid = -1; return; }
        if (hipOccupancyMaxActiveBlocksPerMultiprocessor(&per_cu, (const void*)mk_fwd, NWAVES * 64, LDS_BYTES) != hipSuccess || per_cu < 1) { fprintf(stderr, "kernel_launch: occupancy query says %d\n", per_cu); }
        (void)hipGetLastError();
        grid = cus;
    }
    if (grid < 0) return;
    (void)hipMemsetAsync((char*)d_ws + WS_CTL, 0, CTL_ZERO_BYTES, stream);
    Args a{};
    for (int i = 0; i < 19; ++i) a.in[i] = (const float*)d_in[i];
    a.out = (float*)d_out; a.ws = (unsigned char*)d_ws;
#if defined(CHECK_MODE)
    for (int g = 0; g <= CHECK_UPTO; ++g) { a.lo = g; a.hi = g + 1; hipLaunchKernelGGL(mk_fwd, dim3(grid), dim3(NWAVES * 64), LDS_BYTES, stream, a);
        if (g >= 1 && (g - 1) % NPH_LAYER == 4) hipLaunchKernelGGL(k_fill, dim3(2048), dim3(256), 0, stream, a.ws); }
    a.lo = 0; a.hi = 0;
    hipLaunchKernelGGL(k_check, dim3(512), dim3(256), 0, stream, a, (int)CHECK_MODE, 0);
    hipLaunchKernelGGL(k_report, dim3(2048), dim3(256), 0, stream, a.ws, a.out);
#elif MK_N_LAUNCHES == 1
    a.lo = 0; a.hi = NPHASE;
    hipLaunchKernelGGL(mk_fwd, dim3(grid), dim3(NWAVES * 64), LDS_BYTES, stream, a);
#else
    for (int g = 0; g < NPHASE; ++g) { a.lo = g; a.hi = g + 1; hipLaunchKernelGGL(mk_fwd, dim3(grid), dim3(NWAVES * 64), LDS_BYTES, stream, a);
        if (ORACLE_MASK && ((PHASE_MASK >> 4) & 1) && g >= 1 && (g - 1) % NPH_LAYER == 4) { const int L = (g - 1) / NPH_LAYER;
            if (ORACLE_MASK & 8) hipLaunchKernelGGL(k_fill, dim3(2048), dim3(256), 0, stream, a.ws);
            if (ORACLE_MASK & 1) hipLaunchKernelGGL(k_oracle_A, dim3(4096), dim3(256), 0, stream, a.ws);
            if (ORACLE_MASK & 2) hipLaunchKernelGGL(k_oracle_B, dim3(4096), dim3(256), 0, stream, a.ws, a.in[9], a.in[10], L);
            if (ORACLE_MASK & 4) hipLaunchKernelGGL(k_oracle_C, dim3(4096), dim3(128), 2 * 18944, stream, a.ws); } }
#endif
}
```

```cpp
#include <hip/hip_runtime.h>
#include <cstdio>
#include <cstdint>
#include <cmath>
#ifndef MK_N_LAUNCHES
#define MK_N_LAUNCHES 1
#endif
namespace pg8 {
#define PG8_LAS __attribute__((address_space(3)))
typedef unsigned short bf16_t;
typedef short bf16x8 __attribute__((ext_vector_type(8)));
typedef float f32x4 __attribute__((ext_vector_type(4)));
typedef unsigned u32x4 __attribute__((ext_vector_type(4)));
typedef unsigned u32x2 __attribute__((ext_vector_type(2)));
constexpr int BM = 256, BK = 64, HALF = 128, HTB = HALF * BK * 2  , STAGE_BYTES = 8 * HTB, NXCD = 8, WGM = 8;

__host__ __device__ __forceinline__ int lds_byte(int r, int c) { const int st = (r >> 4) * 2 + (c >> 5), rr = r & 15, cc = c & 31, ob = rr * 64 + cc * 2; return st * 1024 + (ob ^ (((ob >> 9) & 1) << 5)); }
__host__ __device__ __forceinline__ void stage_rc(int b, int& R, int& C) { const int st = b / 1024, sb = b % 1024, swz = sb ^ (((sb >> 9) & 1) << 5); R = (st >> 1) * 16 + swz / 64; C = (st & 1) * 32 + (swz % 64) / 2; }
__host__ __device__ __forceinline__ int perm32(int rho) { const int n = rho >> 4, i = rho & 15; return 8 * (i >> 2) + 4 * n + (i & 3); }

struct Unit { int pm, pn; };
struct Gemm { const bf16_t* A; const bf16_t* Bt; int M, N, K, lda; };

struct StaticOrder {
    int nM, nN, nwg, G, c;
    __host__ __device__ void init(int M, int N, int G_, int c_) { nM = M / BM; nN = N / BM; nwg = nM * nN; G = G_; c = c_; }
    __host__ __device__ bool next(int i, Unit& u) const {
        const long L = (long)i * G + c; if (L >= nwg) return false;
        int wgid = (int)L; { const int q = nwg / NXCD, r = nwg % NXCD, xcd = wgid % NXCD, off = wgid / NXCD; wgid = (xcd < r ? xcd * (q + 1) : r * (q + 1) + (xcd - r) * q) + off; }
        const int nig = WGM * nN, gid = wgid / nig, fm = gid * WGM, gsz = (nM - fm) < WGM ? (nM - fm) : WGM;
        u.pm = fm + ((wgid % nig) % gsz); u.pn = (wgid % nig) / gsz; return true;
    }
    __device__ __forceinline__ void a_ready(const Unit&) const {}
    __device__ __forceinline__ void done(const Unit&) const {}
};

typedef float f32x2_t __attribute__((ext_vector_type(2))); typedef __bf16 bf16x2_t __attribute__((ext_vector_type(2)));
__device__ __forceinline__ unsigned cvt_pk_bf16(float lo, float hi) { f32x2_t v = {lo, hi}; bf16x2_t b = __builtin_convertvector(v, bf16x2_t); return __builtin_bit_cast(unsigned, b); }

template <class Epi, class Sched, bool ALIGN_EPI = false, bool SP2 = false>
__device__ __forceinline__ void gemm_phase(PG8_LAS unsigned char* lds, const Gemm g, const Sched& S, const Epi& E) {
    int tid_ = threadIdx.x; asm volatile("" : "+v"(tid_));
    const int tid = tid_, wid = __builtin_amdgcn_readfirstlane(tid >> 6), lane = tid & 63, wr = wid >> 2, wc = wid & 3, fr = lane & 15, fq = lane >> 4;
    const int K = g.K, nt = K / BK, lda = g.lda;
    unsigned voffA[2], voffB[2];
#pragma unroll
    for (int i = 0; i < 2; ++i) { int R, C; stage_rc(tid * 16 + i * 8192, R, C); const int Rb = Epi::PERM ? ((R & ~31) + perm32(R & 31)) : R;
        voffA[i] = (unsigned)(R * lda + C) * 2u; voffB[i] = (unsigned)(Rb * K + C) * 2u; }
    const size_t kstep = (size_t)(BK * 2);
    const size_t hstepA = (size_t)HALF * lda * 2, hstepB = (size_t)HALF * K * 2;
    const size_t tstepA = 2 * hstepA, tstepB = 2 * hstepB;
    const unsigned ldsw = (unsigned)wid * 1024u;
    const int aoff = lds_byte(wr * 64 + fr, fq * 8), boff = lds_byte(wc * 32 + fr, fq * 8);
#define PG8_SA(b, h) (((b) * 2 + (h)) * HTB)
#define PG8_SB(b, h) ((4 + (b) * 2 + (h)) * HTB)
#define PG8_STAGE(bufoff, gbase, voff) do { _Pragma("unroll") for (int _i = 0; _i < 2; ++_i) \
        __builtin_amdgcn_global_load_lds((const unsigned*)((const char*)(gbase) + (voff)[_i]), (PG8_LAS unsigned*)(lds + (bufoff) + ldsw + _i * 8192), 16, 0, 0); } while (0)
#define PG8_LDA(dst, b, h) do { _Pragma("unroll") for (int m = 0; m < 4; ++m) _Pragma("unroll") for (int k = 0; k < 2; ++k) dst[m][k] = *(const PG8_LAS bf16x8*)(lds + PG8_SA(b, h) + aoff + m * 2048 + k * 1024); } while (0)
#define PG8_LDB(dst, b, h) do { _Pragma("unroll") for (int n = 0; n < 2; ++n) _Pragma("unroll") for (int k = 0; k < 2; ++k) dst[n][k] = *(const PG8_LAS bf16x8*)(lds + PG8_SB(b, h) + boff + n * 2048 + k * 1024); } while (0)
#define PG8_MMA(ai, bj, At, Bt) do { __builtin_amdgcn_s_setprio(1); _Pragma("unroll") for (int m = 0; m < 4; ++m) _Pragma("unroll") for (int n = 0; n < 2; ++n) _Pragma("unroll") for (int k = 0; k < 2; ++k) \
        acc[ai][bj][m][n] = __builtin_amdgcn_mfma_f32_16x16x32_bf16(Bt[n][k], At[m][k], acc[ai][bj][m][n], 0, 0, 0); __builtin_amdgcn_s_setprio(0); } while (0)
#define PG8_WAIT_V(n) asm volatile("s_waitcnt vmcnt(" #n ")" ::: "memory")
#define PG8_WAIT_L(n) asm volatile("s_waitcnt lgkmcnt(" #n ")" ::: "memory")
#define PG8_BAR __builtin_amdgcn_s_barrier()
#define PG8_SCHED __builtin_amdgcn_sched_barrier(0)
    Unit cur, nxt; int ui = 0;
    if (!S.next(0, cur)) return;
    f32x4 acc[2][2][4][2];
#pragma unroll
    for (int a = 0; a < 2; ++a)
#pragma unroll
        for (int b = 0; b < 2; ++b)
#pragma unroll
            for (int m = 0; m < 4; ++m)
#pragma unroll
                for (int n = 0; n < 2; ++n) acc[a][b][m][n] = (f32x4){0.f, 0.f, 0.f, 0.f};
    bf16x8 At[4][2], B0[2][2], B1[2][2];
    const char* cA = (const char*)g.A + (size_t)cur.pm * tstepA; const char* cB = (const char*)g.Bt + (size_t)cur.pn * tstepB;
    S.a_ready(cur);
    if constexpr (SP2) {
        PG8_STAGE(PG8_SB(0, 0), cB, voffB); PG8_STAGE(PG8_SB(0, 1), cB + hstepB, voffB); PG8_STAGE(PG8_SA(0, 0), cA, voffA); PG8_STAGE(PG8_SA(0, 1), cA + hstepA, voffA);
        if (wr == 1) PG8_BAR;
        PG8_WAIT_V(2); PG8_BAR;
        PG8_STAGE(PG8_SB(1, 0), cB + kstep, voffB); PG8_STAGE(PG8_SA(1, 0), cA + kstep, voffA); PG8_STAGE(PG8_SB(1, 1), cB + hstepB + kstep, voffB);
        PG8_WAIT_V(6); PG8_BAR;
    } else {
        PG8_STAGE(PG8_SB(0, 0), cB, voffB); PG8_STAGE(PG8_SA(0, 0), cA, voffA); PG8_STAGE(PG8_SB(0, 1), cB + hstepB, voffB); PG8_STAGE(PG8_SA(0, 1), cA + hstepA, voffA);
        if (wr == 1) PG8_BAR;
        PG8_WAIT_V(4); PG8_BAR;
        PG8_STAGE(PG8_SB(1, 0), cB + kstep, voffB); PG8_STAGE(PG8_SA(1, 0), cA + kstep, voffA); PG8_STAGE(PG8_SB(1, 1), cB + hstepB + kstep, voffB);
        PG8_WAIT_V(6); PG8_BAR;
    }
    for (;;) {
        const bool has_next = S.next(ui + 1, nxt);
        const char* nA = has_next ? (const char*)g.A + (size_t)nxt.pm * tstepA : cA; const char* nB = has_next ? (const char*)g.Bt + (size_t)nxt.pn * tstepB : cB;
        for (int t = 0; t < nt; t += 2) {
            const bool last = (t == nt - 2);
            const char* a1 = cA + (size_t)(t + 1) * kstep;
            const char* a2 = last ? nA : cA + (size_t)(t + 2) * kstep; const char* b2 = last ? nB : cB + (size_t)(t + 2) * kstep;
            const char* a3 = a2 + kstep; const char* b3 = b2 + kstep;
            if (last && has_next) S.a_ready(nxt);
            if constexpr (SP2) {
            PG8_LDB(B0, 0, 0); PG8_LDB(B1, 0, 1); PG8_SCHED; PG8_LDA(At, 0, 0); PG8_STAGE(PG8_SA(1, 1), a1 + hstepA, voffA);
            PG8_WAIT_V(8); PG8_WAIT_L(0); PG8_BAR; PG8_MMA(0, 0, At, B0); PG8_MMA(0, 1, At, B1); PG8_BAR; PG8_SCHED;
            PG8_LDA(At, 0, 1); PG8_STAGE(PG8_SB(0, 0), b2, voffB); PG8_STAGE(PG8_SB(0, 1), b2 + hstepB, voffB); PG8_STAGE(PG8_SA(0, 0), a2, voffA);
            PG8_WAIT_V(8); PG8_WAIT_L(0); PG8_BAR; PG8_MMA(1, 0, At, B0); PG8_MMA(1, 1, At, B1); PG8_BAR; PG8_SCHED;
            PG8_LDB(B0, 1, 0); PG8_LDB(B1, 1, 1); PG8_SCHED; PG8_LDA(At, 1, 0); PG8_STAGE(PG8_SA(0, 1), a2 + hstepA, voffA);
            PG8_WAIT_V(8); PG8_WAIT_L(0); PG8_BAR; PG8_MMA(0, 0, At, B0); PG8_MMA(0, 1, At, B1); PG8_BAR; PG8_SCHED;
            PG8_LDA(At, 1, 1); PG8_STAGE(PG8_SB(1, 0), b3, voffB); PG8_STAGE(PG8_SB(1, 1), b3 + hstepB, voffB); PG8_STAGE(PG8_SA(1, 0), a3, voffA);
            PG8_WAIT_V(8); PG8_WAIT_L(0); PG8_BAR; PG8_MMA(1, 0, At, B0); PG8_MMA(1, 1, At, B1); PG8_BAR; PG8_SCHED;
            } else {
            PG8_LDB(B0, 0, 0); PG8_SCHED; PG8_LDA(At, 0, 0); PG8_STAGE(PG8_SA(1, 1), a1 + hstepA, voffA);
            PG8_WAIT_L(8); PG8_BAR; PG8_WAIT_L(0); PG8_MMA(0, 0, At, B0); PG8_BAR; PG8_SCHED;
            PG8_LDB(B1, 0, 1); PG8_STAGE(PG8_SB(0, 0), b2, voffB);
            PG8_BAR; PG8_WAIT_L(0); PG8_MMA(0, 1, At, B1); PG8_BAR;
            PG8_LDA(At, 0, 1); PG8_STAGE(PG8_SA(0, 0), a2, voffA);
            PG8_BAR; PG8_WAIT_L(0); PG8_MMA(1, 0, At, B0); PG8_BAR; PG8_SCHED;
            PG8_STAGE(PG8_SB(0, 1), b2 + hstepB, voffB);
            PG8_WAIT_V(6); PG8_BAR; PG8_MMA(1, 1, At, B1); PG8_BAR;
            PG8_LDB(B0, 1, 0); PG8_SCHED; PG8_LDA(At, 1, 0); PG8_STAGE(PG8_SA(0, 1), a2 + hstepA, voffA);
            PG8_WAIT_L(8); PG8_BAR; PG8_WAIT_L(0); PG8_MMA(0, 0, At, B0); PG8_BAR; PG8_SCHED;
            PG8_LDB(B1, 1, 1); PG8_STAGE(PG8_SB(1, 0), b3, voffB);
            PG8_BAR; PG8_WAIT_L(0); PG8_MMA(0, 1, At, B1); PG8_BAR;
            PG8_LDA(At, 1, 1); PG8_STAGE(PG8_SA(1, 0), a3, voffA);
            PG8_BAR; PG8_WAIT_L(0); PG8_MMA(1, 0, At, B0); PG8_BAR; PG8_SCHED;
            PG8_STAGE(PG8_SB(1, 1), b3 + hstepB, voffB);
            PG8_WAIT_V(6); PG8_BAR; PG8_MMA(1, 1, At, B1); PG8_BAR;
            }
        }
        if constexpr (ALIGN_EPI) { if (wr == 0) PG8_BAR; }
        E(acc, cur, wr, wc, fr, fq); S.done(cur);
        if (!has_next) break;
#pragma unroll
        for (int a = 0; a < 2; ++a)
#pragma unroll
            for (int b = 0; b < 2; ++b)
#pragma unroll
                for (int m = 0; m < 4; ++m)
#pragma unroll
                    for (int n = 0; n < 2; ++n) acc[a][b][m][n] = (f32x4){0.f, 0.f, 0.f, 0.f};
        cur = nxt; cA = nA; cB = nB; ++ui;
        if constexpr (ALIGN_EPI) { if (wr == 1) PG8_BAR; }
    }
    PG8_WAIT_V(0);
    if constexpr (!ALIGN_EPI) { if (wr == 0) PG8_BAR; }
    PG8_BAR;
#undef PG8_SA
#undef PG8_SB
#undef PG8_STAGE
#undef PG8_LDA
#undef PG8_LDB
#undef PG8_MMA
#undef PG8_WAIT_V
#undef PG8_WAIT_L
#undef PG8_BAR
#undef PG8_SCHED
}
}
namespace epi {
using pg8::f32x4; using pg8::u32x4; using pg8::u32x2; using pg8::Unit; using pg8::bf16_t; using pg8::cvt_pk_bf16;
constexpr int MROWS = 16384;
constexpr float RMS_EPS = 1e-6f;
__device__ __forceinline__ float bflo(unsigned u) { return __uint_as_float(u << 16); }
__device__ __forceinline__ float bfhi(unsigned u) { return __uint_as_float(u & 0xffff0000u); }
__device__ __forceinline__ float row_rs(const float* rowss, int row, int fq) {
    float s = 0.f;
#pragma unroll
    for (int j = 0; j < 4; ++j) s += rowss[(size_t)(4 * fq + j) * MROWS + row];
    s += __shfl_xor(s, 16); s += __shfl_xor(s, 32);
    return __builtin_amdgcn_rsqf(s * (1.0f / 1024.0f) + RMS_EPS);
}
__device__ __forceinline__ float sigmoidf_(float v) { return __builtin_amdgcn_rcpf(1.0f + __builtin_amdgcn_exp2f(-1.4426950408889634f * v)); }

struct EpiSwiGLU {
    static constexpr bool PERM = true;
    bf16_t* H; int ldh; const float* rowss;
    __device__ __forceinline__ void operator()(const f32x4 (&acc)[2][2][4][2], const Unit& u, int wr, int wc, int fr, int fq) const {
        const int row0 = u.pm * 256 + wr * 64 + fr, col0 = u.pn * 128 + wc * 32 + 8 * fq;
#pragma unroll
        for (int ai = 0; ai < 2; ++ai)
#pragma unroll
            for (int m = 0; m < 4; ++m) { const int row = row0 + ai * 128 + m * 16; const float r = row_rs(rowss, row, fq);
                float h[8];
#pragma unroll
                for (int n = 0; n < 2; ++n)
#pragma unroll
                    for (int i = 0; i < 4; ++i) { const float g = acc[ai][0][m][n][i] * r, up = acc[ai][1][m][n][i] * r; h[n * 4 + i] = g * sigmoidf_(g) * up; }
                u32x4 w; w.x = cvt_pk_bf16(h[0], h[1]); w.y = cvt_pk_bf16(h[2], h[3]); w.z = cvt_pk_bf16(h[4], h[5]); w.w = cvt_pk_bf16(h[6], h[7]);
                *(u32x4*)(H + (size_t)row * ldh + col0) = w; asm volatile("" ::: "memory"); }
    }
};

struct EpiResidual {
    static constexpr bool PERM = false;
    const float* base; float* out; bf16_t* xb; float* rowss; float scale;
    __device__ __forceinline__ void operator()(const f32x4 (&acc)[2][2][4][2], const Unit& u, int wr, int wc, int fr, int fq) const {
        const int row0 = u.pm * 256 + wr * 64 + fr, col0 = u.pn * 256 + wc * 32 + 4 * fq;
#pragma unroll
        for (int ai = 0; ai < 2; ++ai)
#pragma unroll
            for (int m = 0; m < 4; ++m) { const int row = row0 + ai * 128 + m * 16; const size_t off = (size_t)row * 1024 + col0; float ss = 0.f;
#pragma unroll
                for (int bj = 0; bj < 2; ++bj)
#pragma unroll
                    for (int n = 0; n < 2; ++n) { const f32x4 b = *(const f32x4*)(base + off + bj * 128 + n * 16); const f32x4 o = b + acc[ai][bj][m][n] * scale;
                        *(f32x4*)(out + off + bj * 128 + n * 16) = o; u32x2 w; w.x = cvt_pk_bf16(o[0], o[1]); w.y = cvt_pk_bf16(o[2], o[3]);
                        *(u32x2*)(xb + off + bj * 128 + n * 16) = w; ss += (o[0] * o[0] + o[1] * o[1]) + (o[2] * o[2] + o[3] * o[3]); }
                ss += __shfl_xor(ss, 16); ss += __shfl_xor(ss, 32);
                if (fq == 0) rowss[(size_t)(u.pn * 4 + wc) * MROWS + row] = ss; asm volatile("" ::: "memory"); }
    }
};

struct EpiQKV {
    static constexpr bool PERM = true;
    bf16_t* P; int ldp; const float* rowss; const float* qk_gain  ; float* widx;
    __device__ __forceinline__ void operator()(const f32x4 (&acc)[2][2][4][2], const Unit& u, int wr, int wc, int fr, int fq) const {
        const int hidx = 4 * u.pn + wc;
        int gi = -1; float post = 1.0f;
        constexpr float C2 = 0.125f * 1.4426950408889634f;
        if (hidx < 12) { gi = 0; post = C2; } else if (hidx < 24) { gi = 1; } else if (hidx < 36) { }
        else if (hidx < 44) { gi = 2; post = C2; } else if (hidx < 52) { gi = 3; } else if (hidx < 60) { }
        else if (hidx < 64) { gi = 4; post = C2; } else if (hidx == 64) { gi = 5; } else if (hidx == 65) { }
        else if (hidx < 74) { post = 0.125f; }
        f32x4 gn[2][2];
#pragma unroll
        for (int bj = 0; bj < 2; ++bj)
#pragma unroll
            for (int n = 0; n < 2; ++n) gn[bj][n] = (gi >= 0) ? *(const f32x4*)(qk_gain + gi * 64 + 32 * bj + 8 * fq + 4 * n) : (f32x4){1.f, 1.f, 1.f, 1.f};
        const int row0 = u.pm * 256 + wr * 64 + fr, col0 = 64 * hidx + 8 * fq;
#pragma unroll
        for (int ai = 0; ai < 2; ++ai)
#pragma unroll
            for (int m = 0; m < 4; ++m) { const int row = row0 + ai * 128 + m * 16; const float r = row_rs(rowss, row, fq);
                f32x4 v[2][2]; float ss = 0.f;
#pragma unroll
                for (int bj = 0; bj < 2; ++bj)
#pragma unroll
                    for (int n = 0; n < 2; ++n) { v[bj][n] = acc[ai][bj][m][n] * r; const f32x4 t = v[bj][n]; ss += (t[0] * t[0] + t[1] * t[1]) + (t[2] * t[2] + t[3] * t[3]); }
                float mul = post;
                if (gi >= 0) { ss += __shfl_xor(ss, 16); ss += __shfl_xor(ss, 32); mul = post * __builtin_amdgcn_rsqf(ss * (1.0f / 64.0f) + RMS_EPS); }
#pragma unroll
                for (int bj = 0; bj < 2; ++bj) { const f32x4 a = v[bj][0] * gn[bj][0] * mul, b = v[bj][1] * gn[bj][1] * mul;
                    u32x4 w; w.x = cvt_pk_bf16(a[0], a[1]); w.y = cvt_pk_bf16(a[2], a[3]); w.z = cvt_pk_bf16(b[0], b[1]); w.w = cvt_pk_bf16(b[2], b[3]);
                    *(u32x4*)(P + (size_t)row * ldp + col0 + 32 * bj) = w; }
                if (hidx == 75 && fq == 0) { *(f32x4*)(widx + (size_t)row * 8) = v[0][0]; *(f32x4*)(widx + (size_t)row * 8 + 4) = v[0][1]; } asm volatile("" ::: "memory"); }
    }
};

struct EpiSigmoid {
    static constexpr bool PERM = true;
    bf16_t* G; int ldg; const float* rowss;
    __device__ __forceinline__ void operator()(const f32x4 (&acc)[2][2][4][2], const Unit& u, int wr, int wc, int fr, int fq) const {
        const int row0 = u.pm * 256 + wr * 64 + fr, col0 = u.pn * 256 + wc * 32 + 8 * fq;
#pragma unroll
        for (int ai = 0; ai < 2; ++ai)
#pragma unroll
            for (int m = 0; m < 4; ++m) { const int row = row0 + ai * 128 + m * 16; const float r = row_rs(rowss, row, fq);
#pragma unroll
                for (int bj = 0; bj < 2; ++bj) { float h[8];
#pragma unroll
                    for (int n = 0; n < 2; ++n)
#pragma unroll
                        for (int i = 0; i < 4; ++i) h[n * 4 + i] = sigmoidf_(acc[ai][bj][m][n][i] * r);
                    u32x4 w; w.x = cvt_pk_bf16(h[0], h[1]); w.y = cvt_pk_bf16(h[2], h[3]); w.z = cvt_pk_bf16(h[4], h[5]); w.w = cvt_pk_bf16(h[6], h[7]);
                    *(u32x4*)(G + (size_t)row * ldg + col0 + bj * 128) = w; } asm volatile("" ::: "memory"); }
    }
};

struct EpiMerge {
    static constexpr bool PERM = true;
    bf16_t* Y; const bf16_t* G  ; int ldg; int accum;
    __device__ __forceinline__ void operator()(const f32x4 (&acc)[2][2][4][2], const Unit& u, int wr, int wc, int fr, int fq) const {
        const int row0 = u.pm * 256 + wr * 64 + fr, col0 = u.pn * 256 + wc * 32 + 8 * fq;
#pragma unroll
        for (int ai = 0; ai < 2; ++ai)
#pragma unroll
            for (int m = 0; m < 4; ++m) { const int row = row0 + ai * 128 + m * 16;
#pragma unroll
                for (int bj = 0; bj < 2; ++bj) { const u32x4 gv = *(const u32x4*)(G + (size_t)row * ldg + col0 + bj * 128);
                    bf16_t* yp = Y + (size_t)row * 1024 + col0 + bj * 128;
                    u32x4 yo = (u32x4){0u, 0u, 0u, 0u}; if (accum) yo = *(const u32x4*)yp;
                    const f32x4 a = acc[ai][bj][m][0], b = acc[ai][bj][m][1];
                    float h[8];
                    h[0] = bflo(yo.x) + bflo(gv.x) * a[0]; h[1] = bfhi(yo.x) + bfhi(gv.x) * a[1]; h[2] = bflo(yo.y) + bflo(gv.y) * a[2]; h[3] = bfhi(yo.y) + bfhi(gv.y) * a[3];
                    h[4] = bflo(yo.z) + bflo(gv.z) * b[0]; h[5] = bfhi(yo.z) + bfhi(gv.z) * b[1]; h[6] = bflo(yo.w) + bflo(gv.w) * b[2]; h[7] = bfhi(yo.w) + bfhi(gv.w) * b[3];
                    u32x4 w; w.x = cvt_pk_bf16(h[0], h[1]); w.y = cvt_pk_bf16(h[2], h[3]); w.z = cvt_pk_bf16(h[4], h[5]); w.w = cvt_pk_bf16(h[6], h[7]);
                    *(u32x4*)yp = w; } asm volatile("" ::: "memory"); }
    }
};
}
constexpr int NWAVES = 8;
constexpr int M = 16384, D = 1024, FF = 2816, T = 4096, NLAYER = 4;
constexpr int NIN = 7880, PP = 4864  , NGATE = 3072, GATE_COL0 = 4808;
constexpr float LOG2E = 1.4426950408889634f;
constexpr size_t MiB = 1u << 20;
constexpr size_t WS_CTL = 0, CTL_ZERO_BYTES = 1 * MiB;
constexpr size_t WS_BIASD = 1 * MiB;
constexpr size_t WS_ROWSS = 1 * MiB + 512 * 1024;
constexpr size_t WS_WIDX = 2 * MiB + 512 * 1024;
constexpr size_t WS_W = 4 * MiB;
constexpr size_t O_GU1 = 0, O_DN1 = 11534336, O_QKV = 17301504, O_GATE = 27262976, O_BA = 33554432, O_BB = 34078720, O_BC = 35127296, O_OUT = 35651584, O_GU2 = 37748736, O_DN2 = 49283072, O_WEND = 55050240;
constexpr size_t WS_XB = 57 * MiB, WS_OATT = 89 * MiB, WS_Y = 121 * MiB, WS_PROJ = 153 * MiB, WS_HMID = WS_PROJ, WS_GATES = 305 * MiB, WS_END = 401 * MiB;
static_assert(WS_W + O_WEND <= WS_XB && WS_PROJ + (size_t)M * PP * 2 <= WS_GATES && WS_GATES + (size_t)M * NGATE * 2 <= WS_END, "ws map");
constexpr int CW_TMO = 0, CW_CODE = 1, CW_BAR = 4096;

constexpr int RING_OFF = 0, RING_BYTES = 131072;
constexpr int MISC_OFF = 160768, LDS_BYTES = 161792;

#define GAS __attribute__((address_space(1)))
#define LAS __attribute__((address_space(3)))
typedef unsigned short bf16;
typedef unsigned v4u __attribute__((ext_vector_type(4)));
typedef unsigned v2u __attribute__((ext_vector_type(2)));
typedef float f32x4 __attribute__((ext_vector_type(4)));
typedef GAS unsigned gu32;
#define RLX_AGENT __ATOMIC_RELAXED, __HIP_MEMORY_SCOPE_AGENT
#define LDS_WAIT() asm volatile("s_waitcnt lgkmcnt(0)" ::: "memory")
#define VM_WAIT() asm volatile("s_waitcnt vmcnt(0)" ::: "memory")
__device__ __forceinline__ float bflo(unsigned u) { return __uint_as_float(u << 16); }
__device__ __forceinline__ float bfhi(unsigned u) { return __uint_as_float(u & 0xffff0000u); }
__device__ __forceinline__ unsigned f2bf(float f) { unsigned u = __builtin_bit_cast(unsigned, f); return (u + 0x7fffu + ((u >> 16) & 1u)) >> 16; }
__device__ __forceinline__ unsigned pk2(float lo, float hi) { return f2bf(lo) | (f2bf(hi) << 16); }
__device__ __forceinline__ float wave_sum(float v) {
#pragma unroll
    for (int o = 1; o < 64; o <<= 1) v += __shfl_xor(v, o);
    return v;
}
__device__ __forceinline__ float wave_max(float v) {
#pragma unroll
    for (int o = 1; o < 64; o <<= 1) v = fmaxf(v, __shfl_xor(v, o));
    return v;
}
__device__ __forceinline__ float dot8(v4u a, v4u b) {
    return ((bflo(a.x) * bflo(b.x) + bfhi(a.x) * bfhi(b.x)) + (bflo(a.y) * bflo(b.y) + bfhi(a.y) * bfhi(b.y))) + ((bflo(a.z) * bflo(b.z) + bfhi(a.z) * bfhi(b.z)) + (bflo(a.w) * bflo(b.w) + bfhi(a.w) * bfhi(b.w)));
}
__device__ __forceinline__ float dot64(const v4u (&q)[8], const bf16* kp) {
    const v4u* k = (const v4u*)kp; float s = 0.f;
#pragma unroll
    for (int i = 0; i < 8; ++i) s += dot8(q[i], k[i]);
    return s;
}
__device__ __forceinline__ int rel_bucket(int n) {
    if (n < 16) return n;
    int b = 16 + (int)(logf((float)n / 16.0f) / logf(128.0f) * 16.0f);
    return b < 31 ? b : 31;
}

struct Args { const float* in[19]; float* out; unsigned char* ws; int lo, hi; };
struct Frame {
    LAS unsigned char* lds;
    volatile LAS unsigned* MISC;
    int tid, lane, wave, G, bx;
};

__device__ __forceinline__ void phase_prologue(Frame& F, const Args& A) {
    float* biasd = (float*)(A.ws + WS_BIASD); const float* rel_bias = A.in[1];
    for (int i = F.bx * 512 + F.tid; i < 20 * 4096; i += F.G * 512) { const int h = i >> 12, d = i & 4095; biasd[i] = rel_bias[rel_bucket(d) * 20 + h] * LOG2E; }
    const float* x = A.in[0]; bf16* xb = (bf16*)(A.ws + WS_XB); float* rowss = (float*)(A.ws + WS_ROWSS);
    const int gw = F.bx * NWAVES + F.wave, NGW = F.G * NWAVES;
    for (int m = gw; m < M; m += NGW) {
        const f32x4* xr = (const f32x4*)(x + (size_t)m * D) + F.lane; float s = 0.f;
        unsigned long long* o8 = (unsigned long long*)(xb + (size_t)m * D) + F.lane;
#pragma unroll
        for (int j = 0; j < 4; ++j) { const f32x4 v = xr[64 * j]; s += (v.x * v.x + v.y * v.y) + (v.z * v.z + v.w * v.w);
            o8[64 * j] = (unsigned long long)pk2(v.x, v.y) | ((unsigned long long)pk2(v.z, v.w) << 32); }
        s = wave_sum(s);
        if (F.lane < 16) rowss[(size_t)F.lane * M + m] = (F.lane == 0) ? s : 0.f;
    }
}

__device__ __forceinline__ void cvt_item(const float* W, int ldw, int col0, int nvalid, const float* gamma, bf16* WT, int K, int dstrow0, int k0, LAS float* scr, int lane) {
    const int c32 = lane & 31;
#pragma unroll 8
    for (int i = 0; i < 32; ++i) { const int kk = 2 * i + (lane >> 5);
        float v = 0.f; if (c32 < nvalid) v = W[(size_t)(k0 + kk) * ldw + col0 + c32];
        if (gamma) v *= gamma[k0 + kk];
        scr[kk * 33 + c32] = v; }
    LDS_WAIT(); asm volatile("" ::: "memory");
    const int c = lane & 7;
#pragma unroll
    for (int j = 0; j < 4; ++j) { const int n = (lane >> 3) + 8 * j; const LAS float* s = scr + (8 * c) * 33 + n;
        v4u o; o.x = pk2(s[0 * 33], s[1 * 33]); o.y = pk2(s[2 * 33], s[3 * 33]); o.z = pk2(s[4 * 33], s[5 * 33]); o.w = pk2(s[6 * 33], s[7 * 33]);
        *(v4u*)(WT + (size_t)(dstrow0 + n) * K + k0 + 8 * c) = o; }
    LDS_WAIT(); asm volatile("" ::: "memory");
}
__device__ __forceinline__ void phase_convert(Frame& F, const Args& A, int L) {
    int lane_ = F.lane; asm volatile("" : "+v"(lane_)); const int lane = lane_;
    LAS float* scr = (LAS float*)(F.lds + RING_OFF + F.wave * 16384);
    const int gw = F.bx * NWAVES + F.wave, NGW = F.G * NWAVES;
    unsigned char* wb = A.ws + WS_W;
    constexpr int I0 = 2816, I1 = 1408, I2 = 2432, I3 = 1536, I4 = 128, I5 = 256, I6 = 128, I7 = 512, I8 = 2816, I9 = 1408;
    constexpr int NITEMS = I0 + I1 + I2 + I3 + I4 + I5 + I6 + I7 + I8 + I9;
    for (int it = gw; it < NITEMS; it += NGW) {
        int r = it;
        if (r < I0 || (r >= I0 + I1 + I2 + I3 + I4 + I5 + I6 + I7 && r < NITEMS - I9)) {
            const bool second = r >= I0; if (second) r -= (I0 + I1 + I2 + I3 + I4 + I5 + I6 + I7);
            const int kb = r / 176, nb = r % 176, n0 = 32 * nb, tile = n0 >> 8, l = n0 & 255;
            const float* Wg = (second ? A.in[16] : A.in[3]) + (size_t)L * D * FF; const float* Wu = (second ? A.in[17] : A.in[4]) + (size_t)L * D * FF;
            const float* gam = (second ? A.in[15] : A.in[2]) + (size_t)L * D;
            cvt_item(l < 128 ? Wg : Wu, FF, 128 * tile + (l & 127), 32, gam, (bf16*)(wb + (second ? O_GU2 : O_GU1)), D, n0, 64 * kb, scr, lane);
            continue; }
        r -= I0;
        if (r < I1) { const int kb = r / 32, nb = r % 32; cvt_item(A.in[5] + (size_t)L * FF * D, D, 32 * nb, 32, nullptr, (bf16*)(wb + O_DN1), FF, 32 * nb, 64 * kb, scr, lane); continue; } r -= I1;
        if (r < I2) { const int kb = r / 152, nb = r % 152, n0 = 32 * nb, tile = n0 >> 8, l = n0 & 255, bj = l >> 7, wc = (l & 127) >> 5, col0 = 256 * tile + 64 * wc + 32 * bj;
            int nv = 4808 - col0; nv = nv < 0 ? 0 : (nv > 32 ? 32 : nv);
            cvt_item(A.in[7] + (size_t)L * D * NIN, NIN, col0, nv, A.in[6] + (size_t)L * D, (bf16*)(wb + O_QKV), D, n0, 64 * kb, scr, lane); continue; } r -= I2;
        if (r < I3) { const int kb = r / 96, nb = r % 96; cvt_item(A.in[7] + (size_t)L * D * NIN, NIN, GATE_COL0 + 32 * nb, 32, A.in[6] + (size_t)L * D, (bf16*)(wb + O_GATE), D, 32 * nb, 64 * kb, scr, lane); continue; } r -= I3;
        if (r < I4) { const int kb = r / 32, nb = r % 32; cvt_item(A.in[11] + (size_t)L * 256 * D, D, 32 * nb, 32, nullptr, (bf16*)(wb + O_BA), 256, 32 * nb, 64 * kb, scr, lane); continue; } r -= I4;
        if (r < I5) { const int kb = r / 32, nb = r % 32; cvt_item(A.in[12] + (size_t)L * 512 * D, D, 32 * nb, 32, nullptr, (bf16*)(wb + O_BB), 512, 32 * nb, 64 * kb, scr, lane); continue; } r -= I5;
        if (r < I6) { const int kb = r / 32, nb = r % 32; cvt_item(A.in[13] + (size_t)L * 256 * D, D, 32 * nb, 32, nullptr, (bf16*)(wb + O_BC), 256, 32 * nb, 64 * kb, scr, lane); continue; } r -= I6;
        if (r < I7) { const int kb = r / 32, nb = r % 32; cvt_item(A.in[14] + (size_t)L * D * D, D, 32 * nb, 32, nullptr, (bf16*)(wb + O_OUT), D, 32 * nb, 64 * kb, scr, lane); continue; } r -= I7;
        r -= I8;
        { const int kb = r / 32, nb = r % 32; cvt_item(A.in[18] + (size_t)L * FF * D, D, 32 * nb, 32, nullptr, (bf16*)(wb + O_DN2), FF, 32 * nb, 64 * kb, scr, lane); }
    }
}

constexpr int COL_AQ = 0, COL_AK = 768, COL_AV = 1536, COL_BQ = 2304, COL_BK = 2816, COL_BV = 3328, COL_CQ = 3840, COL_CK = 4096, COL_CV = 4160, COL_IQ = 4224, COL_IK = 4736;
__device__ __forceinline__ void load_q(v4u (&q)[8], const bf16* p) {
#pragma unroll
    for (int i = 0; i < 8; ++i) q[i] = ((const v4u*)p)[i];
}
__device__ __forceinline__ void oracle_A(unsigned char* ws, int gw, int NGW, int lane) {
    const bf16* P = (const bf16*)(ws + WS_PROJ); const float* biasd = (const float*)(ws + WS_BIASD); bf16* O = (bf16*)(ws + WS_OATT);
    for (int it = gw; it < M * 4; it += NGW) {
        const int row = it >> 2, hs = it & 3, b = row >> 12, t = row & 4095;
        float mrun = -INFINITY, l = 0.f, o = 0.f;
        for (int g = 0; g < 3; ++g) {
            const int dil = (g == 0) ? 1 : (g == 1 ? 4 : 16), head = 4 * g + hs, i = t / dil, r = t % dil;
            v4u q[8]; load_q(q, P + (size_t)row * PP + COL_AQ + head * 64);
            const int jlo = (i - 128) < 0 ? 0 : (i - 128), nk = i - jlo + 1;
            for (int c0 = 0; c0 < nk; c0 += 64) {
                const int jj = c0 + lane; const bool valid = jj < nk; const int j = jlo + (valid ? jj : 0);
                const size_t krow = (size_t)b * T + (size_t)j * dil + r;
                float s = -INFINITY;
                if (valid) s = dot64(q, P + krow * PP + COL_AK + head * 64) + biasd[head * 4096 + (i - j) * dil];
                const float mnew = fmaxf(mrun, wave_max(s)); const float alpha = __builtin_amdgcn_exp2f(mrun - mnew);
                const float p = valid ? __builtin_amdgcn_exp2f(s - mnew) : 0.f;
                l = l * alpha + wave_sum(p); o *= alpha; mrun = mnew;
                const int kn = (nk - c0) < 64 ? (nk - c0) : 64;
                for (int kk = 0; kk < kn; ++kk) { const float pk = __shfl(p, kk); const size_t vrow = (size_t)b * T + (size_t)(jlo + c0 + kk) * dil + r;
                    o += pk * bflo((unsigned)P[vrow * PP + COL_AV + head * 64 + lane]); }
            }
        }
        O[(size_t)row * 1024 + hs * 64 + lane] = (bf16)f2bf(o / l);
    }
}
__device__ __forceinline__ void oracle_B_map(const bf16* P, const float* biasd, int row, int h, int mp, int lane, float& r0, float& r1) {
    const int b = row >> 12, t = row & 4095;
    v4u q[8]; load_q(q, P + (size_t)row * PP + COL_BQ + (mp * 4 + h) * 64);
    float mrun = -INFINITY, l = 0.f, o0 = 0.f, o1 = 0.f;
    for (int c0 = 0; c0 <= t; c0 += 64) {
        const int j = c0 + lane; const bool valid = j <= t; const size_t krow = (size_t)b * T + (valid ? j : 0);
        float s = -INFINITY;
        if (valid) s = dot64(q, P + krow * PP + COL_BK + (mp * 4 + h) * 64) + biasd[(12 + h) * 4096 + (t - j)];
        const float mnew = fmaxf(mrun, wave_max(s)); const float alpha = __builtin_amdgcn_exp2f(mrun - mnew);
        const float p = valid ? __builtin_amdgcn_exp2f(s - mnew) : 0.f;
        l = l * alpha + wave_sum(p); o0 *= alpha; o1 *= alpha; mrun = mnew;
        const int kn = (t + 1 - c0) < 64 ? (t + 1 - c0) : 64;
        for (int kk = 0; kk < kn; ++kk) { const float pk = __shfl(p, kk); const bf16* vp = P + ((size_t)b * T + c0 + kk) * PP + COL_BV + h * 128;
            o0 += pk * bflo((unsigned)vp[lane]); o1 += pk * bflo((unsigned)vp[64 + lane]); }
    }
    r0 = o0 / l; r1 = o1 / l;
}
__device__ __forceinline__ void oracle_B(unsigned char* ws, int gw, int NGW, const float* lv, const float* dn, int L, int lane) {
    const bf16* P = (const bf16*)(ws + WS_PROJ); const float* biasd = (const float*)(ws + WS_BIASD); bf16* O = (bf16*)(ws + WS_OATT);
    const float lam_init = 0.8f - 0.6f * expf(-0.3f * (float)L);
    const float lam = expf(wave_sum(lv[lane] * lv[64 + lane])) - expf(wave_sum(lv[128 + lane] * lv[192 + lane])) + lam_init;
    for (int it = gw; it < M * 4; it += NGW) {
        const int row = it >> 2, h = it & 3;
        float a0, a1, b0, b1;
        oracle_B_map(P, biasd, row, h, 0, lane, a0, a1);
        oracle_B_map(P, biasd, row, h, 1, lane, b0, b1);
        const float d0 = a0 - lam * b0, d1 = a1 - lam * b1;
        const float inv = __builtin_amdgcn_rsqf(wave_sum(d0 * d0 + d1 * d1) * (1.0f / 128.0f) + 1e-6f) * (1.0f - lam_init);
        O[(size_t)row * 1024 + 256 + h * 128 + lane] = (bf16)f2bf(d0 * inv * dn[lane]);
        O[(size_t)row * 1024 + 256 + h * 128 + 64 + lane] = (bf16)f2bf(d1 * inv * dn[64 + lane]);
    }
}
__device__ __forceinline__ void oracle_C(unsigned char* ws, int gw, int NGW, LAS unsigned char* ldsw, int lane) {
    const bf16* P = (const bf16*)(ws + WS_PROJ); const float* biasd = (const float*)(ws + WS_BIASD); bf16* O = (bf16*)(ws + WS_OATT);
    const float* widx = (const float*)(ws + WS_WIDX);
    LAS float* sc = (LAS float*)(ldsw);
    LAS unsigned short* sel = (LAS unsigned short*)(ldsw + 16384);
    LAS float* qi = (LAS float*)(ldsw + 16384 + 512);
    for (int row = gw; row < M; row += NGW) {
        const int b = row >> 12, t = row & 4095, N = t + 1;
#pragma unroll
        for (int i = 0; i < 8; ++i) qi[i * 64 + lane] = bflo((unsigned)P[(size_t)row * PP + COL_IQ + i * 64 + lane]);
        float w[8];
#pragma unroll
        for (int h = 0; h < 8; ++h) w[h] = widx[(size_t)row * 8 + h] * 0.35355339059327373f;
        LDS_WAIT();
#pragma unroll 1
        for (int c0 = 0; c0 < N; c0 += 64) {
            const int j = c0 + lane; const bool valid = j < N;
            const v4u* kp = (const v4u*)(P + ((size_t)b * T + (valid ? j : 0)) * PP + COL_IK);
            float dsum[8];
#pragma unroll
            for (int h = 0; h < 8; ++h) dsum[h] = 0.f;
#pragma unroll 2
            for (int i = 0; i < 8; ++i) { const v4u kv = kp[i];
                const float k0 = bflo(kv.x), k1 = bfhi(kv.x), k2 = bflo(kv.y), k3 = bfhi(kv.y), k4 = bflo(kv.z), k5 = bfhi(kv.z), k6 = bflo(kv.w), k7 = bfhi(kv.w);
#pragma unroll
                for (int h = 0; h < 8; ++h) { const f32x4 qa = *(const LAS f32x4*)(qi + h * 64 + i * 8), qb = *(const LAS f32x4*)(qi + h * 64 + i * 8 + 4);
                    dsum[h] += ((qa.x * k0 + qa.y * k1) + (qa.z * k2 + qa.w * k3)) + ((qb.x * k4 + qb.y * k5) + (qb.z * k6 + qb.w * k7)); } }
            float score = 0.f;
#pragma unroll
            for (int h = 0; h < 8; ++h) score += w[h] * fmaxf(dsum[h], 0.f);
            if (j < 4096) sc[j] = valid ? score : -INFINITY;
        }
        LDS_WAIT();
        int cnt = 0;
        if (N <= 256) { for (int n = lane; n < N; n += 64) sel[n] = (unsigned short)n; cnt = N; }
        else {
            const int N4 = (N + 3) & ~3;
#pragma unroll 1
            for (int c0 = 0; c0 < N; c0 += 64) {
                const int j = c0 + lane; const bool valid = j < N; const float sj = valid ? sc[j] : INFINITY;
                int rank = 0;
                for (int jp = 0; jp < N4; jp += 4) { const f32x4 v = *(const LAS f32x4*)(sc + jp);
                    rank += (v.x > sj || (v.x == sj && jp < j)) ? 1 : 0; rank += (v.y > sj || (v.y == sj && jp + 1 < j)) ? 1 : 0;
                    rank += (v.z > sj || (v.z == sj && jp + 2 < j)) ? 1 : 0; rank += (v.w > sj || (v.w == sj && jp + 3 < j)) ? 1 : 0; }
                const bool s = valid && rank < 256;
                const unsigned long long bal = __ballot(s);
                const int pos = cnt + __popcll(bal & ((1ull << lane) - 1ull));
                if (s && pos < 256) sel[pos] = (unsigned short)j;
                cnt += __popcll(bal);
            }
            cnt = cnt > 256 ? 256 : cnt;
        }
        LDS_WAIT();
#pragma unroll 1
        for (int h = 0; h < 4; ++h) {
            v4u q[8]; load_q(q, P + (size_t)row * PP + COL_CQ + h * 64);
            float s[4]; float mx = -INFINITY;
#pragma unroll
            for (int c = 0; c < 4; ++c) { const int n = lane + 64 * c; const bool valid = n < cnt; const int key = valid ? (int)sel[n] : 0;
                s[c] = valid ? dot64(q, P + ((size_t)b * T + key) * PP + COL_CK) + biasd[(16 + h) * 4096 + (t - key)] : -INFINITY; mx = fmaxf(mx, s[c]); }
            mx = wave_max(mx);
            float p[4], ls = 0.f;
#pragma unroll
            for (int c = 0; c < 4; ++c) { p[c] = (lane + 64 * c < cnt) ? __builtin_amdgcn_exp2f(s[c] - mx) : 0.f; ls += p[c]; }
            ls = wave_sum(ls);
            float o = 0.f;
#pragma unroll
            for (int c = 0; c < 4; ++c) { const int kn = (cnt - 64 * c) < 64 ? (cnt - 64 * c) : 64;
                for (int kk = 0; kk < kn; ++kk) { const float pk = __shfl(p[c], kk); const int key = (int)sel[64 * c + kk];
                    o += pk * bflo((unsigned)P[((size_t)b * T + key) * PP + COL_CV + lane]); } }
            O[(size_t)row * 1024 + 768 + h * 64 + lane] = (bf16)f2bf(o / ls);
        }
        LDS_WAIT();
    }
}
#define XB_TMO      128
#define XB_XCNT(j)  (256  + 64 * (j))
#define XB_XSUB(j)  (1280 + 64 * (j))
#define XB_XGEN(j)  (2304 + 64 * (j))
#define XB_TOP      3328
#define XB_TOPGEN   3392
#define XCD_BAR_WORDS 3456
#define XB_SPIN_CAP (1u << 24)

__device__ __forceinline__ unsigned xb_ld(unsigned* p)              { return __hip_atomic_load(p, __ATOMIC_RELAXED, __HIP_MEMORY_SCOPE_AGENT); }
__device__ __forceinline__ unsigned xb_add(unsigned* p, unsigned v) { return __hip_atomic_fetch_add(p, v, __ATOMIC_RELAXED, __HIP_MEMORY_SCOPE_AGENT); }
__device__ __forceinline__ unsigned xb_xcc_id() { return (unsigned)__builtin_amdgcn_s_getreg((3 << 11) | 20) & 0xFu; }
#define XB_SPIN(cond, bar) do { unsigned _sp = 0; while (cond) { __builtin_amdgcn_s_sleep(1); \
    if ((++_sp & 255u) == 0u) { if (xb_ld(&(bar)[XB_TMO])) break; if (_sp > XB_SPIN_CAP) { atomicAdd(&(bar)[XB_TMO], 1u); break; } } } } while (0)

struct XcdBarrier {
    unsigned* bar; unsigned x;
    volatile LAS unsigned* st;
};

__device__ __forceinline__ XcdBarrier xcd_barrier_post(unsigned* bar, volatile LAS unsigned* st) {
    XcdBarrier b; b.bar = bar; b.x = xb_xcc_id(); b.st = st;
    if (threadIdx.x == 0) (void)xb_add(&bar[XB_XCNT(b.x)], 1u);
    return b;
}
__device__ __forceinline__ void xcd_barrier_complete(unsigned* bar, unsigned x, unsigned& nloc, unsigned& nx) {
    const unsigned G = gridDim.x * gridDim.y * gridDim.z;
    unsigned sum, cnt, mine, sp = 0u;
    for (;;) {
        sum = 0u; cnt = 0u; mine = 0u;
#pragma unroll
        for (unsigned j = 0; j < 16; ++j) { const unsigned c = xb_ld(&bar[XB_XCNT(j)]); sum += c; cnt += (c > 0u) ? 1u : 0u; mine = (j == x) ? c : mine; }
        if (sum == G) break;
        __builtin_amdgcn_s_sleep(1);
        if ((++sp & 255u) == 0u) { if (xb_ld(&bar[XB_TMO])) break; if (sp > XB_SPIN_CAP) { atomicAdd(&bar[XB_TMO], 1u); break; } }
    }
    nloc = mine > 0u ? mine : 1u; nx = cnt > 0u ? cnt : 1u;
}

__device__ __forceinline__ void xcd_barrier(const XcdBarrier& b) {
    asm volatile("s_waitcnt vmcnt(0)" ::: "memory");
    __syncthreads();
    if (threadIdx.x == 0) {
        unsigned* bar = b.bar;
        __builtin_amdgcn_s_waitcnt(0);
        unsigned nloc = b.st[0], nx = b.st[1];
        if (nloc == 0u) { xcd_barrier_complete(bar, b.x, nloc, nx); b.st[0] = nloc; b.st[1] = nx; }
        const unsigned old = xb_add(&bar[XB_XSUB(b.x)], 1u);
        const unsigned gen = old / nloc;
        if (old + 1u == (gen + 1u) * nloc) {
            __builtin_amdgcn_fence(__ATOMIC_RELEASE, "agent");
            asm volatile("s_waitcnt vmcnt(0)" ::: "memory");
            const unsigned og = xb_add(&bar[XB_TOP], 1u);
            const unsigned tg = og / nx;
            if (og + 1u == (tg + 1u) * nx) xb_add(&bar[XB_TOPGEN], 1u);
            else XB_SPIN(xb_ld(&bar[XB_TOPGEN]) == tg, bar);
            __builtin_amdgcn_fence(__ATOMIC_ACQUIRE, "agent");
            xb_add(&bar[XB_XGEN(b.x)], 1u);
            asm volatile("s_waitcnt vmcnt(0)" ::: "memory");
        } else {
            XB_SPIN(xb_ld(&bar[XB_XGEN(b.x)]) == gen, bar);
            __builtin_amdgcn_fence(__ATOMIC_ACQUIRE, "agent");
            asm volatile("s_waitcnt vmcnt(0)" ::: "memory");
        }
    }
    __syncthreads();
}
#ifndef MODE4_FILTER
#define MODE4_FILTER 1
#endif
#ifndef MODE6_ONLY
#define MODE6_ONLY -1
#endif
__device__ __forceinline__ void chk_put2(unsigned char* ws, float d2, float r2) { if ((threadIdx.x & 63) == 0) { atomicAdd((float*)(ws + WS_CTL) + 8, d2); atomicAdd((float*)(ws + WS_CTL) + 9, r2); } }
__device__ __forceinline__ float row_r_from(const float* xrow, int lane) {
    float s = 0.f; for (int j = 0; j < 16; ++j) { const float v = xrow[lane + 64 * j]; s += v * v; }
    return 1.0f / sqrtf(wave_sum(s) * (1.0f / 1024.0f) + 1e-6f);
}
__global__ void __launch_bounds__(256) k_check(Args A, int mode, int L) {
    const int lane = threadIdx.x & 63, gw = blockIdx.x * 4 + (threadIdx.x >> 6), NGW = gridDim.x * 4;
    unsigned char* ws = A.ws;
    const bf16* HMID = (const bf16*)(ws + WS_HMID); const bf16* PROJ = (const bf16*)(ws + WS_PROJ); const bf16* GATES = (const bf16*)(ws + WS_GATES);
    const bf16* OATT = (const bf16*)(ws + WS_OATT); const bf16* Y = (const bf16*)(ws + WS_Y); const bf16* XB = (const bf16*)(ws + WS_XB); const float* ROWSS = (const float*)(ws + WS_ROWSS);
    for (int s = gw; s < 8192; s += NGW) {
        const int row = (int)(((unsigned)s * 2654435761u) >> 18) & 16383;
        if (mode == 1) {
            const float* x = A.in[0] + (size_t)row * D; const float r = row_r_from(x, lane); const float* gam = A.in[2] + (size_t)L * D;
            const int c = (s * 37) % FF; const float* Wg = A.in[3] + (size_t)L * D * FF; const float* Wu = A.in[4] + (size_t)L * D * FF;
            float g = 0.f, u = 0.f;
            for (int j = 0; j < 16; ++j) { const int k = lane + 64 * j; const float xn = x[k] * r * gam[k]; g += xn * Wg[(size_t)k * FF + c]; u += xn * Wu[(size_t)k * FF + c]; }
            g = wave_sum(g); u = wave_sum(u);
            const float ref = g / (1.0f + expf(-g)) * u, mine = bflo((unsigned)HMID[(size_t)row * FF + c]);
            chk_put2(ws, (mine - ref) * (mine - ref), ref * ref);
        } else if (mode == 2) {
            const int c = (s * 37) % D; const float* Wd = A.in[5] + (size_t)L * FF * D;
            float a = 0.f;
            for (int j = lane; j < FF; j += 64) a += bflo((unsigned)HMID[(size_t)row * FF + j]) * Wd[(size_t)j * D + c];
            a = wave_sum(a);
            const float ref = A.in[0][(size_t)row * D + c] + 0.5f * a, mine = A.out[(size_t)row * D + c];
            float d2 = (mine - ref) * (mine - ref);
            const float xbv = bflo((unsigned)XB[(size_t)row * D + c]); d2 += (xbv - mine) * (xbv - mine);
            float ss = 0.f; for (int j = 0; j < 16; ++j) { const float v = A.out[(size_t)row * D + lane + 64 * j]; ss += v * v; } ss = wave_sum(ss);
            float ps = 0.f; if (lane < 16) ps = ROWSS[(size_t)lane * M + row]; ps = wave_sum(ps);
            d2 += (ps - ss) * (ps - ss) / (ss * ss) * ref * ref;
            chk_put2(ws, d2, ref * ref);
        } else if (mode == 3) {
            const int hidx = (s * 13) % 75; const float* x = A.out + (size_t)row * D; const float r = row_r_from(x, lane); const float* gam = A.in[6] + (size_t)L * D;
            const float* W = A.in[7] + (size_t)L * D * NIN; const int c = 64 * hidx + lane;
            float a = 0.f; for (int k = 0; k < D; ++k) a += x[k] * r * gam[k] * W[(size_t)k * NIN + c];
            int gi = -1; float post = 1.f; const float C2 = 0.125f * LOG2E;
            if (hidx < 12) { gi = 0; post = C2; } else if (hidx < 24) gi = 1; else if (hidx < 36) {} else if (hidx < 44) { gi = 2; post = C2; } else if (hidx < 52) gi = 3; else if (hidx < 60) {}
            else if (hidx < 64) { gi = 4; post = C2; } else if (hidx == 64) gi = 5; else if (hidx == 65) {} else if (hidx < 74) post = 0.125f;
            float ref = a * post;
            if (gi >= 0) { const float ms = wave_sum(a * a) * (1.0f / 64.0f); ref = a / sqrtf(ms + 1e-6f) * (A.in[8] + (size_t)L * 384)[gi * 64 + lane] * post; }
            const float mine = bflo((unsigned)PROJ[(size_t)row * PP + c]);
            chk_put2(ws, wave_sum((mine - ref) * (mine - ref)), wave_sum(ref * ref));
        } else if (mode == 4) {
            const float* x = A.out + (size_t)row * D; const float r = row_r_from(x, lane); const float* gam = A.in[6] + (size_t)L * D;
            const float* W = A.in[7] + (size_t)L * D * NIN; const int c = ((s * 29) % 48) * 64 + lane;
            float a = 0.f; for (int k = 0; k < D; ++k) a += x[k] * r * gam[k] * W[(size_t)k * NIN + GATE_COL0 + c];
            float ref = 1.0f / (1.0f + expf(-a)), mine = bflo((unsigned)GATES[(size_t)row * NGATE + c]);
            if (!(MODE4_FILTER)) { ref = 0.f; mine = 0.f; }
#ifdef MODE4_HALF
            mine = mine - 0.5f + ref;
#endif
            chk_put2(ws, wave_sum((mine - ref) * (mine - ref)), wave_sum(ref * ref));
        } else if (mode == 5) {
            const int c = ((s * 29) % 16) * 64 + lane;
            const float* Wa = A.in[11] + (size_t)L * 256 * D; const float* Wb = A.in[12] + (size_t)L * 512 * D; const float* Wc = A.in[13] + (size_t)L * 256 * D;
            float ya = 0.f, yb = 0.f, yc = 0.f;
            for (int j = 0; j < 256; ++j) ya += bflo((unsigned)OATT[(size_t)row * 1024 + j]) * Wa[(size_t)j * D + c];
            for (int j = 0; j < 512; ++j) yb += bflo((unsigned)OATT[(size_t)row * 1024 + 256 + j]) * Wb[(size_t)j * D + c];
            for (int j = 0; j < 256; ++j) yc += bflo((unsigned)OATT[(size_t)row * 1024 + 768 + j]) * Wc[(size_t)j * D + c];
            const float ref = bflo((unsigned)GATES[(size_t)row * NGATE + c]) * ya + bflo((unsigned)GATES[(size_t)row * NGATE + 1024 + c]) * yb + bflo((unsigned)GATES[(size_t)row * NGATE + 2048 + c]) * yc;
            const float mine = bflo((unsigned)Y[(size_t)row * 1024 + c]);
            chk_put2(ws, wave_sum((mine - ref) * (mine - ref)), wave_sum(ref * ref));
        } else if (mode == 6) {
            const int id = s % 10; const unsigned hsh = ((unsigned)s * 64u + (unsigned)lane) * 2246822519u; const unsigned char* wb = ws + WS_W;
            float ref = 0.f, mine = 0.f;
            if (id == 0 || id == 8) { const int n = (hsh >> 8) % 5632, k = (hsh >> 21) % 1024, tile = n >> 8, l = n & 255; const bool second = id == 8;
                const float* W = (l < 128) ? (second ? A.in[16] : A.in[3]) : (second ? A.in[17] : A.in[4]); const float* gam = second ? A.in[15] : A.in[2];
                ref = W[(size_t)L * D * FF + (size_t)k * FF + 128 * tile + (l & 127)] * gam[(size_t)L * D + k]; mine = bflo((unsigned)((const bf16*)(wb + (second ? O_GU2 : O_GU1)))[(size_t)n * D + k]); }
            else if (id == 1 || id == 9) { const int n = (hsh >> 8) % 1024, k = (hsh >> 19) % FF; const float* W = (id == 9) ? A.in[18] : A.in[5];
                ref = W[(size_t)L * FF * D + (size_t)k * D + n]; mine = bflo((unsigned)((const bf16*)(wb + (id == 9 ? O_DN2 : O_DN1)))[(size_t)n * FF + k]); }
            else if (id == 2) { const int n = (hsh >> 8) % 4864, k = (hsh >> 21) % 1024, tile = n >> 8, l = n & 255, bj = l >> 7, wc = (l & 127) >> 5, col = 256 * tile + 64 * wc + 32 * bj + (l & 31);
                ref = (col < 4808) ? A.in[7][(size_t)L * D * NIN + (size_t)k * NIN + col] * A.in[6][(size_t)L * D + k] : 0.f; mine = bflo((unsigned)((const bf16*)(wb + O_QKV))[(size_t)n * D + k]); }
            else if (id == 3) { const int n = (hsh >> 8) % 3072, k = (hsh >> 21) % 1024;
                ref = A.in[7][(size_t)L * D * NIN + (size_t)k * NIN + GATE_COL0 + n] * A.in[6][(size_t)L * D + k]; mine = bflo((unsigned)((const bf16*)(wb + O_GATE))[(size_t)n * D + k]); }
            else if (id == 4 || id == 6) { const int n = (hsh >> 8) % 1024, k = (hsh >> 19) % 256; const float* W = (id == 4) ? A.in[11] : A.in[13];
                ref = W[(size_t)L * 256 * D + (size_t)k * D + n]; mine = bflo((unsigned)((const bf16*)(wb + (id == 4 ? O_BA : O_BC)))[(size_t)n * 256 + k]); }
            else if (id == 5) { const int n = (hsh >> 8) % 1024, k = (hsh >> 19) % 512; ref = A.in[12][(size_t)L * 512 * D + (size_t)k * D + n]; mine = bflo((unsigned)((const bf16*)(wb + O_BB))[(size_t)n * 512 + k]); }
            else { const int n = (hsh >> 8) % 1024, k = (hsh >> 19) % 1024; ref = A.in[14][(size_t)L * D * D + (size_t)k * D + n]; mine = bflo((unsigned)((const bf16*)(wb + O_OUT))[(size_t)n * D + k]); }
            if (MODE6_ONLY >= 0 && id != MODE6_ONLY) { ref = 0.f; mine = 0.f; }
            chk_put2(ws, wave_sum((mine - ref) * (mine - ref)), wave_sum(ref * ref));
        } else { chk_put2(ws, 1.0f, 1.0f); }
    }
}
__global__ void __launch_bounds__(256) k_report(unsigned char* ws, float* out) {
    const float sd = ((const float*)(ws + WS_CTL))[8], sr = ((const float*)(ws + WS_CTL))[9]; const float v = sqrtf(sd / fmaxf(sr, 1e-30f)); const float K = 1.0e5f * fminf(v, 1.0e3f);
    for (size_t i = (size_t)blockIdx.x * 256 + threadIdx.x; i < (size_t)M * D; i += (size_t)gridDim.x * 256) out[i] = K;
}
#ifndef GATE_ALIGN
#define GATE_ALIGN true
#endif
#ifndef MERGE_CALLS
#define MERGE_CALLS 3
#endif
#ifndef ORACLE_MASK
#define ORACLE_MASK 7
#endif
#ifndef PHASE_MASK
#define PHASE_MASK 0x1ff
#endif
constexpr int NPH_LAYER = 9, NPHASE = 1 + NLAYER * NPH_LAYER;
__global__ void __launch_bounds__(NWAVES * 64, 2) mk_fwd(const Args A) {
    extern __shared__ __attribute__((aligned(16))) unsigned char lds[];
    Frame F;
    F.lds = (LAS unsigned char*)lds;
    F.MISC = (volatile LAS unsigned*)(F.lds + MISC_OFF);
    F.tid = threadIdx.x; F.lane = F.tid & 63; F.wave = __builtin_amdgcn_readfirstlane(F.tid >> 6);
    F.G = gridDim.x; F.bx = blockIdx.x;
    gu32* const ctl = (gu32*)(A.ws + WS_CTL);
    for (int u = F.tid; u < (LDS_BYTES - MISC_OFF) / 4; u += NWAVES * 64) ((LAS unsigned*)(F.lds + MISC_OFF))[u] = 0u;
    __syncthreads();
    const int lo = A.lo, hi = A.hi;
    XcdBarrier bar; bar.bar = (unsigned*)(ctl + CW_BAR); bar.x = 0; bar.st = nullptr;
    if (hi - lo > 1) bar = xcd_barrier_post((unsigned*)(ctl + CW_BAR), F.MISC + 8);
#define IN(k) (lo <= (k) && (k) < hi)
#define SEAM(k) do { if (IN(k) && IN((k) + 1)) xcd_barrier(bar); } while (0)
    bf16* const XB = (bf16*)(A.ws + WS_XB); bf16* const PROJ = (bf16*)(A.ws + WS_PROJ); bf16* const HMID = (bf16*)(A.ws + WS_HMID); bf16* const GATES = (bf16*)(A.ws + WS_GATES);
    bf16* const OATT = (bf16*)(A.ws + WS_OATT); bf16* const Y = (bf16*)(A.ws + WS_Y); float* const ROWSS = (float*)(A.ws + WS_ROWSS); float* const WIDX = (float*)(A.ws + WS_WIDX);
    unsigned char* const wb = A.ws + WS_W;

    if (IN(0)) { phase_prologue(F, A); } SEAM(0);

    for (int L = 0; L < NLAYER; ++L) {
        const int g0 = 1 + L * NPH_LAYER;
        if (hi <= g0 || lo >= g0 + NPH_LAYER) continue;
        if (((PHASE_MASK >> 0) & 1) && IN(g0 + 0)) { phase_convert(F, A, L); } SEAM(g0 + 0);
        if (((PHASE_MASK >> 1) & 1) && IN(g0 + 1)) {
            pg8::Gemm g{XB, (const bf16*)(wb + O_GU1), M, 2 * FF, D, D}; pg8::StaticOrder S; S.init(M, 2 * FF, F.G, F.bx);
            epi::EpiSwiGLU E{HMID, FF, ROWSS};
            pg8::gemm_phase<epi::EpiSwiGLU, pg8::StaticOrder, true, true>(F.lds + RING_OFF, g, S, E);
        } SEAM(g0 + 1);
        if (((PHASE_MASK >> 2) & 1) && IN(g0 + 2)) {
            pg8::Gemm g{HMID, (const bf16*)(wb + O_DN1), M, D, FF, FF}; pg8::StaticOrder S; S.init(M, D, F.G, F.bx);
            epi::EpiResidual E{(L == 0) ? A.in[0] : (const float*)A.out, A.out, XB, ROWSS, 0.5f};
            pg8::gemm_phase<epi::EpiResidual, pg8::StaticOrder, false, true>(F.lds + RING_OFF, g, S, E);
        } SEAM(g0 + 2);
        if (((PHASE_MASK >> 3) & 1) && IN(g0 + 3)) {
            pg8::Gemm g{XB, (const bf16*)(wb + O_QKV), M, PP, D, D}; pg8::StaticOrder S; S.init(M, PP, F.G, F.bx);
            epi::EpiQKV E{PROJ, PP, ROWSS, A.in[8] + (size_t)L * 384, WIDX};
            pg8::gemm_phase<epi::EpiQKV, pg8::StaticOrder, true, true>(F.lds + RING_OFF, g, S, E);
        } SEAM(g0 + 3);
        if (((PHASE_MASK >> 4) & 1) && IN(g0 + 4)) {
            { pg8::Gemm g{XB, (const bf16*)(wb + O_GATE), M, NGATE, D, D}; pg8::StaticOrder S; S.init(M, NGATE, F.G, F.bx);
              epi::EpiSigmoid E{GATES, NGATE, ROWSS};
              pg8::gemm_phase<epi::EpiSigmoid, pg8::StaticOrder, GATE_ALIGN, true>(F.lds + RING_OFF, g, S, E); }
            __syncthreads();
#if MK_N_LAUNCHES == 1 && !defined(CHECK_MODE)
            { int ln_ = F.lane; asm volatile("" : "+v"(ln_));
              oracle_A(A.ws, F.bx * NWAVES + F.wave, F.G * NWAVES, ln_);
              oracle_B(A.ws, F.bx * NWAVES + F.wave, F.G * NWAVES, A.in[9] + (size_t)L * 256, A.in[10] + (size_t)L * 128, L, ln_);
              oracle_C(A.ws, F.bx * NWAVES + F.wave, F.G * NWAVES, F.lds + F.wave * 18944, ln_); }
#endif
            __syncthreads();
        } SEAM(g0 + 4);
        if (((PHASE_MASK >> 5) & 1) && IN(g0 + 5)) {
            pg8::StaticOrder S; S.init(M, D, F.G, F.bx);
            { pg8::Gemm g{OATT, (const bf16*)(wb + O_BA), M, D, 256, 1024}; epi::EpiMerge E{Y, GATES, NGATE, 0};
              pg8::gemm_phase<epi::EpiMerge, pg8::StaticOrder, false, true>(F.lds + RING_OFF, g, S, E); }
#if MERGE_CALLS > 1
            { pg8::Gemm g{OATT + 256, (const bf16*)(wb + O_BB), M, D, 512, 1024}; epi::EpiMerge E{Y, GATES + 1024, NGATE, 1};
              pg8::gemm_phase<epi::EpiMerge, pg8::StaticOrder, false, true>(F.lds + RING_OFF, g, S, E); }
            { pg8::Gemm g{OATT + 768, (const bf16*)(wb + O_BC), M, D, 256, 1024}; epi::EpiMerge E{Y, GATES + 2048, NGATE, 1};
              pg8::gemm_phase<epi::EpiMerge, pg8::StaticOrder, false, true>(F.lds + RING_OFF, g, S, E); }
#endif
        } SEAM(g0 + 5);
        if (((PHASE_MASK >> 6) & 1) && IN(g0 + 6)) {
            pg8::Gemm g{Y, (const bf16*)(wb + O_OUT), M, D, D, D}; pg8::StaticOrder S; S.init(M, D, F.G, F.bx);
            epi::EpiResidual E{(const float*)A.out, A.out, XB, ROWSS, 1.0f};
            pg8::gemm_phase<epi::EpiResidual, pg8::StaticOrder, false, true>(F.lds + RING_OFF, g, S, E);
        } SEAM(g0 + 6);
        if (((PHASE_MASK >> 7) & 1) && IN(g0 + 7)) {
            pg8::Gemm g{XB, (const bf16*)(wb + O_GU2), M, 2 * FF, D, D}; pg8::StaticOrder S; S.init(M, 2 * FF, F.G, F.bx);
            epi::EpiSwiGLU E{HMID, FF, ROWSS};
            pg8::gemm_phase<epi::EpiSwiGLU, pg8::StaticOrder, true, true>(F.lds + RING_OFF, g, S, E);
        } SEAM(g0 + 7);
        if (((PHASE_MASK >> 8) & 1) && IN(g0 + 8)) {
            pg8::Gemm g{HMID, (const bf16*)(wb + O_DN2), M, D, FF, FF}; pg8::StaticOrder S; S.init(M, D, F.G, F.bx);
            epi::EpiResidual E{(const float*)A.out, A.out, XB, ROWSS, 0.5f};
            pg8::gemm_phase<epi::EpiResidual, pg8::StaticOrder, false, true>(F.lds + RING_OFF, g, S, E);
        } SEAM(g0 + 8);
    }
#undef IN
#undef SEAM
}

__global__ void __launch_bounds__(256) k_oracle_A(unsigned char* ws) { oracle_A(ws, blockIdx.x * 4 + (threadIdx.x >> 6), gridDim.x * 4, threadIdx.x & 63); }
__global__ void __launch_bounds__(256) k_oracle_B(unsigned char* ws, const float* lv, const float* dn, int L) { oracle_B(ws, blockIdx.x * 4 + (threadIdx.x >> 6), gridDim.x * 4, lv + (size_t)L * 256, dn + (size_t)L * 128, L, threadIdx.x & 63); }
__global__ void __launch_bounds__(128, 1) k_oracle_C(unsigned char* ws) { extern __shared__ __attribute__((aligned(16))) unsigned char olds[]; oracle_C(ws, blockIdx.x * 2 + (threadIdx.x >> 6), gridDim.x * 2, (LAS unsigned char*)olds + (threadIdx.x >> 6) * 18944, threadIdx.x & 63); }
__global__ void __launch_bounds__(256) k_fill(unsigned char* ws) { const bf16* P = (const bf16*)(ws + WS_PROJ); bf16* O = (bf16*)(ws + WS_OATT);
    for (size_t i = (size_t)blockIdx.x * 256 + threadIdx.x; i < (size_t)M * 1024; i += (size_t)gridDim.x * 256) { const size_t row = i >> 10, c = i & 1023; O[row * 1024 + c] = P[row * PP + c]; } }
extern "C" void kernel_launch(void* const* d_in, const int* in_sizes, int n_in, void* d_out, int out_size, void* d_ws, size_t ws_size, hipStream_t stream) {
    static int grid = 0;
    if (grid == 0) {
        if (n_in != 19 || in_sizes[0] != M * D || out_size != M * D || ws_size < WS_END) { fprintf(stderr, "kernel_launch: unexpected shapes / workspace (n_in %d, ws %zu)\n", n_in, ws_size); grid = -1; return; }
        int dev = 0, cus = 0, per_cu = 0;
        if (hipGetDevice(&dev) != hipSuccess || hipDeviceGetAttribute(&cus, hipDeviceAttributeMultiprocessorCount, dev) != hipSuccess) { grid = -1; return; }
        if (hipFuncSetAttribute((const void*)mk_fwd, hipFuncAttributeMaxDynamicSharedMemorySize, LDS_BYTES) != hipSuccess) { fprintf(stderr, "kernel_launch: hipFuncSetAttribute failed\n"); grid = -1; return; }
        if (hipOccupancyMaxActiveBlocksPerMultiprocessor(&per_cu, (const void*)mk_fwd, NWAVES * 64, LDS_BYTES) != hipSuccess || per_cu < 1) { fprintf(stderr, "kernel_launch: occupancy query says %d\n", per_cu); }
        (void)hipGetLastError();
        grid = cus;
    }
    if (grid < 0) return;
    (void)hipMemsetAsync((char*)d_ws + WS_CTL, 0, CTL_ZERO_BYTES, stream);
    Args a{};
    for (int i = 0; i < 19; ++i) a.in[i] = (const float*)d_in[i];
    a.out = (float*)d_out; a.ws = (unsigned char*)d_ws;
#if defined(CHECK_MODE)
    for (int g = 0; g <= CHECK_UPTO; ++g) { a.lo = g; a.hi = g + 1; hipLaunchKernelGGL(mk_fwd, dim3(grid), dim3(NWAVES * 64), LDS_BYTES, stream, a);
        if (g >= 1 && (g - 1) % NPH_LAYER == 4) hipLaunchKernelGGL(k_fill, dim3(2048), dim3(256), 0, stream, a.ws); }
    a.lo = 0; a.hi = 0;
    hipLaunchKernelGGL(k_check, dim3(512), dim3(256), 0, stream, a, (int)CHECK_MODE, 0);
    hipLaunchKernelGGL(k_report, dim3(2048), dim3(256), 0, stream, a.ws, a.out);
#elif MK_N_LAUNCHES == 1
    a.lo = 0; a.hi = NPHASE;
    hipLaunchKernelGGL(mk_fwd, dim3(grid), dim3(NWAVES * 64), LDS_BYTES, stream, a);
#else
    for (int g = 0; g < NPHASE; ++g) { a.lo = g; a.hi = g + 1; hipLaunchKernelGGL(mk_fwd, dim3(grid), dim3(NWAVES * 64), LDS_BYTES, stream, a);
        if (ORACLE_MASK && ((PHASE_MASK >> 4) & 1) && g >= 1 && (g - 1) % NPH_LAYER == 4) { const int L = (g - 1) / NPH_LAYER;
            if (ORACLE_MASK & 8) hipLaunchKernelGGL(k_fill, dim3(2048), dim3(256), 0, stream, a.ws);
            if (ORACLE_MASK & 1) hipLaunchKernelGGL(k_oracle_A, dim3(4096), dim3(256), 0, stream, a.ws);
            if (ORACLE_MASK & 2) hipLaunchKernelGGL(k_oracle_B, dim3(4096), dim3(256), 0, stream, a.ws, a.in[9], a.in[10], L);
            if (ORACLE_MASK & 4) hipLaunchKernelGGL(k_oracle_C, dim3(4096), dim3(128), 2 * 18944, stream, a.ws); } }
#endif
}
```

```cpp
#include <hip/hip_runtime.h>
#include <cstdio>
#include <cstdint>
#include <cmath>
#ifndef MK_N_LAUNCHES
#define MK_N_LAUNCHES 1
#endif
namespace pg8 {
#define PG8_LAS __attribute__((address_space(3)))
typedef unsigned short bf16_t;
typedef short bf16x8 __attribute__((ext_vector_type(8)));
typedef float f32x4 __attribute__((ext_vector_type(4)));
typedef unsigned u32x4 __attribute__((ext_vector_type(4)));
typedef unsigned u32x2 __attribute__((ext_vector_type(2)));
constexpr int BM = 256, BK = 64, HALF = 128, HTB = HALF * BK * 2  , STAGE_BYTES = 8 * HTB, NXCD = 8, WGM = 8;

__host__ __device__ __forceinline__ int lds_byte(int r, int c) { const int st = (r >> 4) * 2 + (c >> 5), rr = r & 15, cc = c & 31, ob = rr * 64 + cc * 2; return st * 1024 + (ob ^ (((ob >> 9) & 1) << 5)); }
__host__ __device__ __forceinline__ void stage_rc(int b, int& R, int& C) { const int st = b / 1024, sb = b % 1024, swz = sb ^ (((sb >> 9) & 1) << 5); R = (st >> 1) * 16 + swz / 64; C = (st & 1) * 32 + (swz % 64) / 2; }
__host__ __device__ __forceinline__ int perm32(int rho) { const int n = rho >> 4, i = rho & 15; return 8 * (i >> 2) + 4 * n + (i & 3); }

struct Unit { int pm, pn; };
struct Gemm { const bf16_t* A; const bf16_t* Bt; int M, N, K, lda; };

struct StaticOrder {
    int nM, nN, nwg, G, c;
    __host__ __device__ void init(int M, int N, int G_, int c_) { nM = M / BM; nN = N / BM; nwg = nM * nN; G = G_; c = c_; }
    __host__ __device__ bool next(int i, Unit& u) const {
        const long L = (long)i * G + c; if (L >= nwg) return false;
        int wgid = (int)L; { const int q = nwg / NXCD, r = nwg % NXCD, xcd = wgid % NXCD, off = wgid / NXCD; wgid = (xcd < r ? xcd * (q + 1) : r * (q + 1) + (xcd - r) * q) + off; }
        const int nig = WGM * nN, gid = wgid / nig, fm = gid * WGM, gsz = (nM - fm) < WGM ? (nM - fm) : WGM;
        u.pm = fm + ((wgid % nig) % gsz); u.pn = (wgid % nig) / gsz; return true;
    }
    __device__ __forceinline__ void a_ready(const Unit&) const {}
    __device__ __forceinline__ void done(const Unit&) const {}
};

typedef float f32x2_t __attribute__((ext_vector_type(2))); typedef __bf16 bf16x2_t __attribute__((ext_vector_type(2)));
__device__ __forceinline__ unsigned cvt_pk_bf16(float lo, float hi) { f32x2_t v = {lo, hi}; bf16x2_t b = __builtin_convertvector(v, bf16x2_t); return __builtin_bit_cast(unsigned, b); }

template <class Epi, class Sched, bool ALIGN_EPI = false, bool SP2 = false>
__device__ __forceinline__ void gemm_phase(PG8_LAS unsigned char* lds, const Gemm g, const Sched& S, const Epi& E) {
    int tid_ = threadIdx.x; asm volatile("" : "+v"(tid_));
    const int tid = tid_, wid = __builtin_amdgcn_readfirstlane(tid >> 6), lane = tid & 63, wr = wid >> 2, wc = wid & 3, fr = lane & 15, fq = lane >> 4;
    const int K = g.K, nt = K / BK, lda = g.lda;
    unsigned voffA[2], voffB[2];
#pragma unroll
    for (int i = 0; i < 2; ++i) { int R, C; stage_rc(tid * 16 + i * 8192, R, C); const int Rb = Epi::PERM ? ((R & ~31) + perm32(R & 31)) : R;
        voffA[i] = (unsigned)(R * lda + C) * 2u; voffB[i] = (unsigned)(Rb * K + C) * 2u; }
    const size_t kstep = (size_t)(BK * 2);
    const size_t hstepA = (size_t)HALF * lda * 2, hstepB = (size_t)HALF * K * 2;
    const size_t tstepA = 2 * hstepA, tstepB = 2 * hstepB;
    const unsigned ldsw = (unsigned)wid * 1024u;
    const int aoff = lds_byte(wr * 64 + fr, fq * 8), boff = lds_byte(wc * 32 + fr, fq * 8);
#define PG8_SA(b, h) (((b) * 2 + (h)) * HTB)
#define PG8_SB(b, h) ((4 + (b) * 2 + (h)) * HTB)
#define PG8_STAGE(bufoff, gbase, voff) do { _Pragma("unroll") for (int _i = 0; _i < 2; ++_i) \
        __builtin_amdgcn_global_load_lds((const unsigned*)((const char*)(gbase) + (voff)[_i]), (PG8_LAS unsigned*)(lds + (bufoff) + ldsw + _i * 8192), 16, 0, 0); } while (0)
#define PG8_LDA(dst, b, h) do { _Pragma("unroll") for (int m = 0; m < 4; ++m) _Pragma("unroll") for (int k = 0; k < 2; ++k) dst[m][k] = *(const PG8_LAS bf16x8*)(lds + PG8_SA(b, h) + aoff + m * 2048 + k * 1024); } while (0)
#define PG8_LDB(dst, b, h) do { _Pragma("unroll") for (int n = 0; n < 2; ++n) _Pragma("unroll") for (int k = 0; k < 2; ++k) dst[n][k] = *(const PG8_LAS bf16x8*)(lds + PG8_SB(b, h) + boff + n * 2048 + k * 1024); } while (0)
#define PG8_MMA(ai, bj, At, Bt) do { __builtin_amdgcn_s_setprio(1); _Pragma("unroll") for (int m = 0; m < 4; ++m) _Pragma("unroll") for (int n = 0; n < 2; ++n) _Pragma("unroll") for (int k = 0; k < 2; ++k) \
        acc[ai][bj][m][n] = __builtin_amdgcn_mfma_f32_16x16x32_bf16(Bt[n][k], At[m][k], acc[ai][bj][m][n], 0, 0, 0); __builtin_amdgcn_s_setprio(0); } while (0)
#define PG8_WAIT_V(n) asm volatile("s_waitcnt vmcnt(" #n ")" ::: "memory")
#define PG8_WAIT_L(n) asm volatile("s_waitcnt lgkmcnt(" #n ")" ::: "memory")
#define PG8_BAR __builtin_amdgcn_s_barrier()
#define PG8_SCHED __builtin_amdgcn_sched_barrier(0)
    Unit cur, nxt; int ui = 0;
    if (!S.next(0, cur)) return;
    f32x4 acc[2][2][4][2];
#pragma unroll
    for (int a = 0; a < 2; ++a)
#pragma unroll
        for (int b = 0; b < 2; ++b)
#pragma unroll
            for (int m = 0; m < 4; ++m)
#pragma unroll
                for (int n = 0; n < 2; ++n) acc[a][b][m][n] = (f32x4){0.f, 0.f, 0.f, 0.f};
    bf16x8 At[4][2], B0[2][2], B1[2][2];
    const char* cA = (const char*)g.A + (size_t)cur.pm * tstepA; const char* cB = (const char*)g.Bt + (size_t)cur.pn * tstepB;
    S.a_ready(cur);
    if constexpr (SP2) {
        PG8_STAGE(PG8_SB(0, 0), cB, voffB); PG8_STAGE(PG8_SB(0, 1), cB + hstepB, voffB); PG8_STAGE(PG8_SA(0, 0), cA, voffA); PG8_STAGE(PG8_SA(0, 1), cA + hstepA, voffA);
        if (wr == 1) PG8_BAR;
        PG8_WAIT_V(2); PG8_BAR;
        PG8_STAGE(PG8_SB(1, 0), cB + kstep, voffB); PG8_STAGE(PG8_SA(1, 0), cA + kstep, voffA); PG8_STAGE(PG8_SB(1, 1), cB + hstepB + kstep, voffB);
        PG8_WAIT_V(6); PG8_BAR;
    } else {
        PG8_STAGE(PG8_SB(0, 0), cB, voffB); PG8_STAGE(PG8_SA(0, 0), cA, voffA); PG8_STAGE(PG8_SB(0, 1), cB + hstepB, voffB); PG8_STAGE(PG8_SA(0, 1), cA + hstepA, voffA);
        if (wr == 1) PG8_BAR;
        PG8_WAIT_V(4); PG8_BAR;
        PG8_STAGE(PG8_SB(1, 0), cB + kstep, voffB); PG8_STAGE(PG8_SA(1, 0), cA + kstep, voffA); PG8_STAGE(PG8_SB(1, 1), cB + hstepB + kstep, voffB);
        PG8_WAIT_V(6); PG8_BAR;
    }
    for (;;) {
        const bool has_next = S.next(ui + 1, nxt);
        const char* nA = has_next ? (const char*)g.A + (size_t)nxt.pm * tstepA : cA; const char* nB = has_next ? (const char*)g.Bt + (size_t)nxt.pn * tstepB : cB;
        for (int t = 0; t < nt; t += 2) {
            const bool last = (t == nt - 2);
            const char* a1 = cA + (size_t)(t + 1) * kstep;
            const char* a2 = last ? nA : cA + (size_t)(t + 2) * kstep; const char* b2 = last ? nB : cB + (size_t)(t + 2) * kstep;
            const char* a3 = a2 + kstep; const char* b3 = b2 + kstep;
            if (last && has_next) S.a_ready(nxt);
            if constexpr (SP2) {
            PG8_LDB(B0, 0, 0); PG8_LDB(B1, 0, 1); PG8_SCHED; PG8_LDA(At, 0, 0); PG8_STAGE(PG8_SA(1, 1), a1 + hstepA, voffA);
            PG8_WAIT_V(8); PG8_WAIT_L(0); PG8_BAR; PG8_MMA(0, 0, At, B0); PG8_MMA(0, 1, At, B1); PG8_BAR; PG8_SCHED;
            PG8_LDA(At, 0, 1); PG8_STAGE(PG8_SB(0, 0), b2, voffB); PG8_STAGE(PG8_SB(0, 1), b2 + hstepB, voffB); PG8_STAGE(PG8_SA(0, 0), a2, voffA);
            PG8_WAIT_V(8); PG8_WAIT_L(0); PG8_BAR; PG8_MMA(1, 0, At, B0); PG8_MMA(1, 1, At, B1); PG8_BAR; PG8_SCHED;
            PG8_LDB(B0, 1, 0); PG8_LDB(B1, 1, 1); PG8_SCHED; PG8_LDA(At, 1, 0); PG8_STAGE(PG8_SA(0, 1), a2 + hstepA, voffA);
            PG8_WAIT_V(8); PG8_WAIT_L(0); PG8_BAR; PG8_MMA(0, 0, At, B0); PG8_MMA(0, 1, At, B1); PG8_BAR; PG8_SCHED;
            PG8_LDA(At, 1, 1); PG8_STAGE(PG8_SB(1, 0), b3, voffB); PG8_STAGE(PG8_SB(1, 1), b3 + hstepB, voffB); PG8_STAGE(PG8_SA(1, 0), a3, voffA);
            PG8_WAIT_V(8); PG8_WAIT_L(0); PG8_BAR; PG8_MMA(1, 0, At, B0); PG8_MMA(1, 1, At, B1); PG8_BAR; PG8_SCHED;
            } else {
            PG8_LDB(B0, 0, 0); PG8_SCHED; PG8_LDA(At, 0, 0); PG8_STAGE(PG8_SA(1, 1), a1 + hstepA, voffA);
            PG8_WAIT_L(8); PG8_BAR; PG8_WAIT_L(0); PG8_MMA(0, 0, At, B0); PG8_BAR; PG8_SCHED;
            PG8_LDB(B1, 0, 1); PG8_STAGE(PG8_SB(0, 0), b2, voffB);
            PG8_BAR; PG8_WAIT_L(0); PG8_MMA(0, 1, At, B1); PG8_BAR;
            PG8_LDA(At, 0, 1); PG8_STAGE(PG8_SA(0, 0), a2, voffA);
            PG8_BAR; PG8_WAIT_L(0); PG8_MMA(1, 0, At, B0); PG8_BAR; PG8_SCHED;
            PG8_STAGE(PG8_SB(0, 1), b2 + hstepB, voffB);
            PG8_WAIT_V(6); PG8_BAR; PG8_MMA(1, 1, At, B1); PG8_BAR;
            PG8_LDB(B0, 1, 0); PG8_SCHED; PG8_LDA(At, 1, 0); PG8_STAGE(PG8_SA(0, 1), a2 + hstepA, voffA);
            PG8_WAIT_L(8); PG8_BAR; PG8_WAIT_L(0); PG8_MMA(0, 0, At, B0); PG8_BAR; PG8_SCHED;
            PG8_LDB(B1, 1, 1); PG8_STAGE(PG8_SB(1, 0), b3, voffB);
            PG8_BAR; PG8_WAIT_L(0); PG8_MMA(0, 1, At, B1); PG8_BAR;
            PG8_LDA(At, 1, 1); PG8_STAGE(PG8_SA(1, 0), a3, voffA);
            PG8_BAR; PG8_WAIT_L(0); PG8_MMA(1, 0, At, B0); PG8_BAR; PG8_SCHED;
            PG8_STAGE(PG8_SB(1, 1), b3 + hstepB, voffB);
            PG8_WAIT_V(6); PG8_BAR; PG8_MMA(1, 1, At, B1); PG8_BAR;
            }
        }
        if constexpr (ALIGN_EPI) { if (wr == 0) PG8_BAR; }
        E(acc, cur, wr, wc, fr, fq); S.done(cur);
        if (!has_next) break;
#pragma unroll
        for (int a = 0; a < 2; ++a)
#pragma unroll
            for (int b = 0; b < 2; ++b)
#pragma unroll
                for (int m = 0; m < 4; ++m)
#pragma unroll
                    for (int n = 0; n < 2; ++n) acc[a][b][m][n] = (f32x4){0.f, 0.f, 0.f, 0.f};
        cur = nxt; cA = nA; cB = nB; ++ui;
        if constexpr (ALIGN_EPI) { if (wr == 1) PG8_BAR; }
    }
    PG8_WAIT_V(0);
    if constexpr (!ALIGN_EPI) { if (wr == 0) PG8_BAR; }
    PG8_BAR;
#undef PG8_SA
#undef PG8_SB
#undef PG8_STAGE
#undef PG8_LDA
#undef PG8_LDB
#undef PG8_MMA
#undef PG8_WAIT_V
#undef PG8_WAIT_L
#undef PG8_BAR
#undef PG8_SCHED
}
}
namespace epi {
using pg8::f32x4; using pg8::u32x4; using pg8::u32x2; using pg8::Unit; using pg8::bf16_t; using pg8::cvt_pk_bf16;
constexpr int MROWS = 16384;
constexpr float RMS_EPS = 1e-6f;
__device__ __forceinline__ float bflo(unsigned u) { return __uint_as_float(u << 16); }
__device__ __forceinline__ float bfhi(unsigned u) { return __uint_as_float(u & 0xffff0000u); }
__device__ __forceinline__ float row_rs(const float* rowss, int row, int fq) {
    float s = 0.f;
#pragma unroll
    for (int j = 0; j < 4; ++j) s += rowss[(size_t)(4 * fq + j) * MROWS + row];
    s += __shfl_xor(s, 16); s += __shfl_xor(s, 32);
    return __builtin_amdgcn_rsqf(s * (1.0f / 1024.0f) + RMS_EPS);
}
__device__ __forceinline__ float sigmoidf_(float v) { return __builtin_amdgcn_rcpf(1.0f + __builtin_amdgcn_exp2f(-1.4426950408889634f * v)); }

struct EpiSwiGLU {
    static constexpr bool PERM = true;
    bf16_t* H; int ldh; const float* rowss;
    __device__ __forceinline__ void operator()(const f32x4 (&acc)[2][2][4][2], const Unit& u, int wr, int wc, int fr, int fq) const {
        const int row0 = u.pm * 256 + wr * 64 + fr, col0 = u.pn * 128 + wc * 32 + 8 * fq;
#pragma unroll
        for (int ai = 0; ai < 2; ++ai)
#pragma unroll
            for (int m = 0; m < 4; ++m) { const int row = row0 + ai * 128 + m * 16; const float r = row_rs(rowss, row, fq);
                float h[8];
#pragma unroll
                for (int n = 0; n < 2; ++n)
#pragma unroll
                    for (int i = 0; i < 4; ++i) { const float g = acc[ai][0][m][n][i] * r, up = acc[ai][1][m][n][i] * r; h[n * 4 + i] = g * sigmoidf_(g) * up; }
                u32x4 w; w.x = cvt_pk_bf16(h[0], h[1]); w.y = cvt_pk_bf16(h[2], h[3]); w.z = cvt_pk_bf16(h[4], h[5]); w.w = cvt_pk_bf16(h[6], h[7]);
                *(u32x4*)(H + (size_t)row * ldh + col0) = w; asm volatile("" ::: "memory"); }
    }
};

struct EpiResidual {
    static constexpr bool PERM = false;
    const float* base; float* out; bf16_t* xb; float* rowss; float scale;
    __device__ __forceinline__ void operator()(const f32x4 (&acc)[2][2][4][2], const Unit& u, int wr, int wc, int fr, int fq) const {
        const int row0 = u.pm * 256 + wr * 64 + fr, col0 = u.pn * 256 + wc * 32 + 4 * fq;
#pragma unroll
        for (int ai = 0; ai < 2; ++ai)
#pragma unroll
            for (int m = 0; m < 4; ++m) { const int row = row0 + ai * 128 + m * 16; const size_t off = (size_t)row * 1024 + col0; float ss = 0.f;
#pragma unroll
                for (int bj = 0; bj < 2; ++bj)
#pragma unroll
                    for (int n = 0; n < 2; ++n) { const f32x4 b = *(const f32x4*)(base + off + bj * 128 + n * 16); const f32x4 o = b + acc[ai][bj][m][n] * scale;
                        *(f32x4*)(out + off + bj * 128 + n * 16) = o; u32x2 w; w.x = cvt_pk_bf16(o[0], o[1]); w.y = cvt_pk_bf16(o[2], o[3]);
                        *(u32x2*)(xb + off + bj * 128 + n * 16) = w; ss += (o[0] * o[0] + o[1] * o[1]) + (o[2] * o[2] + o[3] * o[3]); }
                ss += __shfl_xor(ss, 16); ss += __shfl_xor(ss, 32);
                if (fq == 0) rowss[(size_t)(u.pn * 4 + wc) * MROWS + row] = ss; asm volatile("" ::: "memory"); }
    }
};

struct EpiQKV {
    static constexpr bool PERM = true;
    bf16_t* P; int ldp; const float* rowss; const float* qk_gain  ; float* widx;
    __device__ __forceinline__ void operator()(const f32x4 (&acc)[2][2][4][2], const Unit& u, int wr, int wc, int fr, int fq) const {
        const int hidx = 4 * u.pn + wc;
        int gi = -1; float post = 1.0f;
        constexpr float C2 = 0.125f * 1.4426950408889634f;
        if (hidx < 12) { gi = 0; post = C2; } else if (hidx < 24) { gi = 1; } else if (hidx < 36) { }
        else if (hidx < 44) { gi = 2; post = C2; } else if (hidx < 52) { gi = 3; } else if (hidx < 60) { }
        else if (hidx < 64) { gi = 4; post = C2; } else if (hidx == 64) { gi = 5; } else if (hidx == 65) { }
        else if (hidx < 74) { post = 0.125f; }
        f32x4 gn[2][2];
#pragma unroll
        for (int bj = 0; bj < 2; ++bj)
#pragma unroll
            for (int n = 0; n < 2; ++n) gn[bj][n] = (gi >= 0) ? *(const f32x4*)(qk_gain + gi * 64 + 32 * bj + 8 * fq + 4 * n) : (f32x4){1.f, 1.f, 1.f, 1.f};
        const int row0 = u.pm * 256 + wr * 64 + fr, col0 = 64 * hidx + 8 * fq;
#pragma unroll
        for (int ai = 0; ai < 2; ++ai)
#pragma unroll
            for (int m = 0; m < 4; ++m) { const int row = row0 + ai * 128 + m * 16; const float r = row_rs(rowss, row, fq);
                f32x4 v[2][2]; float ss = 0.f;
#pragma unroll
                for (int bj = 0; bj < 2; ++bj)
#pragma unroll
                    for (int n = 0; n < 2; ++n) { v[bj][n] = acc[ai][bj][m][n] * r; const f32x4 t = v[bj][n]; ss += (t[0] * t[0] + t[1] * t[1]) + (t[2] * t[2] + t[3] * t[3]); }
                float mul = post;
                if (gi >= 0) { ss += __shfl_xor(ss, 16); ss += __shfl_xor(ss, 32); mul = post * __builtin_amdgcn_rsqf(ss * (1.0f / 64.0f) + RMS_EPS); }
#pragma unroll
                for (int bj = 0; bj < 2; ++bj) { const f32x4 a = v[bj][0] * gn[bj][0] * mul, b = v[bj][1] * gn[bj][1] * mul;
                    u32x4 w; w.x = cvt_pk_bf16(a[0], a[1]); w.y = cvt_pk_bf16(a[2], a[3]); w.z = cvt_pk_bf16(b[0], b[1]); w.w = cvt_pk_bf16(b[2], b[3]);
                    *(u32x4*)(P + (size_t)row * ldp + col0 + 32 * bj) = w; }
                if (hidx == 75 && fq == 0) { *(f32x4*)(widx + (size_t)row * 8) = v[0][0]; *(f32x4*)(widx + (size_t)row * 8 + 4) = v[0][1]; } asm volatile("" ::: "memory"); }
    }
};

struct EpiSigmoid {
    static constexpr bool PERM = true;
    bf16_t* G; int ldg; const float* rowss;
    __device__ __forceinline__ void operator()(const f32x4 (&acc)[2][2][4][2], const Unit& u, int wr, int wc, int fr, int fq) const {
        const int row0 = u.pm * 256 + wr * 64 + fr, col0 = u.pn * 256 + wc * 32 + 8 * fq;
#pragma unroll
        for (int ai = 0; ai < 2; ++ai)
#pragma unroll
            for (int m = 0; m < 4; ++m) { const int row = row0 + ai * 128 + m * 16; const float r = row_rs(rowss, row, fq);
#pragma unroll
                for (int bj = 0; bj < 2; ++bj) { float h[8];
#pragma unroll
                    for (int n = 0; n < 2; ++n)
#pragma unroll
                        for (int i = 0; i < 4; ++i) h[n * 4 + i] = sigmoidf_(acc[ai][bj][m][n][i] * r);
                    u32x4 w; w.x = cvt_pk_bf16(h[0], h[1]); w.y = cvt_pk_bf16(h[2], h[3]); w.z = cvt_pk_bf16(h[4], h[5]); w.w = cvt_pk_bf16(h[6], h[7]);
                    *(u32x4*)(G + (size_t)row * ldg + col0 + bj * 128) = w; } asm volatile("" ::: "memory"); }
    }
};

struct EpiMerge {
    static constexpr bool PERM = true;
    bf16_t* Y; const bf16_t* G  ; int ldg; int accum;
    __device__ __forceinline__ void operator()(const f32x4 (&acc)[2][2][4][2], const Unit& u, int wr, int wc, int fr, int fq) const {
        const int row0 = u.pm * 256 + wr * 64 + fr, col0 = u.pn * 256 + wc * 32 + 8 * fq;
#pragma unroll
        for (int ai = 0; ai < 2; ++ai)
#pragma unroll
            for (int m = 0; m < 4; ++m) { const int row = row0 + ai * 128 + m * 16;
#pragma unroll
                for (int bj = 0; bj < 2; ++bj) { const u32x4 gv = *(const u32x4*)(G + (size_t)row * ldg + col0 + bj * 128);
                    bf16_t* yp = Y + (size_t)row * 1024 + col0 + bj * 128;
                    u32x4 yo = (u32x4){0u, 0u, 0u, 0u}; if (accum) yo = *(const u32x4*)yp;
                    const f32x4 a = acc[ai][bj][m][0], b = acc[ai][bj][m][1];
                    float h[8];
                    h[0] = bflo(yo.x) + bflo(gv.x) * a[0]; h[1] = bfhi(yo.x) + bfhi(gv.x) * a[1]; h[2] = bflo(yo.y) + bflo(gv.y) * a[2]; h[3] = bfhi(yo.y) + bfhi(gv.y) * a[3];
                    h[4] = bflo(yo.z) + bflo(gv.z) * b[0]; h[5] = bfhi(yo.z) + bfhi(gv.z) * b[1]; h[6] = bflo(yo.w) + bflo(gv.w) * b[2]; h[7] = bfhi(yo.w) + bfhi(gv.w) * b[3];
                    u32x4 w; w.x = cvt_pk_bf16(h[0], h[1]); w.y = cvt_pk_bf16(h[2], h[3]); w.z = cvt_pk_bf16(h[4], h[5]); w.w = cvt_pk_bf16(h[6], h[7]);
                    *(u32x4*)yp = w; } asm volatile("" ::: "memory"); }
    }
};
}
constexpr int NWAVES = 8;
constexpr int M = 16384, D = 1024, FF = 2816, T = 4096, NLAYER = 4;
constexpr int NIN = 7880, PP = 4864  , NGATE = 3072, GATE_COL0 = 4808;
constexpr float LOG2E = 1.4426950408889634f;
constexpr size_t MiB = 1u << 20;
constexpr size_t WS_CTL = 0, CTL_ZERO_BYTES = 1 * MiB;
constexpr size_t WS_BIASD = 1 * MiB;
constexpr size_t WS_ROWSS = 1 * MiB + 512 * 1024;
constexpr size_t WS_WIDX = 2 * MiB + 512 * 1024;
constexpr size_t WS_W = 4 * MiB;
constexpr size_t O_GU1 = 0, O_DN1 = 11534336, O_QKV = 17301504, O_GATE = 27262976, O_BA = 33554432, O_BB = 34078720, O_BC = 35127296, O_OUT = 35651584, O_GU2 = 37748736, O_DN2 = 49283072, O_WEND = 55050240;
constexpr size_t WS_XB = 57 * MiB, WS_OATT = 89 * MiB, WS_Y = 121 * MiB, WS_PROJ = 153 * MiB, WS_HMID = WS_PROJ, WS_GATES = 305 * MiB, WS_OB = WS_Y  , WS_SCORES = 305 * MiB  , WS_OAP = 434 * MiB, WS_END = 461 * MiB;
static_assert(WS_W + O_WEND <= WS_XB && WS_PROJ + (size_t)M * PP * 2 <= WS_GATES && WS_GATES + (size_t)M * NGATE * 2 <= WS_END && WS_SCORES + 4 * (size_t)8454144 * 4 <= WS_OAP, "ws map");
constexpr int CW_TMO = 0, CW_CODE = 1, CW_BAR = 4096;

constexpr int RING_OFF = 0, RING_BYTES = 131072;
constexpr int MISC_OFF = 160768, LDS_BYTES = 161792;

#define GAS __attribute__((address_space(1)))
#define LAS __attribute__((address_space(3)))
typedef unsigned short bf16;
typedef unsigned v4u __attribute__((ext_vector_type(4)));
typedef unsigned v2u __attribute__((ext_vector_type(2)));
typedef float f32x4 __attribute__((ext_vector_type(4)));
typedef GAS unsigned gu32;
#define RLX_AGENT __ATOMIC_RELAXED, __HIP_MEMORY_SCOPE_AGENT
#define LDS_WAIT() asm volatile("s_waitcnt lgkmcnt(0)" ::: "memory")
#define VM_WAIT() asm volatile("s_waitcnt vmcnt(0)" ::: "memory")
__device__ __forceinline__ float bflo(unsigned u) { return __uint_as_float(u << 16); }
__device__ __forceinline__ float bfhi(unsigned u) { return __uint_as_float(u & 0xffff0000u); }
__device__ __forceinline__ unsigned f2bf(float f) { unsigned u = __builtin_bit_cast(unsigned, f); return (u + 0x7fffu + ((u >> 16) & 1u)) >> 16; }
__device__ __forceinline__ unsigned pk2(float lo, float hi) { return f2bf(lo) | (f2bf(hi) << 16); }
__device__ __forceinline__ float wave_sum(float v) {
#pragma unroll
    for (int o = 1; o < 64; o <<= 1) v += __shfl_xor(v, o);
    return v;
}
__device__ __forceinline__ float wave_max(float v) {
#pragma unroll
    for (int o = 1; o < 64; o <<= 1) v = fmaxf(v, __shfl_xor(v, o));
    return v;
}
__device__ __forceinline__ float dot8(v4u a, v4u b) {
    return ((bflo(a.x) * bflo(b.x) + bfhi(a.x) * bfhi(b.x)) + (bflo(a.y) * bflo(b.y) + bfhi(a.y) * bfhi(b.y))) + ((bflo(a.z) * bflo(b.z) + bfhi(a.z) * bfhi(b.z)) + (bflo(a.w) * bflo(b.w) + bfhi(a.w) * bfhi(b.w)));
}
__device__ __forceinline__ float dot64(const v4u (&q)[8], const bf16* kp) {
    const v4u* k = (const v4u*)kp; float s = 0.f;
#pragma unroll
    for (int i = 0; i < 8; ++i) s += dot8(q[i], k[i]);
    return s;
}
__device__ __forceinline__ int rel_bucket(int n) {
    if (n < 16) return n;
    int b = 16 + (int)(logf((float)n / 16.0f) / logf(128.0f) * 16.0f);
    return b < 31 ? b : 31;
}

struct Args { const float* in[19]; float* out; unsigned char* ws; int lo, hi; };
struct Frame {
    LAS unsigned char* lds;
    volatile LAS unsigned* MISC;
    int tid, lane, wave, G, bx;
};

__device__ __forceinline__ void phase_prologue(Frame& F, const Args& A) {
    float* biasd = (float*)(A.ws + WS_BIASD); const float* rel_bias = A.in[1];
    for (int i = F.bx * 512 + F.tid; i < 20 * 4096; i += F.G * 512) { const int h = i >> 12, d = i & 4095; biasd[i] = rel_bias[rel_bucket(d) * 20 + h] * LOG2E; }
    const float* x = A.in[0]; bf16* xb = (bf16*)(A.ws + WS_XB); float* rowss = (float*)(A.ws + WS_ROWSS);
    const int gw = F.bx * NWAVES + F.wave, NGW = F.G * NWAVES;
    for (int m = gw; m < M; m += NGW) {
        const f32x4* xr = (const f32x4*)(x + (size_t)m * D) + F.lane; float s = 0.f;
        unsigned long long* o8 = (unsigned long long*)(xb + (size_t)m * D) + F.lane;
#pragma unroll
        for (int j = 0; j < 4; ++j) { const f32x4 v = xr[64 * j]; s += (v.x * v.x + v.y * v.y) + (v.z * v.z + v.w * v.w);
            o8[64 * j] = (unsigned long long)pk2(v.x, v.y) | ((unsigned long long)pk2(v.z, v.w) << 32); }
        s = wave_sum(s);
        if (F.lane < 16) rowss[(size_t)F.lane * M + m] = (F.lane == 0) ? s : 0.f;
    }
}

__device__ __forceinline__ void cvt_item(const float* W, int ldw, int col0, int nvalid, const float* gamma, bf16* WT, int K, int dstrow0, int k0, LAS float* scr, int lane) {
    const int c32 = lane & 31;
#pragma unroll 8
    for (int i = 0; i < 32; ++i) { const int kk = 2 * i + (lane >> 5);
        float v = 0.f; if (c32 < nvalid) v = W[(size_t)(k0 + kk) * ldw + col0 + c32];
        if (gamma) v *= gamma[k0 + kk];
        scr[kk * 33 + c32] = v; }
    LDS_WAIT(); asm volatile("" ::: "memory");
    const int c = lane & 7;
#pragma unroll
    for (int j = 0; j < 4; ++j) { const int n = (lane >> 3) + 8 * j; const LAS float* s = scr + (8 * c) * 33 + n;
        v4u o; o.x = pk2(s[0 * 33], s[1 * 33]); o.y = pk2(s[2 * 33], s[3 * 33]); o.z = pk2(s[4 * 33], s[5 * 33]); o.w = pk2(s[6 * 33], s[7 * 33]);
        *(v4u*)(WT + (size_t)(dstrow0 + n) * K + k0 + 8 * c) = o; }
    LDS_WAIT(); asm volatile("" ::: "memory");
}
__device__ __forceinline__ void phase_convert(Frame& F, const Args& A, int L) {
    int lane_ = F.lane; asm volatile("" : "+v"(lane_)); const int lane = lane_;
    LAS float* scr = (LAS float*)(F.lds + RING_OFF + F.wave * 16384);
    const int gw = F.bx * NWAVES + F.wave, NGW = F.G * NWAVES;
    unsigned char* wb = A.ws + WS_W;
    constexpr int I0 = 2816, I1 = 1408, I2 = 2432, I3 = 1536, I4 = 128, I5 = 256, I6 = 128, I7 = 512, I8 = 2816, I9 = 1408;
    constexpr int NITEMS = I0 + I1 + I2 + I3 + I4 + I5 + I6 + I7 + I8 + I9;
    for (int it = gw; it < NITEMS; it += NGW) {
        int r = it;
        if (r < I0 || (r >= I0 + I1 + I2 + I3 + I4 + I5 + I6 + I7 && r < NITEMS - I9)) {
            const bool second = r >= I0; if (second) r -= (I0 + I1 + I2 + I3 + I4 + I5 + I6 + I7);
            const int kb = r / 176, nb = r % 176, n0 = 32 * nb, tile = n0 >> 8, l = n0 & 255;
            const float* Wg = (second ? A.in[16] : A.in[3]) + (size_t)L * D * FF; const float* Wu = (second ? A.in[17] : A.in[4]) + (size_t)L * D * FF;
            const float* gam = (second ? A.in[15] : A.in[2]) + (size_t)L * D;
            cvt_item(l < 128 ? Wg : Wu, FF, 128 * tile + (l & 127), 32, gam, (bf16*)(wb + (second ? O_GU2 : O_GU1)), D, n0, 64 * kb, scr, lane);
            continue; }
        r -= I0;
        if (r < I1) { const int kb = r / 32, nb = r % 32; cvt_item(A.in[5] + (size_t)L * FF * D, D, 32 * nb, 32, nullptr, (bf16*)(wb + O_DN1), FF, 32 * nb, 64 * kb, scr, lane); continue; } r -= I1;
        if (r < I2) { const int kb = r / 152, nb = r % 152, n0 = 32 * nb, tile = n0 >> 8, l = n0 & 255, bj = l >> 7, wc = (l & 127) >> 5, col0 = 256 * tile + 64 * wc + 32 * bj;
            int nv = 4808 - col0; nv = nv < 0 ? 0 : (nv > 32 ? 32 : nv);
            cvt_item(A.in[7] + (size_t)L * D * NIN, NIN, col0, nv, A.in[6] + (size_t)L * D, (bf16*)(wb + O_QKV), D, n0, 64 * kb, scr, lane); continue; } r -= I2;
        if (r < I3) { const int kb = r / 96, nb = r % 96; cvt_item(A.in[7] + (size_t)L * D * NIN, NIN, GATE_COL0 + 32 * nb, 32, A.in[6] + (size_t)L * D, (bf16*)(wb + O_GATE), D, 32 * nb, 64 * kb, scr, lane); continue; } r -= I3;
        if (r < I4) { const int kb = r / 32, nb = r % 32; cvt_item(A.in[11] + (size_t)L * 256 * D, D, 32 * nb, 32, nullptr, (bf16*)(wb + O_BA), 256, 32 * nb, 64 * kb, scr, lane); continue; } r -= I4;
        if (r < I5) { const int kb = r / 32, nb = r % 32; cvt_item(A.in[12] + (size_t)L * 512 * D, D, 32 * nb, 32, nullptr, (bf16*)(wb + O_BB), 512, 32 * nb, 64 * kb, scr, lane); continue; } r -= I5;
        if (r < I6) { const int kb = r / 32, nb = r % 32; cvt_item(A.in[13] + (size_t)L * 256 * D, D, 32 * nb, 32, nullptr, (bf16*)(wb + O_BC), 256, 32 * nb, 64 * kb, scr, lane); continue; } r -= I6;
        if (r < I7) { const int kb = r / 32, nb = r % 32; cvt_item(A.in[14] + (size_t)L * D * D, D, 32 * nb, 32, nullptr, (bf16*)(wb + O_OUT), D, 32 * nb, 64 * kb, scr, lane); continue; } r -= I7;
        r -= I8;
        { const int kb = r / 32, nb = r % 32; cvt_item(A.in[18] + (size_t)L * FF * D, D, 32 * nb, 32, nullptr, (bf16*)(wb + O_DN2), FF, 32 * nb, 64 * kb, scr, lane); }
    }
}

constexpr int COL_AQ = 0, COL_AK = 768, COL_AV = 1536, COL_BQ = 2304, COL_BK = 2816, COL_BV = 3328, COL_CQ = 3840, COL_CK = 4096, COL_CV = 4160, COL_IQ = 4224, COL_IK = 4736;
__device__ __forceinline__ void load_q(v4u (&q)[8], const bf16* p) {
#pragma unroll
    for (int i = 0; i < 8; ++i) q[i] = ((const v4u*)p)[i];
}
__device__ __forceinline__ void oracle_A(unsigned char* ws, int gw, int NGW, int lane) {
    const bf16* P = (const bf16*)(ws + WS_PROJ); const float* biasd = (const float*)(ws + WS_BIASD); bf16* O = (bf16*)(ws + WS_OATT);
    for (int it = gw; it < M * 4; it += NGW) {
        const int row = it >> 2, hs = it & 3, b = row >> 12, t = row & 4095;
        float mrun = -INFINITY, l = 0.f, o = 0.f;
        for (int g = 0; g < 3; ++g) {
            const int dil = (g == 0) ? 1 : (g == 1 ? 4 : 16), head = 4 * g + hs, i = t / dil, r = t % dil;
            v4u q[8]; load_q(q, P + (size_t)row * PP + COL_AQ + head * 64);
            const int jlo = (i - 128) < 0 ? 0 : (i - 128), nk = i - jlo + 1;
            for (int c0 = 0; c0 < nk; c0 += 64) {
                const int jj = c0 + lane; const bool valid = jj < nk; const int j = jlo + (valid ? jj : 0);
                const size_t krow = (size_t)b * T + (size_t)j * dil + r;
                float s = -INFINITY;
                if (valid) s = dot64(q, P + krow * PP + COL_AK + head * 64) + biasd[head * 4096 + (i - j) * dil];
                const float mnew = fmaxf(mrun, wave_max(s)); const float alpha = __builtin_amdgcn_exp2f(mrun - mnew);
                const float p = valid ? __builtin_amdgcn_exp2f(s - mnew) : 0.f;
                l = l * alpha + wave_sum(p); o *= alpha; mrun = mnew;
                const int kn = (nk - c0) < 64 ? (nk - c0) : 64;
                for (int kk = 0; kk < kn; ++kk) { const float pk = __shfl(p, kk); const size_t vrow = (size_t)b * T + (size_t)(jlo + c0 + kk) * dil + r;
                    o += pk * bflo((unsigned)P[vrow * PP + COL_AV + head * 64 + lane]); }
            }
        }
        O[(size_t)row * 1024 + hs * 64 + lane] = (bf16)f2bf(o / l);
    }
}
__device__ __forceinline__ void oracle_B_map(const bf16* P, const float* biasd, int row, int h, int mp, int lane, float& r0, float& r1) {
    const int b = row >> 12, t = row & 4095;
    v4u q[8]; load_q(q, P + (size_t)row * PP + COL_BQ + (mp * 4 + h) * 64);
    float mrun = -INFINITY, l = 0.f, o0 = 0.f, o1 = 0.f;
    for (int c0 = 0; c0 <= t; c0 += 64) {
        const int j = c0 + lane; const bool valid = j <= t; const size_t krow = (size_t)b * T + (valid ? j : 0);
        float s = -INFINITY;
        if (valid) s = dot64(q, P + krow * PP + COL_BK + (mp * 4 + h) * 64) + biasd[(12 + h) * 4096 + (t - j)];
        const float mnew = fmaxf(mrun, wave_max(s)); const float alpha = __builtin_amdgcn_exp2f(mrun - mnew);
        const float p = valid ? __builtin_amdgcn_exp2f(s - mnew) : 0.f;
        l = l * alpha + wave_sum(p); o0 *= alpha; o1 *= alpha; mrun = mnew;
        const int kn = (t + 1 - c0) < 64 ? (t + 1 - c0) : 64;
        for (int kk = 0; kk < kn; ++kk) { const float pk = __shfl(p, kk); const bf16* vp = P + ((size_t)b * T + c0 + kk) * PP + COL_BV + h * 128;
            o0 += pk * bflo((unsigned)vp[lane]); o1 += pk * bflo((unsigned)vp[64 + lane]); }
    }
    r0 = o0 / l; r1 = o1 / l;
}
__device__ __forceinline__ void oracle_B(unsigned char* ws, int gw, int NGW, const float* lv, const float* dn, int L, int lane) {
    const bf16* P = (const bf16*)(ws + WS_PROJ); const float* biasd = (const float*)(ws + WS_BIASD); bf16* O = (bf16*)(ws + WS_OATT);
    const float lam_init = 0.8f - 0.6f * expf(-0.3f * (float)L);
    const float lam = expf(wave_sum(lv[lane] * lv[64 + lane])) - expf(wave_sum(lv[128 + lane] * lv[192 + lane])) + lam_init;
    for (int it = gw; it < M * 4; it += NGW) {
        const int row = it >> 2, h = it & 3;
        float a0, a1, b0, b1;
        oracle_B_map(P, biasd, row, h, 0, lane, a0, a1);
        oracle_B_map(P, biasd, row, h, 1, lane, b0, b1);
        const float d0 = a0 - lam * b0, d1 = a1 - lam * b1;
        const float inv = __builtin_amdgcn_rsqf(wave_sum(d0 * d0 + d1 * d1) * (1.0f / 128.0f) + 1e-6f) * (1.0f - lam_init);
        O[(size_t)row * 1024 + 256 + h * 128 + lane] = (bf16)f2bf(d0 * inv * dn[lane]);
        O[(size_t)row * 1024 + 256 + h * 128 + 64 + lane] = (bf16)f2bf(d1 * inv * dn[64 + lane]);
    }
}
__device__ __forceinline__ void oracle_C(unsigned char* ws, int gw, int NGW, LAS unsigned char* ldsw, int lane) {
    const bf16* P = (const bf16*)(ws + WS_PROJ); const float* biasd = (const float*)(ws + WS_BIASD); bf16* O = (bf16*)(ws + WS_OATT);
    const float* widx = (const float*)(ws + WS_WIDX);
    LAS float* sc = (LAS float*)(ldsw);
    LAS unsigned short* sel = (LAS unsigned short*)(ldsw + 16384);
    LAS float* qi = (LAS float*)(ldsw + 16384 + 512);
    for (int row = gw; row < M; row += NGW) {
        const int b = row >> 12, t = row & 4095, N = t + 1;
#pragma unroll
        for (int i = 0; i < 8; ++i) qi[i * 64 + lane] = bflo((unsigned)P[(size_t)row * PP + COL_IQ + i * 64 + lane]);
        float w[8];
#pragma unroll
        for (int h = 0; h < 8; ++h) w[h] = widx[(size_t)row * 8 + h] * 0.35355339059327373f;
        LDS_WAIT();
#pragma unroll 1
        for (int c0 = 0; c0 < N; c0 += 64) {
            const int j = c0 + lane; const bool valid = j < N;
            const v4u* kp = (const v4u*)(P + ((size_t)b * T + (valid ? j : 0)) * PP + COL_IK);
            float dsum[8];
#pragma unroll
            for (int h = 0; h < 8; ++h) dsum[h] = 0.f;
#pragma unroll 2
            for (int i = 0; i < 8; ++i) { const v4u kv = kp[i];
                const float k0 = bflo(kv.x), k1 = bfhi(kv.x), k2 = bflo(kv.y), k3 = bfhi(kv.y), k4 = bflo(kv.z), k5 = bfhi(kv.z), k6 = bflo(kv.w), k7 = bfhi(kv.w);
#pragma unroll
                for (int h = 0; h < 8; ++h) { const f32x4 qa = *(const LAS f32x4*)(qi + h * 64 + i * 8), qb = *(const LAS f32x4*)(qi + h * 64 + i * 8 + 4);
                    dsum[h] += ((qa.x * k0 + qa.y * k1) + (qa.z * k2 + qa.w * k3)) + ((qb.x * k4 + qb.y * k5) + (qb.z * k6 + qb.w * k7)); } }
            float score = 0.f;
#pragma unroll
            for (int h = 0; h < 8; ++h) score += w[h] * fmaxf(dsum[h], 0.f);
            if (j < 4096) sc[j] = valid ? score : -INFINITY;
        }
        LDS_WAIT();
        int cnt = 0;
        if (N <= 256) { for (int n = lane; n < N; n += 64) sel[n] = (unsigned short)n; cnt = N; }
        else {
            const int N4 = (N + 3) & ~3;
#pragma unroll 1
            for (int c0 = 0; c0 < N; c0 += 64) {
                const int j = c0 + lane; const bool valid = j < N; const float sj = valid ? sc[j] : INFINITY;
                int rank = 0;
                for (int jp = 0; jp < N4; jp += 4) { const f32x4 v = *(const LAS f32x4*)(sc + jp);
                    rank += (v.x > sj || (v.x == sj && jp < j)) ? 1 : 0; rank += (v.y > sj || (v.y == sj && jp + 1 < j)) ? 1 : 0;
                    rank += (v.z > sj || (v.z == sj && jp + 2 < j)) ? 1 : 0; rank += (v.w > sj || (v.w == sj && jp + 3 < j)) ? 1 : 0; }
                const bool s = valid && rank < 256;
                const unsigned long long bal = __ballot(s);
                const int pos = cnt + __popcll(bal & ((1ull << lane) - 1ull));
                if (s && pos < 256) sel[pos] = (unsigned short)j;
                cnt += __popcll(bal);
            }
            cnt = cnt > 256 ? 256 : cnt;
        }
        LDS_WAIT();
#pragma unroll 1
        for (int h = 0; h < 4; ++h) {
            v4u q[8]; load_q(q, P + (size_t)row * PP + COL_CQ + h * 64);
            float s[4]; float mx = -INFINITY;
#pragma unroll
            for (int c = 0; c < 4; ++c) { const int n = lane + 64 * c; const bool valid = n < cnt; const int key = valid ? (int)sel[n] : 0;
                s[c] = valid ? dot64(q, P + ((size_t)b * T + key) * PP + COL_CK) + biasd[(16 + h) * 4096 + (t - key)] : -INFINITY; mx = fmaxf(mx, s[c]); }
            mx = wave_max(mx);
            float p[4], ls = 0.f;
#pragma unroll
            for (int c = 0; c < 4; ++c) { p[c] = (lane + 64 * c < cnt) ? __builtin_amdgcn_exp2f(s[c] - mx) : 0.f; ls += p[c]; }
            ls = wave_sum(ls);
            float o = 0.f;
#pragma unroll
            for (int c = 0; c < 4; ++c) { const int kn = (cnt - 64 * c) < 64 ? (cnt - 64 * c) : 64;
                for (int kk = 0; kk < kn; ++kk) { const float pk = __shfl(p[c], kk); const int key = (int)sel[64 * c + kk];
                    o += pk * bflo((unsigned)P[((size_t)b * T + key) * PP + COL_CV + lane]); } }
            O[(size_t)row * 1024 + 768 + h * 64 + lane] = (bf16)f2bf(o / ls);
        }
        LDS_WAIT();
    }
}
namespace fa {
typedef short bf16x8 __attribute__((ext_vector_type(8)));
typedef short v4i16_t __attribute__((ext_vector_type(4)));
typedef float f32x16 __attribute__((ext_vector_type(16)));
typedef unsigned u32x4 __attribute__((ext_vector_type(4)));
constexpr int KPITCH = 144;
constexpr int KSTAGE = 64 * KPITCH;
template <int NDB> struct Geo { static constexpr int VPITCH = (NDB == 4) ? 320 : 192, VSTAGE = 64 * VPITCH, OFF_K = 0, OFF_V = 2 * KSTAGE, OFF_BIAS = OFF_V + 2 * VSTAGE, LDS_END = OFF_BIAS + 16384; };
__device__ __forceinline__ int crow(int r, int hi) { return (r & 3) + 8 * (r >> 2) + 4 * hi; }

struct Unit {
    const bf16* P;
    int colQ, colK, colV;
    long rowbase;
    int stride, rofs;
    int qi0;
    int kt0, kt1;
    const float* biasd;
};

template <int NDB, int MODE>
__device__ __forceinline__ void run(LAS unsigned char* lds, const Unit& U, int tid, f32x16 (&o)[NDB], float& mrun_out, float& lsum_out) {
    typedef Geo<NDB> G;
    const int lane = tid & 63, wid = __builtin_amdgcn_readfirstlane(tid >> 6), q32 = lane & 31, hi = lane >> 5;
    { LAS float* bl = (LAS float*)(lds + G::OFF_BIAS);
#pragma unroll
      for (int i = 0; i < 2; ++i) { const f32x4 v = *(const f32x4*)(U.biasd + (tid + 512 * i) * 4); *(LAS f32x4*)(bl + (tid + 512 * i) * 4) = v; } }
    const int qi = U.qi0 + 32 * wid + q32;
    bf16x8 qr[4];
    { const bf16* qp = U.P + (size_t)(U.rowbase + (long)qi * U.stride + U.rofs) * PP + U.colQ + 8 * hi;
#pragma unroll
      for (int d0 = 0; d0 < 4; ++d0) qr[d0] = *(const bf16x8*)(qp + 16 * d0); }
#pragma unroll
    for (int db = 0; db < NDB; ++db)
#pragma unroll
        for (int r = 0; r < 16; ++r) o[db][r] = 0.f;
    float mrun = -1.0e30f, lsum = 0.f;
    const int krow = tid >> 3, kch = tid & 7;
    u32x4 kst; u32x4 vst[NDB / 2];
    auto load_tile = [&](int kt) {
        { const long pos = (long)(64 * kt + krow) * U.stride + U.rofs; kst = *(const u32x4*)(U.P + (size_t)(U.rowbase + pos) * PP + U.colK + 8 * kch); }
#pragma unroll
        for (int i = 0; i < NDB / 2; ++i) { const int idx = tid + 512 * i, vr = idx / (NDB * 4), vc = idx % (NDB * 4);
            const long pos = (long)(64 * kt + vr) * U.stride + U.rofs; vst[i] = *(const u32x4*)(U.P + (size_t)(U.rowbase + pos) * PP + U.colV + 8 * vc); }
    };
    auto store_tile = [&](int buf) {
        *(LAS u32x4*)(lds + G::OFF_K + buf * KSTAGE + krow * KPITCH + kch * 16) = kst;
#pragma unroll
        for (int i = 0; i < NDB / 2; ++i) { const int idx = tid + 512 * i, vr = idx / (NDB * 4), vc = idx % (NDB * 4);
            *(LAS u32x4*)(lds + G::OFF_V + buf * G::VSTAGE + vr * G::VPITCH + vc * 16) = vst[i]; }
    };
    load_tile(U.kt0); store_tile(0);
    __syncthreads();
    const LAS float* bl = (const LAS float*)(lds + G::OFF_BIAS);
    const int qlo = U.qi0 + 32 * wid, qhi = qlo + 31;
    for (int kt = U.kt0; kt < U.kt1; ++kt) {
        const int buf = (kt - U.kt0) & 1;
        if (kt + 1 < U.kt1) load_tile(kt + 1);
        const int k0 = 64 * kt;
        bool need = (k0 <= qhi);
        if (MODE == 1) need = need && (k0 + 63 >= qlo - 128);
        if (need) {
            f32x16 p0, p1;
#pragma unroll
            for (int r = 0; r < 16; ++r) { p0[r] = 0.f; p1[r] = 0.f; }
            const LAS unsigned char* kb = lds + G::OFF_K + buf * KSTAGE + q32 * KPITCH + hi * 16;
#pragma unroll
            for (int d0 = 0; d0 < 4; ++d0) {
                const bf16x8 ka = *(const LAS bf16x8*)(kb + d0 * 32), kc = *(const LAS bf16x8*)(kb + 32 * KPITCH + d0 * 32);
                p0 = __builtin_amdgcn_mfma_f32_32x32x16_bf16(ka, qr[d0], p0, 0, 0, 0);
                p1 = __builtin_amdgcn_mfma_f32_32x32x16_bf16(kc, qr[d0], p1, 0, 0, 0);
                if (d0 & 1) asm volatile("" ::: "memory");
            }
            const bool edge = (k0 + 63 > qlo) || (MODE == 1 && k0 < qhi - 128 + 0);
            float mx = -INFINITY;
#pragma unroll
            for (int r = 0; r < 16; ++r) {
                const int j0 = k0 + crow(r, hi), j1 = j0 + 32; const int d0_ = qi - j0, d1_ = qi - j1;
                float b0 = bl[(d0_ < 0 ? 0 : d0_) * U.stride], b1 = bl[(d1_ < 0 ? 0 : d1_) * U.stride];
                float s0 = p0[r] + b0, s1 = p1[r] + b1;
                if (edge) { bool v0 = d0_ >= 0, v1 = d1_ >= 0; if (MODE == 1) { v0 = v0 && d0_ <= 128; v1 = v1 && d1_ <= 128; }
                    s0 = v0 ? s0 : -INFINITY; s1 = v1 ? s1 : -INFINITY; }
                p0[r] = s0; p1[r] = s1; mx = fmaxf(mx, fmaxf(s0, s1));
                if ((r & 3) == 3) asm volatile("" ::: "memory");
            }
            mx = fmaxf(mx, __shfl_xor(mx, 32));
            const float mnew = fmaxf(mrun, mx);
            if (__any(mnew > mrun)) {
                const float alpha = __builtin_amdgcn_exp2f(mrun - mnew);
                lsum *= alpha;
#pragma unroll
                for (int r = 0; r < 16; ++r) { const float ar = __shfl(alpha, crow(r, hi));
#pragma unroll
                    for (int db = 0; db < NDB; ++db) o[db][r] *= ar; }
                mrun = mnew;
            }
            float ps = 0.f;
#pragma unroll
            for (int r = 0; r < 16; ++r) { p0[r] = __builtin_amdgcn_exp2f(p0[r] - mrun); p1[r] = __builtin_amdgcn_exp2f(p1[r] - mrun); ps += p0[r] + p1[r]; }
            lsum += ps;
            const LAS unsigned char* vb = lds + G::OFF_V + buf * G::VSTAGE + (4 * hi + ((lane & 15) >> 2)) * G::VPITCH + (16 * ((lane >> 4) & 1) + 4 * (lane & 3)) * 2;
#pragma unroll
            for (int s = 0; s < 4; ++s) {
                u32x4 pw;
                if (s < 2) { pw.x = pg8::cvt_pk_bf16(p0[8 * s + 0], p0[8 * s + 1]); pw.y = pg8::cvt_pk_bf16(p0[8 * s + 2], p0[8 * s + 3]); pw.z = pg8::cvt_pk_bf16(p0[8 * s + 4], p0[8 * s + 5]); pw.w = pg8::cvt_pk_bf16(p0[8 * s + 6], p0[8 * s + 7]); }
                else { const int s2 = s - 2; pw.x = pg8::cvt_pk_bf16(p1[8 * s2 + 0], p1[8 * s2 + 1]); pw.y = pg8::cvt_pk_bf16(p1[8 * s2 + 2], p1[8 * s2 + 3]); pw.z = pg8::cvt_pk_bf16(p1[8 * s2 + 4], p1[8 * s2 + 5]); pw.w = pg8::cvt_pk_bf16(p1[8 * s2 + 6], p1[8 * s2 + 7]); }
                const bf16x8 pa = __builtin_bit_cast(bf16x8, pw);
                const LAS unsigned char* vs = vb + (32 * (s >> 1) + 16 * (s & 1)) * G::VPITCH;
#pragma unroll
                for (int db = 0; db < NDB; ++db) {
                    const v4i16_t lo = __builtin_amdgcn_ds_read_tr16_b64_v4i16((LAS v4i16_t*)(vs + db * 64));
                    const v4i16_t hv = __builtin_amdgcn_ds_read_tr16_b64_v4i16((LAS v4i16_t*)(vs + 8 * G::VPITCH + db * 64));
                    const bf16x8 vf = (bf16x8){lo[0], lo[1], lo[2], lo[3], hv[0], hv[1], hv[2], hv[3]};
                    o[db] = __builtin_amdgcn_mfma_f32_32x32x16_bf16(pa, vf, o[db], 0, 0, 0);
                }
                asm volatile("" ::: "memory");
            }
        }
        if (kt + 1 < U.kt1) store_tile(buf ^ 1);
        __syncthreads();
    }
    lsum += __shfl_xor(lsum, 32);
    mrun_out = mrun; lsum_out = lsum;
}
}
__device__ __forceinline__ void phase_attn_B(Frame& F, const Args& A) {
    int tid_ = F.tid; asm volatile("" : "+v"(tid_)); const int tid = tid_, lane = tid & 63, wid = __builtin_amdgcn_readfirstlane(tid >> 6), q32 = lane & 31, hi = lane >> 5;
    const int v = (F.bx % 8) * (F.G / 8) + F.bx / 8;
    const bf16* P = (const bf16*)(A.ws + WS_PROJ); bf16* OB = (bf16*)(A.ws + WS_OB); const float* biasd = (const float*)(A.ws + WS_BIASD);
    for (int pv = v; pv < 512; pv += F.G) {
        const int combo = pv >> 3, s = pv & 7, b = combo >> 4, h = (combo >> 2) & 3, mp = (combo >> 1) & 1, vh = combo & 1;
#pragma unroll 1
        for (int half = 0; half < 2; ++half) {
            const int qb = half ? s : 15 - s;
            fa::Unit U; U.P = P; U.colQ = COL_BQ + (mp * 4 + h) * 64; U.colK = COL_BK + (mp * 4 + h) * 64; U.colV = COL_BV + h * 128 + vh * 64; U.rowbase = (long)b * T; U.stride = 1; U.rofs = 0;
            U.qi0 = 256 * qb; U.kt0 = 0; U.kt1 = 4 * (qb + 1); U.biasd = biasd + (12 + h) * 4096;
            fa::f32x16 o[2]; float mrun, lsum;
            fa::run<2, 0>(F.lds + RING_OFF, U, tid, o, mrun, lsum);
            const float inv = 1.0f / lsum;
            bf16* orow = OB + (size_t)(U.rowbase + U.qi0 + 32 * wid) * 1024 + h * 256 + mp * 128 + vh * 64 + q32;
#pragma unroll
            for (int r = 0; r < 16; ++r) { const int qq = fa::crow(r, hi); const float ir = __shfl(inv, qq);
#pragma unroll
                for (int db = 0; db < 2; ++db) orow[(size_t)qq * 1024 + 32 * db] = (bf16)f2bf(o[db][r] * ir); }
        }
    }
}
__device__ __forceinline__ void phase_combine_B(Frame& F, const Args& A, int L) {
    int lane_ = F.lane; asm volatile("" : "+v"(lane_)); const int lane = lane_;
    const bf16* OB = (const bf16*)(A.ws + WS_OB); bf16* O = (bf16*)(A.ws + WS_OATT);
    const float* lv = A.in[9] + (size_t)L * 256; const float* dn = A.in[10] + (size_t)L * 128;
    const float lam_init = 0.8f - 0.6f * expf(-0.3f * (float)L);
    const float lam = expf(wave_sum(lv[lane] * lv[64 + lane])) - expf(wave_sum(lv[128 + lane] * lv[192 + lane])) + lam_init;
    const float g0 = dn[lane], g1 = dn[64 + lane];
    const int gw = F.bx * NWAVES + F.wave, NGW = F.G * NWAVES;
    for (int it = gw; it < M * 4; it += NGW) {
        const int row = it >> 2, h = it & 3; const bf16* p = OB + (size_t)row * 1024 + h * 256;
        const float d0 = bflo((unsigned)p[lane]) - lam * bflo((unsigned)p[128 + lane]), d1 = bflo((unsigned)p[64 + lane]) - lam * bflo((unsigned)p[192 + lane]);
        const float inv = __builtin_amdgcn_rsqf(wave_sum(d0 * d0 + d1 * d1) * (1.0f / 128.0f) + 1e-6f) * (1.0f - lam_init);
        O[(size_t)row * 1024 + 256 + h * 128 + lane] = (bf16)f2bf(d0 * inv * g0);
        O[(size_t)row * 1024 + 256 + h * 128 + 64 + lane] = (bf16)f2bf(d1 * inv * g1);
    }
}
constexpr size_t SC_BATCH = 8454144;
__device__ __forceinline__ size_t sc_rowoff(int t) { const size_t i = (size_t)(t >> 5); return 512 * i * (i + 1) + (size_t)(t & 31) * 32 * (i + 1); }
typedef float f32x4v __attribute__((ext_vector_type(4)));
__device__ __forceinline__ void c1_decode(int f, int& b, int& qb, int& kt) { b = f / 1056; const int rem = f - 1056 * b; qb = 0; while ((qb + 1) * (qb + 2) <= rem) ++qb; kt = rem - qb * (qb + 1); }
__device__ __forceinline__ void phase_C1(Frame& F, const Args& A) {
    int tid_ = F.tid; asm volatile("" : "+v"(tid_)); const int tid = tid_, lane = tid & 63, wid = __builtin_amdgcn_readfirstlane(tid >> 6), q16 = lane & 15, g = lane >> 4;
    const int v = (F.bx % 8) * (F.G / 8) + F.bx / 8;
    const bf16* P = (const bf16*)(A.ws + WS_PROJ); float* SC = (float*)(A.ws + WS_SCORES); const float* WIDX = (const float*)(A.ws + WS_WIDX);
    constexpr int NTOT = 4 * 1056;
    const int f0 = (int)(((long)v * NTOT) / F.G), f1 = (int)(((long)(v + 1) * NTOT) / F.G);
    if (f0 >= f1) return;
    LAS unsigned char* lds = F.lds + RING_OFF;
    const int krow = tid >> 3, kch = tid & 7;
    fa::u32x4 kst;
    int b, qb, kt; c1_decode(f0, b, qb, kt);
    kst = *(const fa::u32x4*)(P + (size_t)((long)b * T + 64 * kt + krow) * PP + COL_IK + 8 * kch);
    *(LAS fa::u32x4*)(lds + krow * fa::KPITCH + kch * 16) = kst;
    __syncthreads();
    int cb = -1, cqb = -1;
    fa::bf16x8 qf[8][2]; float wq[8];
    for (int f = f0; f < f1; ++f) {
        const int buf = (f - f0) & 1;
        int nb = b, nqb = qb, nkt = kt + 1; if (nkt >= 2 * (qb + 1)) { nkt = 0; ++nqb; if (nqb >= 32) { nqb = 0; ++nb; } }
        if (f + 1 < f1) kst = *(const fa::u32x4*)(P + (size_t)((long)nb * T + 64 * nkt + krow) * PP + COL_IK + 8 * kch);
        if (b != cb || qb != cqb) {
            cb = b; cqb = qb;
            const size_t row = (size_t)b * T + 128 * qb + 16 * wid + q16;
#pragma unroll
            for (int h = 0; h < 8; ++h) { wq[h] = WIDX[row * 8 + h] * 0.35355339059327373f;
#pragma unroll
                for (int ks = 0; ks < 2; ++ks) qf[h][ks] = *(const fa::bf16x8*)(P + row * PP + COL_IQ + h * 64 + 32 * ks + 8 * g); }
        }
        const int tq0 = 128 * qb + 16 * wid, k0 = 64 * kt;
        float* srow = SC + (size_t)b * SC_BATCH + sc_rowoff(tq0 + q16);
#pragma unroll 1
        for (int kb = 0; kb < 4; ++kb) {
            const int kbase = k0 + 16 * kb;
            if (kbase > tq0 + 15) continue;
            const LAS unsigned char* kp = lds + buf * fa::KSTAGE + (16 * kb + q16) * fa::KPITCH + g * 16;
            const fa::bf16x8 kf0 = *(const LAS fa::bf16x8*)(kp), kf1 = *(const LAS fa::bf16x8*)(kp + 64);
            f32x4v sc = {0.f, 0.f, 0.f, 0.f};
#pragma unroll
            for (int h = 0; h < 8; ++h) {
                f32x4v p = {0.f, 0.f, 0.f, 0.f};
                p = __builtin_amdgcn_mfma_f32_16x16x32_bf16(kf0, qf[h][0], p, 0, 0, 0);
                p = __builtin_amdgcn_mfma_f32_16x16x32_bf16(kf1, qf[h][1], p, 0, 0, 0);
#pragma unroll
                for (int r = 0; r < 4; ++r) sc[r] += wq[h] * fmaxf(p[r], 0.f);
            }
            *(f32x4v*)(srow + kbase + 4 * g) = sc;
        }
        if (f + 1 < f1) *(LAS fa::u32x4*)(lds + (buf ^ 1) * fa::KSTAGE + krow * fa::KPITCH + kch * 16) = kst;
        __syncthreads();
        b = nb; qb = nqb; kt = nkt;
    }
}

__device__ __forceinline__ void phase_C2(Frame& F, const Args& A) {
    int lane_ = F.lane; asm volatile("" : "+v"(lane_)); const int lane = lane_;
    const bf16* P = (const bf16*)(A.ws + WS_PROJ); const float* SC = (const float*)(A.ws + WS_SCORES); const float* biasd = (const float*)(A.ws + WS_BIASD); bf16* O = (bf16*)(A.ws + WS_OATT);
    LAS unsigned char* wl = F.lds + RING_OFF + F.wave * 17920;
    LAS unsigned* keys = (LAS unsigned*)wl;
    LAS float* pl = (LAS float*)wl;
    LAS unsigned* hist = (LAS unsigned*)(wl + 16384);
    LAS unsigned short* sel = (LAS unsigned short*)(wl + 17408);
    const int gw = F.bx * NWAVES + F.wave, NGW = F.G * NWAVES;
    const unsigned long long ltmask = (1ull << lane) - 1ull;
#pragma unroll 1
    for (int row = gw; row < M; row += NGW) {
        const int b = row >> 12, t = row & 4095, N = t + 1;
        int cnt;
        if (N <= 256) { for (int n = lane; n < N; n += 64) sel[n] = (unsigned short)n; cnt = N; }
        else {
            const float* srow = SC + (size_t)b * SC_BATCH + sc_rowoff(t);
            const int nc = (N + 63) >> 6;
#pragma unroll 4
            for (int c = 0; c < nc; ++c) { const int j = c * 64 + lane; unsigned u = 0u;
                if (j < N) { const unsigned bits = __float_as_uint(srow[j] + 0.0f);     u = (bits & 0x80000000u) ? ~bits : (bits | 0x80000000u); }
                keys[j] = u; }
            unsigned prefix = 0u, mask = 0u; int krem = 256;
#pragma unroll 1
            for (int pass = 0; pass < 4; ++pass) {
                const int shift = 24 - 8 * pass;
                *(LAS v4u*)(hist + 4 * lane) = (v4u){0u, 0u, 0u, 0u};
                LDS_WAIT();
#pragma unroll 4
                for (int c = 0; c < nc; ++c) { const unsigned kk = keys[c * 64 + lane]; if (kk != 0u && (kk & mask) == prefix) __hip_atomic_fetch_add(hist + ((kk >> shift) & 255u), 1u, __ATOMIC_RELAXED, __HIP_MEMORY_SCOPE_WORKGROUP); }
                LDS_WAIT();
                const v4u hc = *(const LAS v4u*)(hist + 4 * lane);
                const unsigned sl = hc.x + hc.y + hc.z + hc.w;
                unsigned suf = sl;
#pragma unroll
                for (int o = 1; o < 64; o <<= 1) { const unsigned other = __shfl_down(suf, o); if (lane + o < 64) suf += other; }
                unsigned cum = suf - sl;
                int fb = -1; unsigned fabove = 0u;
                { const unsigned cc[4] = {hc.w, hc.z, hc.y, hc.x};
#pragma unroll
                  for (int i = 0; i < 4; ++i) { if (fb < 0 && cum < (unsigned)krem && cum + cc[i] >= (unsigned)krem) { fb = 4 * lane + 3 - i; fabove = cum; } cum += cc[i]; } }
                const unsigned long long bal = __ballot(fb >= 0);
                const int src = __builtin_ctzll(bal);
                const int bin = __shfl(fb, src); const unsigned above = __shfl(fabove, src);
                prefix |= (unsigned)bin << shift; mask |= 0xFFu << shift; krem -= (int)above;
            }
            cnt = 0; int eqseen = 0;
#pragma unroll 2
            for (int c = 0; c < nc; ++c) {
                const unsigned kk = keys[c * 64 + lane];
                const bool gt = kk > prefix, eq = kk == prefix;
                const unsigned long long beq = __ballot(eq);
                const bool sflag = gt || (eq && (eqseen + __popcll(beq & ltmask)) < krem);
                const unsigned long long bs = __ballot(sflag);
                if (sflag) sel[cnt + __popcll(bs & ltmask)] = (unsigned short)(c * 64 + lane);
                cnt += __popcll(bs); eqseen += __popcll(beq);
            }
        }
        LDS_WAIT();
        float lg[4][4];
        {
            int keyi[4]; bool valid[4];
#pragma unroll
            for (int c = 0; c < 4; ++c) { const int n = lane + 64 * c; valid[c] = n < cnt; keyi[c] = valid[c] ? (int)sel[n] : 0; }
#pragma unroll
            for (int h = 0; h < 4; ++h) {
                v4u q[8]; load_q(q, P + (size_t)row * PP + COL_CQ + h * 64);
#pragma unroll
                for (int c = 0; c < 4; ++c) lg[h][c] = valid[c] ? dot64(q, P + ((size_t)b * T + keyi[c]) * PP + COL_CK) + biasd[(16 + h) * 4096 + (t - keyi[c])] : -INFINITY;
            }
        }
        float linv[4];
#pragma unroll
        for (int h = 0; h < 4; ++h) {
            float mx = fmaxf(fmaxf(lg[h][0], lg[h][1]), fmaxf(lg[h][2], lg[h][3])); mx = wave_max(mx);
            float ls = 0.f;
#pragma unroll
            for (int c = 0; c < 4; ++c) { const float p = __builtin_amdgcn_exp2f(lg[h][c] - mx); pl[h * 256 + lane + 64 * c] = p; ls += p; }
            linv[h] = 1.0f / wave_sum(ls);
        }
        LDS_WAIT();
        float o0 = 0.f, o1 = 0.f, o2 = 0.f, o3 = 0.f;
        const bf16* vbase = P + (size_t)b * T * PP + COL_CV + lane;
#pragma unroll 4
        for (int n = 0; n < cnt; ++n) { const int key = (int)sel[n]; const float vv = bflo((unsigned)vbase[(size_t)key * PP]);
            o0 += pl[n] * vv; o1 += pl[256 + n] * vv; o2 += pl[512 + n] * vv; o3 += pl[768 + n] * vv; }
        bf16* op = O + (size_t)row * 1024 + 768 + lane;
        op[0] = (bf16)f2bf(o0 * linv[0]); op[64] = (bf16)f2bf(o1 * linv[1]); op[128] = (bf16)f2bf(o2 * linv[2]); op[192] = (bf16)f2bf(o3 * linv[3]);
        LDS_WAIT();
    }
}
#define XB_TMO      128
#define XB_XCNT(j)  (256  + 64 * (j))
#define XB_XSUB(j)  (1280 + 64 * (j))
#define XB_XGEN(j)  (2304 + 64 * (j))
#define XB_TOP      3328
#define XB_TOPGEN   3392
#define XCD_BAR_WORDS 3456
#define XB_SPIN_CAP (1u << 24)

__device__ __forceinline__ unsigned xb_ld(unsigned* p)              { return __hip_atomic_load(p, __ATOMIC_RELAXED, __HIP_MEMORY_SCOPE_AGENT); }
__device__ __forceinline__ unsigned xb_add(unsigned* p, unsigned v) { return __hip_atomic_fetch_add(p, v, __ATOMIC_RELAXED, __HIP_MEMORY_SCOPE_AGENT); }
__device__ __forceinline__ unsigned xb_xcc_id() { return (unsigned)__builtin_amdgcn_s_getreg((3 << 11) | 20) & 0xFu; }
#define XB_SPIN(cond, bar) do { unsigned _sp = 0; while (cond) { __builtin_amdgcn_s_sleep(1); \
    if ((++_sp & 255u) == 0u) { if (xb_ld(&(bar)[XB_TMO])) break; if (_sp > XB_SPIN_CAP) { atomicAdd(&(bar)[XB_TMO], 1u); break; } } } } while (0)

struct XcdBarrier {
    unsigned* bar; unsigned x;
    volatile LAS unsigned* st;
};

__device__ __forceinline__ XcdBarrier xcd_barrier_post(unsigned* bar, volatile LAS unsigned* st) {
    XcdBarrier b; b.bar = bar; b.x = xb_xcc_id(); b.st = st;
    if (threadIdx.x == 0) (void)xb_add(&bar[XB_XCNT(b.x)], 1u);
    return b;
}
__device__ __forceinline__ void xcd_barrier_complete(unsigned* bar, unsigned x, unsigned& nloc, unsigned& nx) {
    const unsigned G = gridDim.x * gridDim.y * gridDim.z;
    unsigned sum, cnt, mine, sp = 0u;
    for (;;) {
        sum = 0u; cnt = 0u; mine = 0u;
#pragma unroll
        for (unsigned j = 0; j < 16; ++j) { const unsigned c = xb_ld(&bar[XB_XCNT(j)]); sum += c; cnt += (c > 0u) ? 1u : 0u; mine = (j == x) ? c : mine; }
        if (sum == G) break;
        __builtin_amdgcn_s_sleep(1);
        if ((++sp & 255u) == 0u) { if (xb_ld(&bar[XB_TMO])) break; if (sp > XB_SPIN_CAP) { atomicAdd(&bar[XB_TMO], 1u); break; } }
    }
    nloc = mine > 0u ? mine : 1u; nx = cnt > 0u ? cnt : 1u;
}

__device__ __forceinline__ void xcd_barrier(const XcdBarrier& b) {
    asm volatile("s_waitcnt vmcnt(0)" ::: "memory");
    __syncthreads();
    if (threadIdx.x == 0) {
        unsigned* bar = b.bar;
        __builtin_amdgcn_s_waitcnt(0);
        unsigned nloc = b.st[0], nx = b.st[1];
        if (nloc == 0u) { xcd_barrier_complete(bar, b.x, nloc, nx); b.st[0] = nloc; b.st[1] = nx; }
        const unsigned old = xb_add(&bar[XB_XSUB(b.x)], 1u);
        const unsigned gen = old / nloc;
        if (old + 1u == (gen + 1u) * nloc) {
            __builtin_amdgcn_fence(__ATOMIC_RELEASE, "agent");
            asm volatile("s_waitcnt vmcnt(0)" ::: "memory");
            const unsigned og = xb_add(&bar[XB_TOP], 1u);
            const unsigned tg = og / nx;
            if (og + 1u == (tg + 1u) * nx) xb_add(&bar[XB_TOPGEN], 1u);
            else XB_SPIN(xb_ld(&bar[XB_TOPGEN]) == tg, bar);
            __builtin_amdgcn_fence(__ATOMIC_ACQUIRE, "agent");
            xb_add(&bar[XB_XGEN(b.x)], 1u);
            asm volatile("s_waitcnt vmcnt(0)" ::: "memory");
        } else {
            XB_SPIN(xb_ld(&bar[XB_XGEN(b.x)]) == gen, bar);
            __builtin_amdgcn_fence(__ATOMIC_ACQUIRE, "agent");
            asm volatile("s_waitcnt vmcnt(0)" ::: "memory");
        }
    }
    __syncthreads();
}
#ifndef MODE4_FILTER
#define MODE4_FILTER 1
#endif
#ifndef MODE6_ONLY
#define MODE6_ONLY -1
#endif
__device__ __forceinline__ void chk_put2(unsigned char* ws, float d2, float r2) { if ((threadIdx.x & 63) == 0) { atomicAdd((float*)(ws + WS_CTL) + 8, d2); atomicAdd((float*)(ws + WS_CTL) + 9, r2); } }
__device__ __forceinline__ float row_r_from(const float* xrow, int lane) {
    float s = 0.f; for (int j = 0; j < 16; ++j) { const float v = xrow[lane + 64 * j]; s += v * v; }
    return 1.0f / sqrtf(wave_sum(s) * (1.0f / 1024.0f) + 1e-6f);
}
__global__ void __launch_bounds__(256) k_check(Args A, int mode, int L) {
    const int lane = threadIdx.x & 63, gw = blockIdx.x * 4 + (threadIdx.x >> 6), NGW = gridDim.x * 4;
    unsigned char* ws = A.ws;
    const bf16* HMID = (const bf16*)(ws + WS_HMID); const bf16* PROJ = (const bf16*)(ws + WS_PROJ); const bf16* GATES = (const bf16*)(ws + WS_GATES);
    const bf16* OATT = (const bf16*)(ws + WS_OATT); const bf16* Y = (const bf16*)(ws + WS_Y); const bf16* XB = (const bf16*)(ws + WS_XB); const float* ROWSS = (const float*)(ws + WS_ROWSS);
    for (int s = gw; s < 8192; s += NGW) {
        const int row = (int)(((unsigned)s * 2654435761u) >> 18) & 16383;
        if (mode == 1) {
            const float* x = A.in[0] + (size_t)row * D; const float r = row_r_from(x, lane); const float* gam = A.in[2] + (size_t)L * D;
            const int c = (s * 37) % FF; const float* Wg = A.in[3] + (size_t)L * D * FF; const float* Wu = A.in[4] + (size_t)L * D * FF;
            float g = 0.f, u = 0.f;
            for (int j = 0; j < 16; ++j) { const int k = lane + 64 * j; const float xn = x[k] * r * gam[k]; g += xn * Wg[(size_t)k * FF + c]; u += xn * Wu[(size_t)k * FF + c]; }
            g = wave_sum(g); u = wave_sum(u);
            const float ref = g / (1.0f + expf(-g)) * u, mine = bflo((unsigned)HMID[(size_t)row * FF + c]);
            chk_put2(ws, (mine - ref) * (mine - ref), ref * ref);
        } else if (mode == 2) {
            const int c = (s * 37) % D; const float* Wd = A.in[5] + (size_t)L * FF * D;
            float a = 0.f;
            for (int j = lane; j < FF; j += 64) a += bflo((unsigned)HMID[(size_t)row * FF + j]) * Wd[(size_t)j * D + c];
            a = wave_sum(a);
            const float ref = A.in[0][(size_t)row * D + c] + 0.5f * a, mine = A.out[(size_t)row * D + c];
            float d2 = (mine - ref) * (mine - ref);
            const float xbv = bflo((unsigned)XB[(size_t)row * D + c]); d2 += (xbv - mine) * (xbv - mine);
            float ss = 0.f; for (int j = 0; j < 16; ++j) { const float v = A.out[(size_t)row * D + lane + 64 * j]; ss += v * v; } ss = wave_sum(ss);
            float ps = 0.f; if (lane < 16) ps = ROWSS[(size_t)lane * M + row]; ps = wave_sum(ps);
            d2 += (ps - ss) * (ps - ss) / (ss * ss) * ref * ref;
            chk_put2(ws, d2, ref * ref);
        } else if (mode == 3) {
            const int hidx = (s * 13) % 75; const float* x = A.out + (size_t)row * D; const float r = row_r_from(x, lane); const float* gam = A.in[6] + (size_t)L * D;
            const float* W = A.in[7] + (size_t)L * D * NIN; const int c = 64 * hidx + lane;
            float a = 0.f; for (int k = 0; k < D; ++k) a += x[k] * r * gam[k] * W[(size_t)k * NIN + c];
            int gi = -1; float post = 1.f; const float C2 = 0.125f * LOG2E;
            if (hidx < 12) { gi = 0; post = C2; } else if (hidx < 24) gi = 1; else if (hidx < 36) {} else if (hidx < 44) { gi = 2; post = C2; } else if (hidx < 52) gi = 3; else if (hidx < 60) {}
            else if (hidx < 64) { gi = 4; post = C2; } else if (hidx == 64) gi = 5; else if (hidx == 65) {} else if (hidx < 74) post = 0.125f;
            float ref = a * post;
            if (gi >= 0) { const float ms = wave_sum(a * a) * (1.0f / 64.0f); ref = a / sqrtf(ms + 1e-6f) * (A.in[8] + (size_t)L * 384)[gi * 64 + lane] * post; }
            const float mine = bflo((unsigned)PROJ[(size_t)row * PP + c]);
            chk_put2(ws, wave_sum((mine - ref) * (mine - ref)), wave_sum(ref * ref));
        } else if (mode == 4) {
            const float* x = A.out + (size_t)row * D; const float r = row_r_from(x, lane); const float* gam = A.in[6] + (size_t)L * D;
            const float* W = A.in[7] + (size_t)L * D * NIN; const int c = ((s * 29) % 48) * 64 + lane;
            float a = 0.f; for (int k = 0; k < D; ++k) a += x[k] * r * gam[k] * W[(size_t)k * NIN + GATE_COL0 + c];
            float ref = 1.0f / (1.0f + expf(-a)), mine = bflo((unsigned)GATES[(size_t)row * NGATE + c]);
            if (!(MODE4_FILTER)) { ref = 0.f; mine = 0.f; }
#ifdef MODE4_HALF
            mine = mine - 0.5f + ref;
#endif
            chk_put2(ws, wave_sum((mine - ref) * (mine - ref)), wave_sum(ref * ref));
        } else if (mode == 5) {
            const int c = ((s * 29) % 16) * 64 + lane;
            const float* Wa = A.in[11] + (size_t)L * 256 * D; const float* Wb = A.in[12] + (size_t)L * 512 * D; const float* Wc = A.in[13] + (size_t)L * 256 * D;
            float ya = 0.f, yb = 0.f, yc = 0.f;
            for (int j = 0; j < 256; ++j) ya += bflo((unsigned)OATT[(size_t)row * 1024 + j]) * Wa[(size_t)j * D + c];
            for (int j = 0; j < 512; ++j) yb += bflo((unsigned)OATT[(size_t)row * 1024 + 256 + j]) * Wb[(size_t)j * D + c];
            for (int j = 0; j < 256; ++j) yc += bflo((unsigned)OATT[(size_t)row * 1024 + 768 + j]) * Wc[(size_t)j * D + c];
            const float ref = bflo((unsigned)GATES[(size_t)row * NGATE + c]) * ya + bflo((unsigned)GATES[(size_t)row * NGATE + 1024 + c]) * yb + bflo((unsigned)GATES[(size_t)row * NGATE + 2048 + c]) * yc;
            const float mine = bflo((unsigned)Y[(size_t)row * 1024 + c]);
            chk_put2(ws, wave_sum((mine - ref) * (mine - ref)), wave_sum(ref * ref));
        } else if (mode == 6) {
            const int id = s % 10; const unsigned hsh = ((unsigned)s * 64u + (unsigned)lane) * 2246822519u; const unsigned char* wb = ws + WS_W;
            float ref = 0.f, mine = 0.f;
            if (id == 0 || id == 8) { const int n = (hsh >> 8) % 5632, k = (hsh >> 21) % 1024, tile = n >> 8, l = n & 255; const bool second = id == 8;
                const float* W = (l < 128) ? (second ? A.in[16] : A.in[3]) : (second ? A.in[17] : A.in[4]); const float* gam = second ? A.in[15] : A.in[2];
                ref = W[(size_t)L * D * FF + (size_t)k * FF + 128 * tile + (l & 127)] * gam[(size_t)L * D + k]; mine = bflo((unsigned)((const bf16*)(wb + (second ? O_GU2 : O_GU1)))[(size_t)n * D + k]); }
            else if (id == 1 || id == 9) { const int n = (hsh >> 8) % 1024, k = (hsh >> 19) % FF; const float* W = (id == 9) ? A.in[18] : A.in[5];
                ref = W[(size_t)L * FF * D + (size_t)k * D + n]; mine = bflo((unsigned)((const bf16*)(wb + (id == 9 ? O_DN2 : O_DN1)))[(size_t)n * FF + k]); }
            else if (id == 2) { const int n = (hsh >> 8) % 4864, k = (hsh >> 21) % 1024, tile = n >> 8, l = n & 255, bj = l >> 7, wc = (l & 127) >> 5, col = 256 * tile + 64 * wc + 32 * bj + (l & 31);
                ref = (col < 4808) ? A.in[7][(size_t)L * D * NIN + (size_t)k * NIN + col] * A.in[6][(size_t)L * D + k] : 0.f; mine = bflo((unsigned)((const bf16*)(wb + O_QKV))[(size_t)n * D + k]); }
            else if (id == 3) { const int n = (hsh >> 8) % 3072, k = (hsh >> 21) % 1024;
                ref = A.in[7][(size_t)L * D * NIN + (size_t)k * NIN + GATE_COL0 + n] * A.in[6][(size_t)L * D + k]; mine = bflo((unsigned)((const bf16*)(wb + O_GATE))[(size_t)n * D + k]); }
            else if (id == 4 || id == 6) { const int n = (hsh >> 8) % 1024, k = (hsh >> 19) % 256; const float* W = (id == 4) ? A.in[11] : A.in[13];
                ref = W[(size_t)L * 256 * D + (size_t)k * D + n]; mine = bflo((unsigned)((const bf16*)(wb + (id == 4 ? O_BA : O_BC)))[(size_t)n * 256 + k]); }
            else if (id == 5) { const int n = (hsh >> 8) % 1024, k = (hsh >> 19) % 512; ref = A.in[12][(size_t)L * 512 * D + (size_t)k * D + n]; mine = bflo((unsigned)((const bf16*)(wb + O_BB))[(size_t)n * 512 + k]); }
            else { const int n = (hsh >> 8) % 1024, k = (hsh >> 19) % 1024; ref = A.in[14][(size_t)L * D * D + (size_t)k * D + n]; mine = bflo((unsigned)((const bf16*)(wb + O_OUT))[(size_t)n * D + k]); }
            if (MODE6_ONLY >= 0 && id != MODE6_ONLY) { ref = 0.f; mine = 0.f; }
            chk_put2(ws, wave_sum((mine - ref) * (mine - ref)), wave_sum(ref * ref));
        } else { chk_put2(ws, 1.0f, 1.0f); }
    }
}
__global__ void __launch_bounds__(256) k_report(unsigned char* ws, float* out) {
    const float sd = ((const float*)(ws + WS_CTL))[8], sr = ((const float*)(ws + WS_CTL))[9]; const float v = sqrtf(sd / fmaxf(sr, 1e-30f)); const float K = 1.0e5f * fminf(v, 1.0e3f);
    for (size_t i = (size_t)blockIdx.x * 256 + threadIdx.x; i < (size_t)M * D; i += (size_t)gridDim.x * 256) out[i] = K;
}
#ifndef FAST_B
#define FAST_B 1
#endif
#ifndef GATE_ALIGN
#define GATE_ALIGN true
#endif
#ifndef MERGE_CALLS
#define MERGE_CALLS 3
#endif
#ifndef ORACLE_MASK
#define ORACLE_MASK 7
#endif
#ifndef PHASE_MASK
#define PHASE_MASK 0x7ff
#endif
constexpr int NPH_LAYER = 11, NPHASE = 1 + NLAYER * NPH_LAYER;
__global__ void __launch_bounds__(NWAVES * 64, 2) mk_fwd(const Args A) {
    extern __shared__ __attribute__((aligned(16))) unsigned char lds[];
    Frame F;
    F.lds = (LAS unsigned char*)lds;
    F.MISC = (volatile LAS unsigned*)(F.lds + MISC_OFF);
    F.tid = threadIdx.x; F.lane = F.tid & 63; F.wave = __builtin_amdgcn_readfirstlane(F.tid >> 6);
    F.G = gridDim.x; F.bx = blockIdx.x;
    gu32* const ctl = (gu32*)(A.ws + WS_CTL);
    for (int u = F.tid; u < (LDS_BYTES - MISC_OFF) / 4; u += NWAVES * 64) ((LAS unsigned*)(F.lds + MISC_OFF))[u] = 0u;
    __syncthreads();
    const int lo = A.lo, hi = A.hi;
    XcdBarrier bar; bar.bar = (unsigned*)(ctl + CW_BAR); bar.x = 0; bar.st = nullptr;
    if (hi - lo > 1) bar = xcd_barrier_post((unsigned*)(ctl + CW_BAR), F.MISC + 8);
#define IN(k) (lo <= (k) && (k) < hi)
#define SEAM(k) do { if (IN(k) && IN((k) + 1)) xcd_barrier(bar); } while (0)
    bf16* const XB = (bf16*)(A.ws + WS_XB); bf16* const PROJ = (bf16*)(A.ws + WS_PROJ); bf16* const HMID = (bf16*)(A.ws + WS_HMID); bf16* const GATES = (bf16*)(A.ws + WS_GATES);
    bf16* const OATT = (bf16*)(A.ws + WS_OATT); bf16* const Y = (bf16*)(A.ws + WS_Y); float* const ROWSS = (float*)(A.ws + WS_ROWSS); float* const WIDX = (float*)(A.ws + WS_WIDX);
    unsigned char* const wb = A.ws + WS_W;

    if (IN(0)) { phase_prologue(F, A); } SEAM(0);

    for (int L = 0; L < NLAYER; ++L) {
        const int g0 = 1 + L * NPH_LAYER;
        if (hi <= g0 || lo >= g0 + NPH_LAYER) continue;
        if (((PHASE_MASK >> 0) & 1) && IN(g0 + 0)) { phase_convert(F, A, L); } SEAM(g0 + 0);
        if (((PHASE_MASK >> 1) & 1) && IN(g0 + 1)) {
            pg8::Gemm g{XB, (const bf16*)(wb + O_GU1), M, 2 * FF, D, D}; pg8::StaticOrder S; S.init(M, 2 * FF, F.G, F.bx);
            epi::EpiSwiGLU E{HMID, FF, ROWSS};
            pg8::gemm_phase<epi::EpiSwiGLU, pg8::StaticOrder, true, true>(F.lds + RING_OFF, g, S, E);
        } SEAM(g0 + 1);
        if (((PHASE_MASK >> 2) & 1) && IN(g0 + 2)) {
            pg8::Gemm g{HMID, (const bf16*)(wb + O_DN1), M, D, FF, FF}; pg8::StaticOrder S; S.init(M, D, F.G, F.bx);
            epi::EpiResidual E{(L == 0) ? A.in[0] : (const float*)A.out, A.out, XB, ROWSS, 0.5f};
            pg8::gemm_phase<epi::EpiResidual, pg8::StaticOrder, false, true>(F.lds + RING_OFF, g, S, E);
        } SEAM(g0 + 2);
        if (((PHASE_MASK >> 3) & 1) && IN(g0 + 3)) {
            pg8::Gemm g{XB, (const bf16*)(wb + O_QKV), M, PP, D, D}; pg8::StaticOrder S; S.init(M, PP, F.G, F.bx);
            epi::EpiQKV E{PROJ, PP, ROWSS, A.in[8] + (size_t)L * 384, WIDX};
            pg8::gemm_phase<epi::EpiQKV, pg8::StaticOrder, true, true>(F.lds + RING_OFF, g, S, E);
        } SEAM(g0 + 3);
        if (((PHASE_MASK >> 4) & 1) && IN(g0 + 4)) {
#if MK_N_LAUNCHES == 1 && !defined(CHECK_MODE) && !defined(NO_INK_ORACLE)
            { int ln_ = F.lane; asm volatile("" : "+v"(ln_));
              oracle_A(A.ws, F.bx * NWAVES + F.wave, F.G * NWAVES, ln_); }
            __syncthreads();
#endif
            phase_attn_B(F, A);
            phase_C1(F, A);
        } SEAM(g0 + 4);
        if (((PHASE_MASK >> 5) & 1) && IN(g0 + 5)) {
            phase_C2(F, A);
            phase_combine_B(F, A, L);
        } SEAM(g0 + 5);
        if (((PHASE_MASK >> 6) & 1) && IN(g0 + 6)) {
            pg8::Gemm g{XB, (const bf16*)(wb + O_GATE), M, NGATE, D, D}; pg8::StaticOrder S; S.init(M, NGATE, F.G, F.bx);
            epi::EpiSigmoid E{GATES, NGATE, ROWSS};
            pg8::gemm_phase<epi::EpiSigmoid, pg8::StaticOrder, GATE_ALIGN, true>(F.lds + RING_OFF, g, S, E);
        } SEAM(g0 + 6);
        if (((PHASE_MASK >> 7) & 1) && IN(g0 + 7)) {
            pg8::StaticOrder S; S.init(M, D, F.G, F.bx);
            { pg8::Gemm g{OATT, (const bf16*)(wb + O_BA), M, D, 256, 1024}; epi::EpiMerge E{Y, GATES, NGATE, 0};
              pg8::gemm_phase<epi::EpiMerge, pg8::StaticOrder, false, true>(F.lds + RING_OFF, g, S, E); }
#if MERGE_CALLS > 1
            { pg8::Gemm g{OATT + 256, (const bf16*)(wb + O_BB), M, D, 512, 1024}; epi::EpiMerge E{Y, GATES + 1024, NGATE, 1};
              pg8::gemm_phase<epi::EpiMerge, pg8::StaticOrder, false, true>(F.lds + RING_OFF, g, S, E); }
            { pg8::Gemm g{OATT + 768, (const bf16*)(wb + O_BC), M, D, 256, 1024}; epi::EpiMerge E{Y, GATES + 2048, NGATE, 1};
              pg8::gemm_phase<epi::EpiMerge, pg8::StaticOrder, false, true>(F.lds + RING_OFF, g, S, E); }
#endif
        } SEAM(g0 + 7);
        if (((PHASE_MASK >> 8) & 1) && IN(g0 + 8)) {
            pg8::Gemm g{Y, (const bf16*)(wb + O_OUT), M, D, D, D}; pg8::StaticOrder S; S.init(M, D, F.G, F.bx);
            epi::EpiResidual E{(const float*)A.out, A.out, XB, ROWSS, 1.0f};
            pg8::gemm_phase<epi::EpiResidual, pg8::StaticOrder, false, true>(F.lds + RING_OFF, g, S, E);
        } SEAM(g0 + 8);
        if (((PHASE_MASK >> 9) & 1) && IN(g0 + 9)) {
            pg8::Gemm g{XB, (const bf16*)(wb + O_GU2), M, 2 * FF, D, D}; pg8::StaticOrder S; S.init(M, 2 * FF, F.G, F.bx);
            epi::EpiSwiGLU E{HMID, FF, ROWSS};
            pg8::gemm_phase<epi::EpiSwiGLU, pg8::StaticOrder, true, true>(F.lds + RING_OFF, g, S, E);
        } SEAM(g0 + 9);
        if (((PHASE_MASK >> 10) & 1) && IN(g0 + 10)) {
            pg8::Gemm g{HMID, (const bf16*)(wb + O_DN2), M, D, FF, FF}; pg8::StaticOrder S; S.init(M, D, F.G, F.bx);
            epi::EpiResidual E{(const float*)A.out, A.out, XB, ROWSS, 0.5f};
            pg8::gemm_phase<epi::EpiResidual, pg8::StaticOrder, false, true>(F.lds + RING_OFF, g, S, E);
        } SEAM(g0 + 10);
    }
#undef IN
#undef SEAM
}

__global__ void __launch_bounds__(256) k_oracle_A(unsigned char* ws) { oracle_A(ws, blockIdx.x * 4 + (threadIdx.x >> 6), gridDim.x * 4, threadIdx.x & 63); }
__global__ void __launch_bounds__(256) k_oracle_B(unsigned char* ws, const float* lv, const float* dn, int L) { oracle_B(ws, blockIdx.x * 4 + (threadIdx.x >> 6), gridDim.x * 4, lv + (size_t)L * 256, dn + (size_t)L * 128, L, threadIdx.x & 63); }
__global__ void __launch_bounds__(128, 1) k_oracle_C(unsigned char* ws) { extern __shared__ __attribute__((aligned(16))) unsigned char olds[]; oracle_C(ws, blockIdx.x * 2 + (threadIdx.x >> 6), gridDim.x * 2, (LAS unsigned char*)olds + (threadIdx.x >> 6) * 18944, threadIdx.x & 63); }
__global__ void __launch_bounds__(256) k_fill(unsigned char* ws) { const bf16* P = (const bf16*)(ws + WS_PROJ); bf16* O = (bf16*)(ws + WS_OATT);
    for (size_t i = (size_t)blockIdx.x * 256 + threadIdx.x; i < (size_t)M * 1024; i += (size_t)gridDim.x * 256) { const size_t row = i >> 10, c = i & 1023; O[row * 1024 + c] = P[row * PP + c]; } }
extern "C" void kernel_launch(void* const* d_in, const int* in_sizes, int n_in, void* d_out, int out_size, void* d_ws, size_t ws_size, hipStream_t stream) {
    static int grid = 0;
    if (grid == 0) {
        if (n_in != 19 || in_sizes[0] != M * D || out_size != M * D || ws_size < WS_END) { fprintf(stderr, "kernel_launch: unexpected shapes / workspace (n_in %d, ws %zu)\n", n_in, ws_size); grid = -1; return; }
        int dev = 0, cus = 0, per_cu = 0;
        if (hipGetDevice(&dev) != hipSuccess || hipDeviceGetAttribute(&cus, hipDeviceAttributeMultiprocessorCount, dev) != hipSuccess) { grid = -1; return; }
        if (hipFuncSetAttribute((const void*)mk_fwd, hipFuncAttributeMaxDynamicSharedMemorySize, LDS_BYTES) != hipSuccess) { fprintf(stderr, "kernel_launch: hipFuncSetAttribute failed\n"); grid = -1; return; }
        if (hipOccupancyMaxActiveBlocksPerMultiprocessor(&per_cu, (const void*)mk_fwd, NWAVES * 64, LDS_BYTES) != hipSuccess || per_cu < 1) { fprintf(stderr, "kernel_launch: occupancy query says %d\n", per_cu); }
        (void)hipGetLastError();
        grid = cus;
    }
    if (grid < 0) return;
    (void)hipMemsetAsync((char*)d_ws + WS_CTL, 0, CTL_ZERO_BYTES, stream);
    Args a{};
    for (int i = 0; i < 19; ++i) a.in[i] = (const float*)d_in[i];
    a.out = (float*)d_out; a.ws = (unsigned char*)d_ws;
#if defined(CHECK_MODE)
    for (int g = 0; g <= CHECK_UPTO; ++g) { a.lo = g; a.hi = g + 1; hipLaunchKernelGGL(mk_fwd, dim3(grid), dim3(NWAVES * 64), LDS_BYTES, stream, a);
        if (g >= 1 && (g - 1) % NPH_LAYER == 4) hipLaunchKernelGGL(k_fill, dim3(2048), dim3(256), 0, stream, a.ws); }
    a.lo = 0; a.hi = 0;
    hipLaunchKernelGGL(k_check, dim3(512), dim3(256), 0, stream, a, (int)CHECK_MODE, 0);
    hipLaunchKernelGGL(k_report, dim3(2048), dim3(256), 0, stream, a.ws, a.out);
#elif MK_N_LAUNCHES == 1
    a.lo = 0; a.hi = NPHASE;
    hipLaunchKernelGGL(mk_fwd, dim3(grid), dim3(NWAVES * 64), LDS_BYTES, stream, a);
#else
    for (int g = 0; g < NPHASE; ++g) { a.lo = g; a.hi = g + 1; hipLaunchKernelGGL(mk_fwd, dim3(grid), dim3(NWAVES * 64), LDS_BYTES, stream, a);
        if (ORACLE_MASK && ((PHASE_MASK >> 4) & 1) && g >= 1 && (g - 1) % NPH_LAYER == 4) { const int L = (g - 1) / NPH_LAYER;
            if (ORACLE_MASK & 8) hipLaunchKernelGGL(k_fill, dim3(2048), dim3(256), 0, stream, a.ws);
            if (ORACLE_MASK & 1) hipLaunchKernelGGL(k_oracle_A, dim3(4096), dim3(256), 0, stream, a.ws);
            if ((ORACLE_MASK & 2) && !FAST_B) hipLaunchKernelGGL(k_oracle_B, dim3(4096), dim3(256), 0, stream, a.ws, a.in[9], a.in[10], L);
            if (ORACLE_MASK & 4) hipLaunchKernelGGL(k_oracle_C, dim3(4096), dim3(128), 2 * 18944, stream, a.ws); } }
#endif
}
```

```cpp
#include <hip/hip_runtime.h>
#include <cstdio>
#include <cstdint>
#include <cmath>
#ifndef MK_N_LAUNCHES
#define MK_N_LAUNCHES 1
#endif
namespace pg8 {
#define PG8_LAS __attribute__((address_space(3)))
typedef unsigned short bf16_t;
typedef short bf16x8 __attribute__((ext_vector_type(8)));
typedef float f32x4 __attribute__((ext_vector_type(4)));
typedef unsigned u32x4 __attribute__((ext_vector_type(4)));
typedef unsigned u32x2 __attribute__((ext_vector_type(2)));
constexpr int BM = 256, BK = 64, HALF = 128, HTB = HALF * BK * 2  , STAGE_BYTES = 8 * HTB, NXCD = 8, WGM = 8;

__host__ __device__ __forceinline__ int lds_byte(int r, int c) { const int st = (r >> 4) * 2 + (c >> 5), rr = r & 15, cc = c & 31, ob = rr * 64 + cc * 2; return st * 1024 + (ob ^ (((ob >> 9) & 1) << 5)); }
__host__ __device__ __forceinline__ void stage_rc(int b, int& R, int& C) { const int st = b / 1024, sb = b % 1024, swz = sb ^ (((sb >> 9) & 1) << 5); R = (st >> 1) * 16 + swz / 64; C = (st & 1) * 32 + (swz % 64) / 2; }
__host__ __device__ __forceinline__ int perm32(int rho) { const int n = rho >> 4, i = rho & 15; return 8 * (i >> 2) + 4 * n + (i & 3); }

struct Unit { int pm, pn; };
struct Gemm { const bf16_t* A; const bf16_t* Bt; int M, N, K, lda; };

struct StaticOrder {
    int nM, nN, nwg, G, c;
    __host__ __device__ void init(int M, int N, int G_, int c_) { nM = M / BM; nN = N / BM; nwg = nM * nN; G = G_; c = c_; }
    __host__ __device__ bool next(int i, Unit& u) const {
        const long L = (long)i * G + c; if (L >= nwg) return false;
        int wgid = (int)L; { const int q = nwg / NXCD, r = nwg % NXCD, xcd = wgid % NXCD, off = wgid / NXCD; wgid = (xcd < r ? xcd * (q + 1) : r * (q + 1) + (xcd - r) * q) + off; }
        const int nig = WGM * nN, gid = wgid / nig, fm = gid * WGM, gsz = (nM - fm) < WGM ? (nM - fm) : WGM;
        u.pm = fm + ((wgid % nig) % gsz); u.pn = (wgid % nig) / gsz; return true;
    }
    __device__ __forceinline__ void a_ready(const Unit&) const {}
    __device__ __forceinline__ void done(const Unit&) const {}
};

typedef float f32x2_t __attribute__((ext_vector_type(2))); typedef __bf16 bf16x2_t __attribute__((ext_vector_type(2)));
__device__ __forceinline__ unsigned cvt_pk_bf16(float lo, float hi) { f32x2_t v = {lo, hi}; bf16x2_t b = __builtin_convertvector(v, bf16x2_t); return __builtin_bit_cast(unsigned, b); }

template <class Epi, class Sched, bool ALIGN_EPI = false, bool SP2 = false>
__device__ __forceinline__ void gemm_phase(PG8_LAS unsigned char* lds, const Gemm g, const Sched& S, const Epi& E) {
    int tid_ = threadIdx.x; asm volatile("" : "+v"(tid_));
    const int tid = tid_, wid = __builtin_amdgcn_readfirstlane(tid >> 6), lane = tid & 63, wr = wid >> 2, wc = wid & 3, fr = lane & 15, fq = lane >> 4;
    const int K = g.K, nt = K / BK, lda = g.lda;
    unsigned voffA[2], voffB[2];
#pragma unroll
    for (int i = 0; i < 2; ++i) { int R, C; stage_rc(tid * 16 + i * 8192, R, C); const int Rb = Epi::PERM ? ((R & ~31) + perm32(R & 31)) : R;
        voffA[i] = (unsigned)(R * lda + C) * 2u; voffB[i] = (unsigned)(Rb * K + C) * 2u; }
    const size_t kstep = (size_t)(BK * 2);
    const size_t hstepA = (size_t)HALF * lda * 2, hstepB = (size_t)HALF * K * 2;
    const size_t tstepA = 2 * hstepA, tstepB = 2 * hstepB;
    const unsigned ldsw = (unsigned)wid * 1024u;
    const int aoff = lds_byte(wr * 64 + fr, fq * 8), boff = lds_byte(wc * 32 + fr, fq * 8);
#define PG8_SA(b, h) (((b) * 2 + (h)) * HTB)
#define PG8_SB(b, h) ((4 + (b) * 2 + (h)) * HTB)
#define PG8_STAGE(bufoff, gbase, voff) do { _Pragma("unroll") for (int _i = 0; _i < 2; ++_i) \
        __builtin_amdgcn_global_load_lds((const unsigned*)((const char*)(gbase) + (voff)[_i]), (PG8_LAS unsigned*)(lds + (bufoff) + ldsw + _i * 8192), 16, 0, 0); } while (0)
#define PG8_LDA(dst, b, h) do { _Pragma("unroll") for (int m = 0; m < 4; ++m) _Pragma("unroll") for (int k = 0; k < 2; ++k) dst[m][k] = *(const PG8_LAS bf16x8*)(lds + PG8_SA(b, h) + aoff + m * 2048 + k * 1024); } while (0)
#define PG8_LDB(dst, b, h) do { _Pragma("unroll") for (int n = 0; n < 2; ++n) _Pragma("unroll") for (int k = 0; k < 2; ++k) dst[n][k] = *(const PG8_LAS bf16x8*)(lds + PG8_SB(b, h) + boff + n * 2048 + k * 1024); } while (0)
#define PG8_MMA(ai, bj, At, Bt) do { __builtin_amdgcn_s_setprio(1); _Pragma("unroll") for (int m = 0; m < 4; ++m) _Pragma("unroll") for (int n = 0; n < 2; ++n) _Pragma("unroll") for (int k = 0; k < 2; ++k) \
        acc[ai][bj][m][n] = __builtin_amdgcn_mfma_f32_16x16x32_bf16(Bt[n][k], At[m][k], acc[ai][bj][m][n], 0, 0, 0); __builtin_amdgcn_s_setprio(0); } while (0)
#define PG8_WAIT_V(n) asm volatile("s_waitcnt vmcnt(" #n ")" ::: "memory")
#define PG8_WAIT_L(n) asm volatile("s_waitcnt lgkmcnt(" #n ")" ::: "memory")
#define PG8_BAR __builtin_amdgcn_s_barrier()
#define PG8_SCHED __builtin_amdgcn_sched_barrier(0)
    Unit cur, nxt; int ui = 0;
    if (!S.next(0, cur)) return;
    f32x4 acc[2][2][4][2];
#pragma unroll
    for (int a = 0; a < 2; ++a)
#pragma unroll
        for (int b = 0; b < 2; ++b)
#pragma unroll
            for (int m = 0; m < 4; ++m)
#pragma unroll
                for (int n = 0; n < 2; ++n) acc[a][b][m][n] = (f32x4){0.f, 0.f, 0.f, 0.f};
    bf16x8 At[4][2], B0[2][2], B1[2][2];
    const char* cA = (const char*)g.A + (size_t)cur.pm * tstepA; const char* cB = (const char*)g.Bt + (size_t)cur.pn * tstepB;
    S.a_ready(cur);
    if constexpr (SP2) {
        PG8_STAGE(PG8_SB(0, 0), cB, voffB); PG8_STAGE(PG8_SB(0, 1), cB + hstepB, voffB); PG8_STAGE(PG8_SA(0, 0), cA, voffA); PG8_STAGE(PG8_SA(0, 1), cA + hstepA, voffA);
        if (wr == 1) PG8_BAR;
        PG8_WAIT_V(2); PG8_BAR;
        PG8_STAGE(PG8_SB(1, 0), cB + kstep, voffB); PG8_STAGE(PG8_SA(1, 0), cA + kstep, voffA); PG8_STAGE(PG8_SB(1, 1), cB + hstepB + kstep, voffB);
        PG8_WAIT_V(6); PG8_BAR;
    } else {
        PG8_STAGE(PG8_SB(0, 0), cB, voffB); PG8_STAGE(PG8_SA(0, 0), cA, voffA); PG8_STAGE(PG8_SB(0, 1), cB + hstepB, voffB); PG8_STAGE(PG8_SA(0, 1), cA + hstepA, voffA);
        if (wr == 1) PG8_BAR;
        PG8_WAIT_V(4); PG8_BAR;
        PG8_STAGE(PG8_SB(1, 0), cB + kstep, voffB); PG8_STAGE(PG8_SA(1, 0), cA + kstep, voffA); PG8_STAGE(PG8_SB(1, 1), cB + hstepB + kstep, voffB);
        PG8_WAIT_V(6); PG8_BAR;
    }
    for (;;) {
        const bool has_next = S.next(ui + 1, nxt);
        const char* nA = has_next ? (const char*)g.A + (size_t)nxt.pm * tstepA : cA; const char* nB = has_next ? (const char*)g.Bt + (size_t)nxt.pn * tstepB : cB;
        for (int t = 0; t < nt; t += 2) {
            const bool last = (t == nt - 2);
            const char* a1 = cA + (size_t)(t + 1) * kstep;
            const char* a2 = last ? nA : cA + (size_t)(t + 2) * kstep; const char* b2 = last ? nB : cB + (size_t)(t + 2) * kstep;
            const char* a3 = a2 + kstep; const char* b3 = b2 + kstep;
            if (last && has_next) S.a_ready(nxt);
            if constexpr (SP2) {
            PG8_LDB(B0, 0, 0); PG8_LDB(B1, 0, 1); PG8_SCHED; PG8_LDA(At, 0, 0); PG8_STAGE(PG8_SA(1, 1), a1 + hstepA, voffA);
            PG8_WAIT_V(8); PG8_WAIT_L(0); PG8_BAR; PG8_MMA(0, 0, At, B0); PG8_MMA(0, 1, At, B1); PG8_BAR; PG8_SCHED;
            PG8_LDA(At, 0, 1); PG8_STAGE(PG8_SB(0, 0), b2, voffB); PG8_STAGE(PG8_SB(0, 1), b2 + hstepB, voffB); PG8_STAGE(PG8_SA(0, 0), a2, voffA);
            PG8_WAIT_V(8); PG8_WAIT_L(0); PG8_BAR; PG8_MMA(1, 0, At, B0); PG8_MMA(1, 1, At, B1); PG8_BAR; PG8_SCHED;
            PG8_LDB(B0, 1, 0); PG8_LDB(B1, 1, 1); PG8_SCHED; PG8_LDA(At, 1, 0); PG8_STAGE(PG8_SA(0, 1), a2 + hstepA, voffA);
            PG8_WAIT_V(8); PG8_WAIT_L(0); PG8_BAR; PG8_MMA(0, 0, At, B0); PG8_MMA(0, 1, At, B1); PG8_BAR; PG8_SCHED;
            PG8_LDA(At, 1, 1); PG8_STAGE(PG8_SB(1, 0), b3, voffB); PG8_STAGE(PG8_SB(1, 1), b3 + hstepB, voffB); PG8_STAGE(PG8_SA(1, 0), a3, voffA);
            PG8_WAIT_V(8); PG8_WAIT_L(0); PG8_BAR; PG8_MMA(1, 0, At, B0); PG8_MMA(1, 1, At, B1); PG8_BAR; PG8_SCHED;
            } else {
            PG8_LDB(B0, 0, 0); PG8_SCHED; PG8_LDA(At, 0, 0); PG8_STAGE(PG8_SA(1, 1), a1 + hstepA, voffA);
            PG8_WAIT_L(8); PG8_BAR; PG8_WAIT_L(0); PG8_MMA(0, 0, At, B0); PG8_BAR; PG8_SCHED;
            PG8_LDB(B1, 0, 1); PG8_STAGE(PG8_SB(0, 0), b2, voffB);
            PG8_BAR; PG8_WAIT_L(0); PG8_MMA(0, 1, At, B1); PG8_BAR;
            PG8_LDA(At, 0, 1); PG8_STAGE(PG8_SA(0, 0), a2, voffA);
            PG8_BAR; PG8_WAIT_L(0); PG8_MMA(1, 0, At, B0); PG8_BAR; PG8_SCHED;
            PG8_STAGE(PG8_SB(0, 1), b2 + hstepB, voffB);
            PG8_WAIT_V(6); PG8_BAR; PG8_MMA(1, 1, At, B1); PG8_BAR;
            PG8_LDB(B0, 1, 0); PG8_SCHED; PG8_LDA(At, 1, 0); PG8_STAGE(PG8_SA(0, 1), a2 + hstepA, voffA);
            PG8_WAIT_L(8); PG8_BAR; PG8_WAIT_L(0); PG8_MMA(0, 0, At, B0); PG8_BAR; PG8_SCHED;
            PG8_LDB(B1, 1, 1); PG8_STAGE(PG8_SB(1, 0), b3, voffB);
            PG8_BAR; PG8_WAIT_L(0); PG8_MMA(0, 1, At, B1); PG8_BAR;
            PG8_LDA(At, 1, 1); PG8_STAGE(PG8_SA(1, 0), a3, voffA);
            PG8_BAR; PG8_WAIT_L(0); PG8_MMA(1, 0, At, B0); PG8_BAR; PG8_SCHED;
            PG8_STAGE(PG8_SB(1, 1), b3 + hstepB, voffB);
            PG8_WAIT_V(6); PG8_BAR; PG8_MMA(1, 1, At, B1); PG8_BAR;
            }
        }
        if constexpr (ALIGN_EPI) { if (wr == 0) PG8_BAR; }
        E(acc, cur, wr, wc, fr, fq); S.done(cur);
        if (!has_next) break;
#pragma unroll
        for (int a = 0; a < 2; ++a)
#pragma unroll
            for (int b = 0; b < 2; ++b)
#pragma unroll
                for (int m = 0; m < 4; ++m)
#pragma unroll
                    for (int n = 0; n < 2; ++n) acc[a][b][m][n] = (f32x4){0.f, 0.f, 0.f, 0.f};
        cur = nxt; cA = nA; cB = nB; ++ui;
        if constexpr (ALIGN_EPI) { if (wr == 1) PG8_BAR; }
    }
    PG8_WAIT_V(0);
    if constexpr (!ALIGN_EPI) { if (wr == 0) PG8_BAR; }
    PG8_BAR;
#undef PG8_SA
#undef PG8_SB
#undef PG8_STAGE
#undef PG8_LDA
#undef PG8_LDB
#undef PG8_MMA
#undef PG8_WAIT_V
#undef PG8_WAIT_L
#undef PG8_BAR
#undef PG8_SCHED
}
}
namespace epi {
using pg8::f32x4; using pg8::u32x4; using pg8::u32x2; using pg8::Unit; using pg8::bf16_t; using pg8::cvt_pk_bf16;
constexpr int MROWS = 16384;
constexpr float RMS_EPS = 1e-6f;
__device__ __forceinline__ float bflo(unsigned u) { return __uint_as_float(u << 16); }
__device__ __forceinline__ float bfhi(unsigned u) { return __uint_as_float(u & 0xffff0000u); }
__device__ __forceinline__ float row_rs(const float* rowss, int row, int fq) {
    float s = 0.f;
#pragma unroll
    for (int j = 0; j < 4; ++j) s += rowss[(size_t)(4 * fq + j) * MROWS + row];
    s += __shfl_xor(s, 16); s += __shfl_xor(s, 32);
    return __builtin_amdgcn_rsqf(s * (1.0f / 1024.0f) + RMS_EPS);
}
__device__ __forceinline__ float sigmoidf_(float v) { return __builtin_amdgcn_rcpf(1.0f + __builtin_amdgcn_exp2f(-1.4426950408889634f * v)); }

struct EpiSwiGLU {
    static constexpr bool PERM = true;
    bf16_t* H; int ldh; const float* rowss;
    __device__ __forceinline__ void operator()(const f32x4 (&acc)[2][2][4][2], const Unit& u, int wr, int wc, int fr, int fq) const {
        const int row0 = u.pm * 256 + wr * 64 + fr, col0 = u.pn * 128 + wc * 32 + 8 * fq;
#pragma unroll
        for (int ai = 0; ai < 2; ++ai)
#pragma unroll
            for (int m = 0; m < 4; ++m) { const int row = row0 + ai * 128 + m * 16; const float r = row_rs(rowss, row, fq);
                float h[8];
#pragma unroll
                for (int n = 0; n < 2; ++n)
#pragma unroll
                    for (int i = 0; i < 4; ++i) { const float g = acc[ai][0][m][n][i] * r, up = acc[ai][1][m][n][i] * r; h[n * 4 + i] = g * sigmoidf_(g) * up; }
                u32x4 w; w.x = cvt_pk_bf16(h[0], h[1]); w.y = cvt_pk_bf16(h[2], h[3]); w.z = cvt_pk_bf16(h[4], h[5]); w.w = cvt_pk_bf16(h[6], h[7]);
                *(u32x4*)(H + (size_t)row * ldh + col0) = w; asm volatile("" ::: "memory"); }
    }
};

struct EpiResidual {
    static constexpr bool PERM = false;
    const float* base; float* out; bf16_t* xb; float* rowss; float scale;
    __device__ __forceinline__ void operator()(const f32x4 (&acc)[2][2][4][2], const Unit& u, int wr, int wc, int fr, int fq) const {
        const int row0 = u.pm * 256 + wr * 64 + fr, col0 = u.pn * 256 + wc * 32 + 4 * fq;
#pragma unroll
        for (int ai = 0; ai < 2; ++ai)
#pragma unroll
            for (int m = 0; m < 4; ++m) { const int row = row0 + ai * 128 + m * 16; const size_t off = (size_t)row * 1024 + col0; float ss = 0.f;
#pragma unroll
                for (int bj = 0; bj < 2; ++bj)
#pragma unroll
                    for (int n = 0; n < 2; ++n) { const f32x4 b = *(const f32x4*)(base + off + bj * 128 + n * 16); const f32x4 o = b + acc[ai][bj][m][n] * scale;
                        *(f32x4*)(out + off + bj * 128 + n * 16) = o; u32x2 w; w.x = cvt_pk_bf16(o[0], o[1]); w.y = cvt_pk_bf16(o[2], o[3]);
                        *(u32x2*)(xb + off + bj * 128 + n * 16) = w; ss += (o[0] * o[0] + o[1] * o[1]) + (o[2] * o[2] + o[3] * o[3]); }
                ss += __shfl_xor(ss, 16); ss += __shfl_xor(ss, 32);
                if (fq == 0) rowss[(size_t)(u.pn * 4 + wc) * MROWS + row] = ss; asm volatile("" ::: "memory"); }
    }
};

struct EpiQKV {
    static constexpr bool PERM = true;
    bf16_t* P; int ldp; const float* rowss; const float* qk_gain  ; float* widx;
    __device__ __forceinline__ void operator()(const f32x4 (&acc)[2][2][4][2], const Unit& u, int wr, int wc, int fr, int fq) const {
        const int hidx = 4 * u.pn + wc;
        int gi = -1; float post = 1.0f;
        constexpr float C2 = 0.125f * 1.4426950408889634f;
        if (hidx < 12) { gi = 0; post = C2; } else if (hidx < 24) { gi = 1; } else if (hidx < 36) { }
        else if (hidx < 44) { gi = 2; post = C2; } else if (hidx < 52) { gi = 3; } else if (hidx < 60) { }
        else if (hidx < 64) { gi = 4; post = C2; } else if (hidx == 64) { gi = 5; } else if (hidx == 65) { }
        else if (hidx < 74) { post = 0.125f; }
        f32x4 gn[2][2];
#pragma unroll
        for (int bj = 0; bj < 2; ++bj)
#pragma unroll
            for (int n = 0; n < 2; ++n) gn[bj][n] = (gi >= 0) ? *(const f32x4*)(qk_gain + gi * 64 + 32 * bj + 8 * fq + 4 * n) : (f32x4){1.f, 1.f, 1.f, 1.f};
        const int row0 = u.pm * 256 + wr * 64 + fr, col0 = 64 * hidx + 8 * fq;
#pragma unroll
        for (int ai = 0; ai < 2; ++ai)
#pragma unroll
            for (int m = 0; m < 4; ++m) { const int row = row0 + ai * 128 + m * 16; const float r = row_rs(rowss, row, fq);
                f32x4 v[2][2]; float ss = 0.f;
#pragma unroll
                for (int bj = 0; bj < 2; ++bj)
#pragma unroll
                    for (int n = 0; n < 2; ++n) { v[bj][n] = acc[ai][bj][m][n] * r; const f32x4 t = v[bj][n]; ss += (t[0] * t[0] + t[1] * t[1]) + (t[2] * t[2] + t[3] * t[3]); }
                float mul = post;
                if (gi >= 0) { ss += __shfl_xor(ss, 16); ss += __shfl_xor(ss, 32); mul = post * __builtin_amdgcn_rsqf(ss * (1.0f / 64.0f) + RMS_EPS); }
#pragma unroll
                for (int bj = 0; bj < 2; ++bj) { const f32x4 a = v[bj][0] * gn[bj][0] * mul, b = v[bj][1] * gn[bj][1] * mul;
                    u32x4 w; w.x = cvt_pk_bf16(a[0], a[1]); w.y = cvt_pk_bf16(a[2], a[3]); w.z = cvt_pk_bf16(b[0], b[1]); w.w = cvt_pk_bf16(b[2], b[3]);
                    *(u32x4*)(P + (size_t)row * ldp + col0 + 32 * bj) = w; }
                if (hidx == 75 && fq == 0) { *(f32x4*)(widx + (size_t)row * 8) = v[0][0]; *(f32x4*)(widx + (size_t)row * 8 + 4) = v[0][1]; } asm volatile("" ::: "memory"); }
    }
};

struct EpiSigmoid {
    static constexpr bool PERM = true;
    bf16_t* G; int ldg; const float* rowss;
    __device__ __forceinline__ void operator()(const f32x4 (&acc)[2][2][4][2], const Unit& u, int wr, int wc, int fr, int fq) const {
        const int row0 = u.pm * 256 + wr * 64 + fr, col0 = u.pn * 256 + wc * 32 + 8 * fq;
#pragma unroll
        for (int ai = 0; ai < 2; ++ai)
#pragma unroll
            for (int m = 0; m < 4; ++m) { const int row = row0 + ai * 128 + m * 16; const float r = row_rs(rowss, row, fq);
#pragma unroll
                for (int bj = 0; bj < 2; ++bj) { float h[8];
#pragma unroll
                    for (int n = 0; n < 2; ++n)
#pragma unroll
                        for (int i = 0; i < 4; ++i) h[n * 4 + i] = sigmoidf_(acc[ai][bj][m][n][i] * r);
                    u32x4 w; w.x = cvt_pk_bf16(h[0], h[1]); w.y = cvt_pk_bf16(h[2], h[3]); w.z = cvt_pk_bf16(h[4], h[5]); w.w = cvt_pk_bf16(h[6], h[7]);
                    *(u32x4*)(G + (size_t)row * ldg + col0 + bj * 128) = w; } asm volatile("" ::: "memory"); }
    }
};

struct EpiMerge {
    static constexpr bool PERM = true;
    bf16_t* Y; const bf16_t* G  ; int ldg; int accum;
    __device__ __forceinline__ void operator()(const f32x4 (&acc)[2][2][4][2], const Unit& u, int wr, int wc, int fr, int fq) const {
        const int row0 = u.pm * 256 + wr * 64 + fr, col0 = u.pn * 256 + wc * 32 + 8 * fq;
#pragma unroll
        for (int ai = 0; ai < 2; ++ai)
#pragma unroll
            for (int m = 0; m < 4; ++m) { const int row = row0 + ai * 128 + m * 16;
#pragma unroll
                for (int bj = 0; bj < 2; ++bj) { const u32x4 gv = *(const u32x4*)(G + (size_t)row * ldg + col0 + bj * 128);
                    bf16_t* yp = Y + (size_t)row * 1024 + col0 + bj * 128;
                    u32x4 yo = (u32x4){0u, 0u, 0u, 0u}; if (accum) yo = *(const u32x4*)yp;
                    const f32x4 a = acc[ai][bj][m][0], b = acc[ai][bj][m][1];
                    float h[8];
                    h[0] = bflo(yo.x) + bflo(gv.x) * a[0]; h[1] = bfhi(yo.x) + bfhi(gv.x) * a[1]; h[2] = bflo(yo.y) + bflo(gv.y) * a[2]; h[3] = bfhi(yo.y) + bfhi(gv.y) * a[3];
                    h[4] = bflo(yo.z) + bflo(gv.z) * b[0]; h[5] = bfhi(yo.z) + bfhi(gv.z) * b[1]; h[6] = bflo(yo.w) + bflo(gv.w) * b[2]; h[7] = bfhi(yo.w) + bfhi(gv.w) * b[3];
                    u32x4 w; w.x = cvt_pk_bf16(h[0], h[1]); w.y = cvt_pk_bf16(h[2], h[3]); w.z = cvt_pk_bf16(h[4], h[5]); w.w = cvt_pk_bf16(h[6], h[7]);
                    *(u32x4*)yp = w; } asm volatile("" ::: "memory"); }
    }
};
}
constexpr int NWAVES = 8;
constexpr int M = 16384, D = 1024, FF = 2816, T = 4096, NLAYER = 4;
constexpr int NIN = 7880, PP = 4864  , NGATE = 3072, GATE_COL0 = 4808;
constexpr float LOG2E = 1.4426950408889634f;
constexpr size_t MiB = 1u << 20;
constexpr size_t WS_CTL = 0, CTL_ZERO_BYTES = 1 * MiB;
constexpr size_t WS_BIASD = 1 * MiB;
constexpr size_t WS_ROWSS = 1 * MiB + 512 * 1024;
constexpr size_t WS_WIDX = 2 * MiB + 512 * 1024;
constexpr size_t WS_W = 4 * MiB;
constexpr size_t O_GU1 = 0, O_DN1 = 11534336, O_QKV = 17301504, O_GATE = 27262976, O_BA = 33554432, O_BB = 34078720, O_BC = 35127296, O_OUT = 35651584, O_GU2 = 37748736, O_DN2 = 49283072, O_WEND = 55050240;
constexpr size_t WS_XB = 57 * MiB, WS_OATT = 89 * MiB, WS_Y = 121 * MiB, WS_PROJ = 153 * MiB, WS_HMID = WS_PROJ, WS_GATES = 305 * MiB, WS_OB = WS_Y  , WS_SCORES = 305 * MiB  , WS_OAP = 434 * MiB, WS_END = 461 * MiB;
static_assert(WS_W + O_WEND <= WS_XB && WS_PROJ + (size_t)M * PP * 2 <= WS_GATES && WS_GATES + (size_t)M * NGATE * 2 <= WS_END && WS_SCORES + 4 * (size_t)8454144 * 4 <= WS_OAP, "ws map");
constexpr int CW_TMO = 0, CW_CODE = 1, CW_BAR = 4096;

constexpr int RING_OFF = 0, RING_BYTES = 131072;
constexpr int MISC_OFF = 160768, LDS_BYTES = 161792;

#define GAS __attribute__((address_space(1)))
#define LAS __attribute__((address_space(3)))
typedef unsigned short bf16;
typedef unsigned v4u __attribute__((ext_vector_type(4)));
typedef unsigned v2u __attribute__((ext_vector_type(2)));
typedef float f32x4 __attribute__((ext_vector_type(4)));
typedef GAS unsigned gu32;
#define RLX_AGENT __ATOMIC_RELAXED, __HIP_MEMORY_SCOPE_AGENT
#define LDS_WAIT() asm volatile("s_waitcnt lgkmcnt(0)" ::: "memory")
#define VM_WAIT() asm volatile("s_waitcnt vmcnt(0)" ::: "memory")
__device__ __forceinline__ float bflo(unsigned u) { return __uint_as_float(u << 16); }
__device__ __forceinline__ float bfhi(unsigned u) { return __uint_as_float(u & 0xffff0000u); }
__device__ __forceinline__ unsigned f2bf(float f) { unsigned u = __builtin_bit_cast(unsigned, f); return (u + 0x7fffu + ((u >> 16) & 1u)) >> 16; }
__device__ __forceinline__ unsigned pk2(float lo, float hi) { return f2bf(lo) | (f2bf(hi) << 16); }
__device__ __forceinline__ float wave_sum(float v) {
#pragma unroll
    for (int o = 1; o < 64; o <<= 1) v += __shfl_xor(v, o);
    return v;
}
__device__ __forceinline__ float wave_max(float v) {
#pragma unroll
    for (int o = 1; o < 64; o <<= 1) v = fmaxf(v, __shfl_xor(v, o));
    return v;
}
__device__ __forceinline__ float dot8(v4u a, v4u b) {
    return ((bflo(a.x) * bflo(b.x) + bfhi(a.x) * bfhi(b.x)) + (bflo(a.y) * bflo(b.y) + bfhi(a.y) * bfhi(b.y))) + ((bflo(a.z) * bflo(b.z) + bfhi(a.z) * bfhi(b.z)) + (bflo(a.w) * bflo(b.w) + bfhi(a.w) * bfhi(b.w)));
}
__device__ __forceinline__ float dot64(const v4u (&q)[8], const bf16* kp) {
    const v4u* k = (const v4u*)kp; float s = 0.f;
#pragma unroll
    for (int i = 0; i < 8; ++i) s += dot8(q[i], k[i]);
    return s;
}
__device__ __forceinline__ int rel_bucket(int n) {
    if (n < 16) return n;
    int b = 16 + (int)(logf((float)n / 16.0f) / logf(128.0f) * 16.0f);
    return b < 31 ? b : 31;
}

struct Args { const float* in[19]; float* out; unsigned char* ws; int lo, hi; };
struct Frame {
    LAS unsigned char* lds;
    volatile LAS unsigned* MISC;
    int tid, lane, wave, G, bx;
};

__device__ __forceinline__ void phase_prologue(Frame& F, const Args& A) {
    float* biasd = (float*)(A.ws + WS_BIASD); const float* rel_bias = A.in[1];
    for (int i = F.bx * 512 + F.tid; i < 20 * 4096; i += F.G * 512) { const int h = i >> 12, d = i & 4095; biasd[i] = rel_bias[rel_bucket(d) * 20 + h] * LOG2E; }
    const float* x = A.in[0]; bf16* xb = (bf16*)(A.ws + WS_XB); float* rowss = (float*)(A.ws + WS_ROWSS);
    const int gw = F.bx * NWAVES + F.wave, NGW = F.G * NWAVES;
    for (int m = gw; m < M; m += NGW) {
        const f32x4* xr = (const f32x4*)(x + (size_t)m * D) + F.lane; float s = 0.f;
        unsigned long long* o8 = (unsigned long long*)(xb + (size_t)m * D) + F.lane;
#pragma unroll
        for (int j = 0; j < 4; ++j) { const f32x4 v = xr[64 * j]; s += (v.x * v.x + v.y * v.y) + (v.z * v.z + v.w * v.w);
            o8[64 * j] = (unsigned long long)pk2(v.x, v.y) | ((unsigned long long)pk2(v.z, v.w) << 32); }
        s = wave_sum(s);
        if (F.lane < 16) rowss[(size_t)F.lane * M + m] = (F.lane == 0) ? s : 0.f;
    }
}

__device__ __forceinline__ void cvt_item(const float* W, int ldw, int col0, int nvalid, const float* gamma, bf16* WT, int K, int dstrow0, int k0, LAS float* scr, int lane) {
    const int c32 = lane & 31;
#pragma unroll 8
    for (int i = 0; i < 32; ++i) { const int kk = 2 * i + (lane >> 5);
        float v = 0.f; if (c32 < nvalid) v = W[(size_t)(k0 + kk) * ldw + col0 + c32];
        if (gamma) v *= gamma[k0 + kk];
        scr[kk * 33 + c32] = v; }
    LDS_WAIT(); asm volatile("" ::: "memory");
    const int c = lane & 7;
#pragma unroll
    for (int j = 0; j < 4; ++j) { const int n = (lane >> 3) + 8 * j; const LAS float* s = scr + (8 * c) * 33 + n;
        v4u o; o.x = pk2(s[0 * 33], s[1 * 33]); o.y = pk2(s[2 * 33], s[3 * 33]); o.z = pk2(s[4 * 33], s[5 * 33]); o.w = pk2(s[6 * 33], s[7 * 33]);
        *(v4u*)(WT + (size_t)(dstrow0 + n) * K + k0 + 8 * c) = o; }
    LDS_WAIT(); asm volatile("" ::: "memory");
}
__device__ __forceinline__ void phase_convert(Frame& F, const Args& A, int L) {
    int lane_ = F.lane; asm volatile("" : "+v"(lane_)); const int lane = lane_;
    LAS float* scr = (LAS float*)(F.lds + RING_OFF + F.wave * 16384);
    const int gw = F.bx * NWAVES + F.wave, NGW = F.G * NWAVES;
    unsigned char* wb = A.ws + WS_W;
    constexpr int I0 = 2816, I1 = 1408, I2 = 2432, I3 = 1536, I4 = 128, I5 = 256, I6 = 128, I7 = 512, I8 = 2816, I9 = 1408;
    constexpr int NITEMS = I0 + I1 + I2 + I3 + I4 + I5 + I6 + I7 + I8 + I9;
    for (int it = gw; it < NITEMS; it += NGW) {
        int r = it;
        if (r < I0 || (r >= I0 + I1 + I2 + I3 + I4 + I5 + I6 + I7 && r < NITEMS - I9)) {
            const bool second = r >= I0; if (second) r -= (I0 + I1 + I2 + I3 + I4 + I5 + I6 + I7);
            const int kb = r / 176, nb = r % 176, n0 = 32 * nb, tile = n0 >> 8, l = n0 & 255;
            const float* Wg = (second ? A.in[16] : A.in[3]) + (size_t)L * D * FF; const float* Wu = (second ? A.in[17] : A.in[4]) + (size_t)L * D * FF;
            const float* gam = (second ? A.in[15] : A.in[2]) + (size_t)L * D;
            cvt_item(l < 128 ? Wg : Wu, FF, 128 * tile + (l & 127), 32, gam, (bf16*)(wb + (second ? O_GU2 : O_GU1)), D, n0, 64 * kb, scr, lane);
            continue; }
        r -= I0;
        if (r < I1) { const int kb = r / 32, nb = r % 32; cvt_item(A.in[5] + (size_t)L * FF * D, D, 32 * nb, 32, nullptr, (bf16*)(wb + O_DN1), FF, 32 * nb, 64 * kb, scr, lane); continue; } r -= I1;
        if (r < I2) { const int kb = r / 152, nb = r % 152, n0 = 32 * nb, tile = n0 >> 8, l = n0 & 255, bj = l >> 7, wc = (l & 127) >> 5, col0 = 256 * tile + 64 * wc + 32 * bj;
            int nv = 4808 - col0; nv = nv < 0 ? 0 : (nv > 32 ? 32 : nv);
            cvt_item(A.in[7] + (size_t)L * D * NIN, NIN, col0, nv, A.in[6] + (size_t)L * D, (bf16*)(wb + O_QKV), D, n0, 64 * kb, scr, lane); continue; } r -= I2;
        if (r < I3) { const int kb = r / 96, nb = r % 96; cvt_item(A.in[7] + (size_t)L * D * NIN, NIN, GATE_COL0 + 32 * nb, 32, A.in[6] + (size_t)L * D, (bf16*)(wb + O_GATE), D, 32 * nb, 64 * kb, scr, lane); continue; } r -= I3;
        if (r < I4) { const int kb = r / 32, nb = r % 32; cvt_item(A.in[11] + (size_t)L * 256 * D, D, 32 * nb, 32, nullptr, (bf16*)(wb + O_BA), 256, 32 * nb, 64 * kb, scr, lane); continue; } r -= I4;
        if (r < I5) { const int kb = r / 32, nb = r % 32; cvt_item(A.in[12] + (size_t)L * 512 * D, D, 32 * nb, 32, nullptr, (bf16*)(wb + O_BB), 512, 32 * nb, 64 * kb, scr, lane); continue; } r -= I5;
        if (r < I6) { const int kb = r / 32, nb = r % 32; cvt_item(A.in[13] + (size_t)L * 256 * D, D, 32 * nb, 32, nullptr, (bf16*)(wb + O_BC), 256, 32 * nb, 64 * kb, scr, lane); continue; } r -= I6;
        if (r < I7) { const int kb = r / 32, nb = r % 32; cvt_item(A.in[14] + (size_t)L * D * D, D, 32 * nb, 32, nullptr, (bf16*)(wb + O_OUT), D, 32 * nb, 64 * kb, scr, lane); continue; } r -= I7;
        r -= I8;
        { const int kb = r / 32, nb = r % 32; cvt_item(A.in[18] + (size_t)L * FF * D, D, 32 * nb, 32, nullptr, (bf16*)(wb + O_DN2), FF, 32 * nb, 64 * kb, scr, lane); }
    }
}

constexpr int COL_AQ = 0, COL_AK = 768, COL_AV = 1536, COL_BQ = 2304, COL_BK = 2816, COL_BV = 3328, COL_CQ = 3840, COL_CK = 4096, COL_CV = 4160, COL_IQ = 4224, COL_IK = 4736;
__device__ __forceinline__ void load_q(v4u (&q)[8], const bf16* p) {
#pragma unroll
    for (int i = 0; i < 8; ++i) q[i] = ((const v4u*)p)[i];
}
__device__ __forceinline__ void oracle_A(unsigned char* ws, int gw, int NGW, int lane) {
    const bf16* P = (const bf16*)(ws + WS_PROJ); const float* biasd = (const float*)(ws + WS_BIASD); bf16* O = (bf16*)(ws + WS_OATT);
    for (int it = gw; it < M * 4; it += NGW) {
        const int row = it >> 2, hs = it & 3, b = row >> 12, t = row & 4095;
        float mrun = -INFINITY, l = 0.f, o = 0.f;
        for (int g = 0; g < 3; ++g) {
            const int dil = (g == 0) ? 1 : (g == 1 ? 4 : 16), head = 4 * g + hs, i = t / dil, r = t % dil;
            v4u q[8]; load_q(q, P + (size_t)row * PP + COL_AQ + head * 64);
            const int jlo = (i - 128) < 0 ? 0 : (i - 128), nk = i - jlo + 1;
            for (int c0 = 0; c0 < nk; c0 += 64) {
                const int jj = c0 + lane; const bool valid = jj < nk; const int j = jlo + (valid ? jj : 0);
                const size_t krow = (size_t)b * T + (size_t)j * dil + r;
                float s = -INFINITY;
                if (valid) s = dot64(q, P + krow * PP + COL_AK + head * 64) + biasd[head * 4096 + (i - j) * dil];
                const float mnew = fmaxf(mrun, wave_max(s)); const float alpha = __builtin_amdgcn_exp2f(mrun - mnew);
                const float p = valid ? __builtin_amdgcn_exp2f(s - mnew) : 0.f;
                l = l * alpha + wave_sum(p); o *= alpha; mrun = mnew;
                const int kn = (nk - c0) < 64 ? (nk - c0) : 64;
                for (int kk = 0; kk < kn; ++kk) { const float pk = __shfl(p, kk); const size_t vrow = (size_t)b * T + (size_t)(jlo + c0 + kk) * dil + r;
                    o += pk * bflo((unsigned)P[vrow * PP + COL_AV + head * 64 + lane]); }
            }
        }
        O[(size_t)row * 1024 + hs * 64 + lane] = (bf16)f2bf(o / l);
    }
}
__device__ __forceinline__ void oracle_B_map(const bf16* P, const float* biasd, int row, int h, int mp, int lane, float& r0, float& r1) {
    const int b = row >> 12, t = row & 4095;
    v4u q[8]; load_q(q, P + (size_t)row * PP + COL_BQ + (mp * 4 + h) * 64);
    float mrun = -INFINITY, l = 0.f, o0 = 0.f, o1 = 0.f;
    for (int c0 = 0; c0 <= t; c0 += 64) {
        const int j = c0 + lane; const bool valid = j <= t; const size_t krow = (size_t)b * T + (valid ? j : 0);
        float s = -INFINITY;
        if (valid) s = dot64(q, P + krow * PP + COL_BK + (mp * 4 + h) * 64) + biasd[(12 + h) * 4096 + (t - j)];
        const float mnew = fmaxf(mrun, wave_max(s)); const float alpha = __builtin_amdgcn_exp2f(mrun - mnew);
        const float p = valid ? __builtin_amdgcn_exp2f(s - mnew) : 0.f;
        l = l * alpha + wave_sum(p); o0 *= alpha; o1 *= alpha; mrun = mnew;
        const int kn = (t + 1 - c0) < 64 ? (t + 1 - c0) : 64;
        for (int kk = 0; kk < kn; ++kk) { const float pk = __shfl(p, kk); const bf16* vp = P + ((size_t)b * T + c0 + kk) * PP + COL_BV + h * 128;
            o0 += pk * bflo((unsigned)vp[lane]); o1 += pk * bflo((unsigned)vp[64 + lane]); }
    }
    r0 = o0 / l; r1 = o1 / l;
}
__device__ __forceinline__ void oracle_B(unsigned char* ws, int gw, int NGW, const float* lv, const float* dn, int L, int lane) {
    const bf16* P = (const bf16*)(ws + WS_PROJ); const float* biasd = (const float*)(ws + WS_BIASD); bf16* O = (bf16*)(ws + WS_OATT);
    const float lam_init = 0.8f - 0.6f * expf(-0.3f * (float)L);
    const float lam = expf(wave_sum(lv[lane] * lv[64 + lane])) - expf(wave_sum(lv[128 + lane] * lv[192 + lane])) + lam_init;
    for (int it = gw; it < M * 4; it += NGW) {
        const int row = it >> 2, h = it & 3;
        float a0, a1, b0, b1;
        oracle_B_map(P, biasd, row, h, 0, lane, a0, a1);
        oracle_B_map(P, biasd, row, h, 1, lane, b0, b1);
        const float d0 = a0 - lam * b0, d1 = a1 - lam * b1;
        const float inv = __builtin_amdgcn_rsqf(wave_sum(d0 * d0 + d1 * d1) * (1.0f / 128.0f) + 1e-6f) * (1.0f - lam_init);
        O[(size_t)row * 1024 + 256 + h * 128 + lane] = (bf16)f2bf(d0 * inv * dn[lane]);
        O[(size_t)row * 1024 + 256 + h * 128 + 64 + lane] = (bf16)f2bf(d1 * inv * dn[64 + lane]);
    }
}
__device__ __forceinline__ void oracle_C(unsigned char* ws, int gw, int NGW, LAS unsigned char* ldsw, int lane) {
    const bf16* P = (const bf16*)(ws + WS_PROJ); const float* biasd = (const float*)(ws + WS_BIASD); bf16* O = (bf16*)(ws + WS_OATT);
    const float* widx = (const float*)(ws + WS_WIDX);
    LAS float* sc = (LAS float*)(ldsw);
    LAS unsigned short* sel = (LAS unsigned short*)(ldsw + 16384);
    LAS float* qi = (LAS float*)(ldsw + 16384 + 512);
    for (int row = gw; row < M; row += NGW) {
        const int b = row >> 12, t = row & 4095, N = t + 1;
#pragma unroll
        for (int i = 0; i < 8; ++i) qi[i * 64 + lane] = bflo((unsigned)P[(size_t)row * PP + COL_IQ + i * 64 + lane]);
        float w[8];
#pragma unroll
        for (int h = 0; h < 8; ++h) w[h] = widx[(size_t)row * 8 + h] * 0.35355339059327373f;
        LDS_WAIT();
#pragma unroll 1
        for (int c0 = 0; c0 < N; c0 += 64) {
            const int j = c0 + lane; const bool valid = j < N;
            const v4u* kp = (const v4u*)(P + ((size_t)b * T + (valid ? j : 0)) * PP + COL_IK);
            float dsum[8];
#pragma unroll
            for (int h = 0; h < 8; ++h) dsum[h] = 0.f;
#pragma unroll 2
            for (int i = 0; i < 8; ++i) { const v4u kv = kp[i];
                const float k0 = bflo(kv.x), k1 = bfhi(kv.x), k2 = bflo(kv.y), k3 = bfhi(kv.y), k4 = bflo(kv.z), k5 = bfhi(kv.z), k6 = bflo(kv.w), k7 = bfhi(kv.w);
#pragma unroll
                for (int h = 0; h < 8; ++h) { const f32x4 qa = *(const LAS f32x4*)(qi + h * 64 + i * 8), qb = *(const LAS f32x4*)(qi + h * 64 + i * 8 + 4);
                    dsum[h] += ((qa.x * k0 + qa.y * k1) + (qa.z * k2 + qa.w * k3)) + ((qb.x * k4 + qb.y * k5) + (qb.z * k6 + qb.w * k7)); } }
            float score = 0.f;
#pragma unroll
            for (int h = 0; h < 8; ++h) score += w[h] * fmaxf(dsum[h], 0.f);
            if (j < 4096) sc[j] = valid ? score : -INFINITY;
        }
        LDS_WAIT();
        int cnt = 0;
        if (N <= 256) { for (int n = lane; n < N; n += 64) sel[n] = (unsigned short)n; cnt = N; }
        else {
            const int N4 = (N + 3) & ~3;
#pragma unroll 1
            for (int c0 = 0; c0 < N; c0 += 64) {
                const int j = c0 + lane; const bool valid = j < N; const float sj = valid ? sc[j] : INFINITY;
                int rank = 0;
                for (int jp = 0; jp < N4; jp += 4) { const f32x4 v = *(const LAS f32x4*)(sc + jp);
                    rank += (v.x > sj || (v.x == sj && jp < j)) ? 1 : 0; rank += (v.y > sj || (v.y == sj && jp + 1 < j)) ? 1 : 0;
                    rank += (v.z > sj || (v.z == sj && jp + 2 < j)) ? 1 : 0; rank += (v.w > sj || (v.w == sj && jp + 3 < j)) ? 1 : 0; }
                const bool s = valid && rank < 256;
                const unsigned long long bal = __ballot(s);
                const int pos = cnt + __popcll(bal & ((1ull << lane) - 1ull));
                if (s && pos < 256) sel[pos] = (unsigned short)j;
                cnt += __popcll(bal);
            }
            cnt = cnt > 256 ? 256 : cnt;
        }
        LDS_WAIT();
#pragma unroll 1
        for (int h = 0; h < 4; ++h) {
            v4u q[8]; load_q(q, P + (size_t)row * PP + COL_CQ + h * 64);
            float s[4]; float mx = -INFINITY;
#pragma unroll
            for (int c = 0; c < 4; ++c) { const int n = lane + 64 * c; const bool valid = n < cnt; const int key = valid ? (int)sel[n] : 0;
                s[c] = valid ? dot64(q, P + ((size_t)b * T + key) * PP + COL_CK) + biasd[(16 + h) * 4096 + (t - key)] : -INFINITY; mx = fmaxf(mx, s[c]); }
            mx = wave_max(mx);
            float p[4], ls = 0.f;
#pragma unroll
            for (int c = 0; c < 4; ++c) { p[c] = (lane + 64 * c < cnt) ? __builtin_amdgcn_exp2f(s[c] - mx) : 0.f; ls += p[c]; }
            ls = wave_sum(ls);
            float o = 0.f;
#pragma unroll
            for (int c = 0; c < 4; ++c) { const int kn = (cnt - 64 * c) < 64 ? (cnt - 64 * c) : 64;
                for (int kk = 0; kk < kn; ++kk) { const float pk = __shfl(p[c], kk); const int key = (int)sel[64 * c + kk];
                    o += pk * bflo((unsigned)P[((size_t)b * T + key) * PP + COL_CV + lane]); } }
            O[(size_t)row * 1024 + 768 + h * 64 + lane] = (bf16)f2bf(o / ls);
        }
        LDS_WAIT();
    }
}
namespace fa {
typedef short bf16x8 __attribute__((ext_vector_type(8)));
typedef short v4i16_t __attribute__((ext_vector_type(4)));
typedef float f32x16 __attribute__((ext_vector_type(16)));
typedef unsigned u32x4 __attribute__((ext_vector_type(4)));
constexpr int KPITCH = 144;
constexpr int KSTAGE = 64 * KPITCH;
template <int NDB> struct Geo { static constexpr int VPITCH = (NDB == 4) ? 320 : 192, VSTAGE = 64 * VPITCH, OFF_K = 0, OFF_V = 2 * KSTAGE, OFF_BIAS = OFF_V + 2 * VSTAGE, LDS_END = OFF_BIAS + 16384; };
__device__ __forceinline__ int crow(int r, int hi) { return (r & 3) + 8 * (r >> 2) + 4 * hi; }

struct Unit {
    const bf16* P;
    int colQ, colK, colV;
    long rowbase;
    int stride, rofs;
    int qi0;
    int kt0, kt1;
    const float* biasd;
};

template <int NDB, int MODE>
__device__ __forceinline__ void run(LAS unsigned char* lds, const Unit& U, int tid, f32x16 (&o)[NDB], float& mrun_out, float& lsum_out) {
    typedef Geo<NDB> G;
    const int lane = tid & 63, wid = __builtin_amdgcn_readfirstlane(tid >> 6), q32 = lane & 31, hi = lane >> 5;
    { LAS float* bl = (LAS float*)(lds + G::OFF_BIAS);
#pragma unroll
      for (int i = 0; i < 2; ++i) { const f32x4 v = *(const f32x4*)(U.biasd + (tid + 512 * i) * 4); *(LAS f32x4*)(bl + (tid + 512 * i) * 4) = v; } }
    const int qi = U.qi0 + 32 * wid + q32;
    bf16x8 qr[4];
    { const bf16* qp = U.P + (size_t)(U.rowbase + (long)qi * U.stride + U.rofs) * PP + U.colQ + 8 * hi;
#pragma unroll
      for (int d0 = 0; d0 < 4; ++d0) qr[d0] = *(const bf16x8*)(qp + 16 * d0); }
#pragma unroll
    for (int db = 0; db < NDB; ++db)
#pragma unroll
        for (int r = 0; r < 16; ++r) o[db][r] = 0.f;
    float mrun = -1.0e30f, lsum = 0.f;
    const int krow = tid >> 3, kch = tid & 7;
    u32x4 kst; u32x4 vst[NDB / 2];
    auto load_tile = [&](int kt) {
        { const long pos = (long)(64 * kt + krow) * U.stride + U.rofs; kst = *(const u32x4*)(U.P + (size_t)(U.rowbase + pos) * PP + U.colK + 8 * kch); }
#pragma unroll
        for (int i = 0; i < NDB / 2; ++i) { const int idx = tid + 512 * i, vr = idx / (NDB * 4), vc = idx % (NDB * 4);
            const long pos = (long)(64 * kt + vr) * U.stride + U.rofs; vst[i] = *(const u32x4*)(U.P + (size_t)(U.rowbase + pos) * PP + U.colV + 8 * vc); }
    };
    auto store_tile = [&](int buf) {
        *(LAS u32x4*)(lds + G::OFF_K + buf * KSTAGE + krow * KPITCH + kch * 16) = kst;
#pragma unroll
        for (int i = 0; i < NDB / 2; ++i) { const int idx = tid + 512 * i, vr = idx / (NDB * 4), vc = idx % (NDB * 4);
            *(LAS u32x4*)(lds + G::OFF_V + buf * G::VSTAGE + vr * G::VPITCH + vc * 16) = vst[i]; }
    };
    load_tile(U.kt0); store_tile(0);
    __syncthreads();
    const LAS float* bl = (const LAS float*)(lds + G::OFF_BIAS);
    const int qlo = U.qi0 + 32 * wid, qhi = qlo + 31;
    for (int kt = U.kt0; kt < U.kt1; ++kt) {
        const int buf = (kt - U.kt0) & 1;
        if (kt + 1 < U.kt1) load_tile(kt + 1);
        const int k0 = 64 * kt;
        bool need = (k0 <= qhi);
        if (MODE == 1) need = need && (k0 + 63 >= qlo - 128);
        if (need) {
            f32x16 p0, p1;
#pragma unroll
            for (int r = 0; r < 16; ++r) { p0[r] = 0.f; p1[r] = 0.f; }
            const LAS unsigned char* kb = lds + G::OFF_K + buf * KSTAGE + q32 * KPITCH + hi * 16;
#pragma unroll
            for (int d0 = 0; d0 < 4; ++d0) {
                const bf16x8 ka = *(const LAS bf16x8*)(kb + d0 * 32), kc = *(const LAS bf16x8*)(kb + 32 * KPITCH + d0 * 32);
                p0 = __builtin_amdgcn_mfma_f32_32x32x16_bf16(ka, qr[d0], p0, 0, 0, 0);
                p1 = __builtin_amdgcn_mfma_f32_32x32x16_bf16(kc, qr[d0], p1, 0, 0, 0);
                if (d0 & 1) asm volatile("" ::: "memory");
            }
            const bool edge = (k0 + 63 > qlo) || (MODE == 1 && k0 < qhi - 128 + 0);
            float mx = -INFINITY;
#pragma unroll
            for (int r = 0; r < 16; ++r) {
                const int j0 = k0 + crow(r, hi), j1 = j0 + 32; const int d0_ = qi - j0, d1_ = qi - j1;
                float b0 = bl[(d0_ < 0 ? 0 : d0_) * U.stride], b1 = bl[(d1_ < 0 ? 0 : d1_) * U.stride];
                float s0 = p0[r] + b0, s1 = p1[r] + b1;
                if (edge) { bool v0 = d0_ >= 0, v1 = d1_ >= 0; if (MODE == 1) { v0 = v0 && d0_ <= 128; v1 = v1 && d1_ <= 128; }
                    s0 = v0 ? s0 : -INFINITY; s1 = v1 ? s1 : -INFINITY; }
                p0[r] = s0; p1[r] = s1; mx = fmaxf(mx, fmaxf(s0, s1));
                if ((r & 3) == 3) asm volatile("" ::: "memory");
            }
            mx = fmaxf(mx, __shfl_xor(mx, 32));
            const float mnew = fmaxf(mrun, mx);
            if (__any(mnew > mrun)) {
                const float alpha = __builtin_amdgcn_exp2f(mrun - mnew);
                lsum *= alpha;
#pragma unroll
                for (int r = 0; r < 16; ++r) { const float ar = __shfl(alpha, crow(r, hi));
#pragma unroll
                    for (int db = 0; db < NDB; ++db) o[db][r] *= ar; }
                mrun = mnew;
            }
            float ps = 0.f;
#pragma unroll
            for (int r = 0; r < 16; ++r) { p0[r] = __builtin_amdgcn_exp2f(p0[r] - mrun); p1[r] = __builtin_amdgcn_exp2f(p1[r] - mrun); ps += p0[r] + p1[r]; }
            lsum += ps;
            const LAS unsigned char* vb = lds + G::OFF_V + buf * G::VSTAGE + (4 * hi + ((lane & 15) >> 2)) * G::VPITCH + (16 * ((lane >> 4) & 1) + 4 * (lane & 3)) * 2;
#pragma unroll
            for (int s = 0; s < 4; ++s) {
                u32x4 pw;
                if (s < 2) { pw.x = pg8::cvt_pk_bf16(p0[8 * s + 0], p0[8 * s + 1]); pw.y = pg8::cvt_pk_bf16(p0[8 * s + 2], p0[8 * s + 3]); pw.z = pg8::cvt_pk_bf16(p0[8 * s + 4], p0[8 * s + 5]); pw.w = pg8::cvt_pk_bf16(p0[8 * s + 6], p0[8 * s + 7]); }
                else { const int s2 = s - 2; pw.x = pg8::cvt_pk_bf16(p1[8 * s2 + 0], p1[8 * s2 + 1]); pw.y = pg8::cvt_pk_bf16(p1[8 * s2 + 2], p1[8 * s2 + 3]); pw.z = pg8::cvt_pk_bf16(p1[8 * s2 + 4], p1[8 * s2 + 5]); pw.w = pg8::cvt_pk_bf16(p1[8 * s2 + 6], p1[8 * s2 + 7]); }
                const bf16x8 pa = __builtin_bit_cast(bf16x8, pw);
                const LAS unsigned char* vs = vb + (32 * (s >> 1) + 16 * (s & 1)) * G::VPITCH;
#pragma unroll
                for (int db = 0; db < NDB; ++db) {
                    const v4i16_t lo = __builtin_amdgcn_ds_read_tr16_b64_v4i16((LAS v4i16_t*)(vs + db * 64));
                    const v4i16_t hv = __builtin_amdgcn_ds_read_tr16_b64_v4i16((LAS v4i16_t*)(vs + 8 * G::VPITCH + db * 64));
                    const bf16x8 vf = (bf16x8){lo[0], lo[1], lo[2], lo[3], hv[0], hv[1], hv[2], hv[3]};
                    o[db] = __builtin_amdgcn_mfma_f32_32x32x16_bf16(pa, vf, o[db], 0, 0, 0);
                }
                asm volatile("" ::: "memory");
            }
        }
        if (kt + 1 < U.kt1) store_tile(buf ^ 1);
        __syncthreads();
    }
    lsum += __shfl_xor(lsum, 32);
    mrun_out = mrun; lsum_out = lsum;
}
}
__device__ __forceinline__ void phase_attn_B(Frame& F, const Args& A) {
    int tid_ = F.tid; asm volatile("" : "+v"(tid_)); const int tid = tid_, lane = tid & 63, wid = __builtin_amdgcn_readfirstlane(tid >> 6), q32 = lane & 31, hi = lane >> 5;
    const int v = (F.bx % 8) * (F.G / 8) + F.bx / 8;
    const bf16* P = (const bf16*)(A.ws + WS_PROJ); bf16* OB = (bf16*)(A.ws + WS_OB); const float* biasd = (const float*)(A.ws + WS_BIASD);
    for (int pv = v; pv < 512; pv += F.G) {
        const int combo = pv >> 3, s = pv & 7, b = combo >> 4, h = (combo >> 2) & 3, mp = (combo >> 1) & 1, vh = combo & 1;
#pragma unroll 1
        for (int half = 0; half < 2; ++half) {
            const int qb = half ? s : 15 - s;
            fa::Unit U; U.P = P; U.colQ = COL_BQ + (mp * 4 + h) * 64; U.colK = COL_BK + (mp * 4 + h) * 64; U.colV = COL_BV + h * 128 + vh * 64; U.rowbase = (long)b * T; U.stride = 1; U.rofs = 0;
            U.qi0 = 256 * qb; U.kt0 = 0; U.kt1 = 4 * (qb + 1); U.biasd = biasd + (12 + h) * 4096;
            fa::f32x16 o[2]; float mrun, lsum;
            fa::run<2, 0>(F.lds + RING_OFF, U, tid, o, mrun, lsum);
            const float inv = 1.0f / lsum;
            bf16* orow = OB + (size_t)(U.rowbase + U.qi0 + 32 * wid) * 1024 + h * 256 + mp * 128 + vh * 64 + q32;
#pragma unroll
            for (int r = 0; r < 16; ++r) { const int qq = fa::crow(r, hi); const float ir = __shfl(inv, qq);
#pragma unroll
                for (int db = 0; db < 2; ++db) orow[(size_t)qq * 1024 + 32 * db] = (bf16)f2bf(o[db][r] * ir); }
        }
    }
}
__device__ __forceinline__ void phase_combine_B(Frame& F, const Args& A, int L) {
    int lane_ = F.lane; asm volatile("" : "+v"(lane_)); const int lane = lane_;
    const bf16* OB = (const bf16*)(A.ws + WS_OB); bf16* O = (bf16*)(A.ws + WS_OATT);
    const float* lv = A.in[9] + (size_t)L * 256; const float* dn = A.in[10] + (size_t)L * 128;
    const float lam_init = 0.8f - 0.6f * expf(-0.3f * (float)L);
    const float lam = expf(wave_sum(lv[lane] * lv[64 + lane])) - expf(wave_sum(lv[128 + lane] * lv[192 + lane])) + lam_init;
    const float g0 = dn[lane], g1 = dn[64 + lane];
    const int gw = F.bx * NWAVES + F.wave, NGW = F.G * NWAVES;
    for (int it = gw; it < M * 4; it += NGW) {
        const int row = it >> 2, h = it & 3; const bf16* p = OB + (size_t)row * 1024 + h * 256;
        const float d0 = bflo((unsigned)p[lane]) - lam * bflo((unsigned)p[128 + lane]), d1 = bflo((unsigned)p[64 + lane]) - lam * bflo((unsigned)p[192 + lane]);
        const float inv = __builtin_amdgcn_rsqf(wave_sum(d0 * d0 + d1 * d1) * (1.0f / 128.0f) + 1e-6f) * (1.0f - lam_init);
        O[(size_t)row * 1024 + 256 + h * 128 + lane] = (bf16)f2bf(d0 * inv * g0);
        O[(size_t)row * 1024 + 256 + h * 128 + 64 + lane] = (bf16)f2bf(d1 * inv * g1);
    }
}
constexpr size_t SC_BATCH = 8454144;
__device__ __forceinline__ size_t sc_rowoff(int t) { const size_t i = (size_t)(t >> 5); return 512 * i * (i + 1) + (size_t)(t & 31) * 32 * (i + 1); }
typedef float f32x4v __attribute__((ext_vector_type(4)));
__device__ __forceinline__ void c1_decode(int f, int& b, int& qb, int& kt) { b = f / 1056; const int rem = f - 1056 * b; qb = 0; while ((qb + 1) * (qb + 2) <= rem) ++qb; kt = rem - qb * (qb + 1); }
__device__ __forceinline__ void phase_C1(Frame& F, const Args& A) {
    int tid_ = F.tid; asm volatile("" : "+v"(tid_)); const int tid = tid_, lane = tid & 63, wid = __builtin_amdgcn_readfirstlane(tid >> 6), q16 = lane & 15, g = lane >> 4;
    const int v = (F.bx % 8) * (F.G / 8) + F.bx / 8;
    const bf16* P = (const bf16*)(A.ws + WS_PROJ); float* SC = (float*)(A.ws + WS_SCORES); const float* WIDX = (const float*)(A.ws + WS_WIDX);
    constexpr int NTOT = 4 * 1056;
    const int f0 = (int)(((long)v * NTOT) / F.G), f1 = (int)(((long)(v + 1) * NTOT) / F.G);
    if (f0 >= f1) return;
    LAS unsigned char* lds = F.lds + RING_OFF;
    const int krow = tid >> 3, kch = tid & 7;
    fa::u32x4 kst;
    int b, qb, kt; c1_decode(f0, b, qb, kt);
    kst = *(const fa::u32x4*)(P + (size_t)((long)b * T + 64 * kt + krow) * PP + COL_IK + 8 * kch);
    *(LAS fa::u32x4*)(lds + krow * fa::KPITCH + kch * 16) = kst;
    __syncthreads();
    int cb = -1, cqb = -1;
    fa::bf16x8 qf[8][2]; float wq[8];
    for (int f = f0; f < f1; ++f) {
        const int buf = (f - f0) & 1;
        int nb = b, nqb = qb, nkt = kt + 1; if (nkt >= 2 * (qb + 1)) { nkt = 0; ++nqb; if (nqb >= 32) { nqb = 0; ++nb; } }
        if (f + 1 < f1) kst = *(const fa::u32x4*)(P + (size_t)((long)nb * T + 64 * nkt + krow) * PP + COL_IK + 8 * kch);
        if (b != cb || qb != cqb) {
            cb = b; cqb = qb;
            const size_t row = (size_t)b * T + 128 * qb + 16 * wid + q16;
#pragma unroll
            for (int h = 0; h < 8; ++h) { wq[h] = WIDX[row * 8 + h] * 0.35355339059327373f;
#pragma unroll
                for (int ks = 0; ks < 2; ++ks) qf[h][ks] = *(const fa::bf16x8*)(P + row * PP + COL_IQ + h * 64 + 32 * ks + 8 * g); }
        }
        const int tq0 = 128 * qb + 16 * wid, k0 = 64 * kt;
        float* srow = SC + (size_t)b * SC_BATCH + sc_rowoff(tq0 + q16);
#pragma unroll 1
        for (int kb = 0; kb < 4; ++kb) {
            const int kbase = k0 + 16 * kb;
            if (kbase > tq0 + 15) continue;
            const LAS unsigned char* kp = lds + buf * fa::KSTAGE + (16 * kb + q16) * fa::KPITCH + g * 16;
            const fa::bf16x8 kf0 = *(const LAS fa::bf16x8*)(kp), kf1 = *(const LAS fa::bf16x8*)(kp + 64);
            f32x4v sc = {0.f, 0.f, 0.f, 0.f};
#pragma unroll
            for (int h = 0; h < 8; ++h) {
                f32x4v p = {0.f, 0.f, 0.f, 0.f};
                p = __builtin_amdgcn_mfma_f32_16x16x32_bf16(kf0, qf[h][0], p, 0, 0, 0);
                p = __builtin_amdgcn_mfma_f32_16x16x32_bf16(kf1, qf[h][1], p, 0, 0, 0);
#pragma unroll
                for (int r = 0; r < 4; ++r) sc[r] += wq[h] * fmaxf(p[r], 0.f);
            }
            *(f32x4v*)(srow + kbase + 4 * g) = sc;
        }
        if (f + 1 < f1) *(LAS fa::u32x4*)(lds + (buf ^ 1) * fa::KSTAGE + krow * fa::KPITCH + kch * 16) = kst;
        __syncthreads();
        b = nb; qb = nqb; kt = nkt;
    }
}

__device__ __forceinline__ void phase_C2(Frame& F, const Args& A) {
    int lane_ = F.lane; asm volatile("" : "+v"(lane_)); const int lane = lane_;
    const bf16* P = (const bf16*)(A.ws + WS_PROJ); const float* SC = (const float*)(A.ws + WS_SCORES); const float* biasd = (const float*)(A.ws + WS_BIASD); bf16* O = (bf16*)(A.ws + WS_OATT);
    LAS unsigned char* wl = F.lds + RING_OFF + F.wave * 17920;
    LAS unsigned* keys = (LAS unsigned*)wl;
    LAS float* pl = (LAS float*)wl;
    LAS unsigned* hist = (LAS unsigned*)(wl + 16384);
    LAS unsigned short* sel = (LAS unsigned short*)(wl + 17408);
    const int gw = F.bx * NWAVES + F.wave, NGW = F.G * NWAVES;
    const unsigned long long ltmask = (1ull << lane) - 1ull;
#pragma unroll 1
    for (int row = gw; row < M; row += NGW) {
        const int b = row >> 12, t = row & 4095, N = t + 1;
        int cnt;
        if (N <= 256) { for (int n = lane; n < N; n += 64) sel[n] = (unsigned short)n; cnt = N; }
        else {
            const float* srow = SC + (size_t)b * SC_BATCH + sc_rowoff(t);
            const int nc = (N + 63) >> 6;
#pragma unroll 4
            for (int c = 0; c < nc; ++c) { const int j = c * 64 + lane; unsigned u = 0u;
                if (j < N) { const unsigned bits = __float_as_uint(srow[j] + 0.0f);     u = (bits & 0x80000000u) ? ~bits : (bits | 0x80000000u); }
                keys[j] = u; }
            unsigned prefix = 0u, mask = 0u; int krem = 256;
#pragma unroll 1
            for (int pass = 0; pass < 4; ++pass) {
                const int shift = 24 - 8 * pass;
                *(LAS v4u*)(hist + 4 * lane) = (v4u){0u, 0u, 0u, 0u};
                LDS_WAIT();
#pragma unroll 4
                for (int c = 0; c < nc; ++c) { const unsigned kk = keys[c * 64 + lane]; if (kk != 0u && (kk & mask) == prefix) __hip_atomic_fetch_add(hist + ((kk >> shift) & 255u), 1u, __ATOMIC_RELAXED, __HIP_MEMORY_SCOPE_WORKGROUP); }
                LDS_WAIT();
                const v4u hc = *(const LAS v4u*)(hist + 4 * lane);
                const unsigned sl = hc.x + hc.y + hc.z + hc.w;
                unsigned suf = sl;
#pragma unroll
                for (int o = 1; o < 64; o <<= 1) { const unsigned other = __shfl_down(suf, o); if (lane + o < 64) suf += other; }
                unsigned cum = suf - sl;
                int fb = -1; unsigned fabove = 0u;
                { const unsigned cc[4] = {hc.w, hc.z, hc.y, hc.x};
#pragma unroll
                  for (int i = 0; i < 4; ++i) { if (fb < 0 && cum < (unsigned)krem && cum + cc[i] >= (unsigned)krem) { fb = 4 * lane + 3 - i; fabove = cum; } cum += cc[i]; } }
                const unsigned long long bal = __ballot(fb >= 0);
                const int src = __builtin_ctzll(bal);
                const int bin = __shfl(fb, src); const unsigned above = __shfl(fabove, src);
                prefix |= (unsigned)bin << shift; mask |= 0xFFu << shift; krem -= (int)above;
            }
            cnt = 0; int eqseen = 0;
#pragma unroll 2
            for (int c = 0; c < nc; ++c) {
                const unsigned kk = keys[c * 64 + lane];
                const bool gt = kk > prefix, eq = kk == prefix;
                const unsigned long long beq = __ballot(eq);
                const bool sflag = gt || (eq && (eqseen + __popcll(beq & ltmask)) < krem);
                const unsigned long long bs = __ballot(sflag);
                if (sflag) sel[cnt + __popcll(bs & ltmask)] = (unsigned short)(c * 64 + lane);
                cnt += __popcll(bs); eqseen += __popcll(beq);
            }
        }
        LDS_WAIT();
        float lg[4][4];
        {
            int keyi[4]; bool valid[4];
#pragma unroll
            for (int c = 0; c < 4; ++c) { const int n = lane + 64 * c; valid[c] = n < cnt; keyi[c] = valid[c] ? (int)sel[n] : 0; }
#pragma unroll
            for (int h = 0; h < 4; ++h) {
                v4u q[8]; load_q(q, P + (size_t)row * PP + COL_CQ + h * 64);
#pragma unroll
                for (int c = 0; c < 4; ++c) lg[h][c] = valid[c] ? dot64(q, P + ((size_t)b * T + keyi[c]) * PP + COL_CK) + biasd[(16 + h) * 4096 + (t - keyi[c])] : -INFINITY;
            }
        }
        float linv[4];
#pragma unroll
        for (int h = 0; h < 4; ++h) {
            float mx = fmaxf(fmaxf(lg[h][0], lg[h][1]), fmaxf(lg[h][2], lg[h][3])); mx = wave_max(mx);
            float ls = 0.f;
#pragma unroll
            for (int c = 0; c < 4; ++c) { const float p = __builtin_amdgcn_exp2f(lg[h][c] - mx); pl[h * 256 + lane + 64 * c] = p; ls += p; }
            linv[h] = 1.0f / wave_sum(ls);
        }
        LDS_WAIT();
        float o0 = 0.f, o1 = 0.f, o2 = 0.f, o3 = 0.f;
        const bf16* vbase = P + (size_t)b * T * PP + COL_CV + lane;
#pragma unroll 4
        for (int n = 0; n < cnt; ++n) { const int key = (int)sel[n]; const float vv = bflo((unsigned)vbase[(size_t)key * PP]);
            o0 += pl[n] * vv; o1 += pl[256 + n] * vv; o2 += pl[512 + n] * vv; o3 += pl[768 + n] * vv; }
        bf16* op = O + (size_t)row * 1024 + 768 + lane;
        op[0] = (bf16)f2bf(o0 * linv[0]); op[64] = (bf16)f2bf(o1 * linv[1]); op[128] = (bf16)f2bf(o2 * linv[2]); op[192] = (bf16)f2bf(o3 * linv[3]);
        LDS_WAIT();
    }
}
__device__ __forceinline__ void phase_attn_A(Frame& F, const Args& A) {
    int tid_ = F.tid; asm volatile("" : "+v"(tid_)); const int tid = tid_, lane = tid & 63, wid = __builtin_amdgcn_readfirstlane(tid >> 6), q32 = lane & 31, hi = lane >> 5;
    const int v = (F.bx % 8) * (F.G / 8) + F.bx / 8;
    const bf16* P = (const bf16*)(A.ws + WS_PROJ); bf16* OP = (bf16*)(A.ws + WS_OAP); float* ST = (float*)(A.ws + WS_OAP + 24 * MiB); const float* biasd = (const float*)(A.ws + WS_BIASD);
    const int u0 = (int)(((long)v * 768) / F.G), u1 = (int)(((long)(v + 1) * 768) / F.G);
#pragma unroll 1
    for (int u = u0; u < u1; ++u) {
        const int b = u / 192, rem = u % 192, g = rem >> 6, hs = (rem >> 4) & 3, ri = rem & 15;
        const int dil = (g == 0) ? 1 : (g == 1 ? 4 : 16), res = (g == 0) ? 0 : (g == 1 ? (ri >> 2) : ri), iblk = (g == 0) ? ri : (g == 1 ? (ri & 3) : 0), head = 4 * g + hs;
        fa::Unit U; U.P = P; U.colQ = COL_AQ + head * 64; U.colK = COL_AK + head * 64; U.colV = COL_AV + head * 64; U.rowbase = (long)b * T; U.stride = dil; U.rofs = res;
        U.qi0 = 256 * iblk; U.kt0 = (iblk == 0) ? 0 : 4 * iblk - 2; U.kt1 = 4 * iblk + 4; U.biasd = biasd + head * 4096;
        fa::f32x16 o[2]; float mrun, lsum;
        fa::run<2, 1>(F.lds + RING_OFF, U, tid, o, mrun, lsum);
        const float inv = 1.0f / lsum;
        const size_t prow0 = (size_t)g * M + (size_t)U.rowbase + res;
        if (hi == 0) { const size_t prow = prow0 + (size_t)(U.qi0 + 32 * wid + q32) * dil; *(float2*)(ST + (prow * 4 + hs) * 2) = make_float2(mrun, lsum); }
#pragma unroll
        for (int r = 0; r < 16; ++r) { const int qq = fa::crow(r, hi); const float ir = __shfl(inv, qq); const size_t prow = prow0 + (size_t)(U.qi0 + 32 * wid + qq) * dil;
#pragma unroll
            for (int db = 0; db < 2; ++db) OP[prow * 256 + hs * 64 + 32 * db + q32] = (bf16)f2bf(o[db][r] * ir); }
    }
}
__device__ __forceinline__ void phase_merge_A(Frame& F, const Args& A) {
    int lane_ = F.lane; asm volatile("" : "+v"(lane_)); const int lane = lane_;
    const bf16* OP = (const bf16*)(A.ws + WS_OAP); const float* ST = (const float*)(A.ws + WS_OAP + 24 * MiB); bf16* O = (bf16*)(A.ws + WS_OATT);
    const int gw = F.bx * NWAVES + F.wave, NGW = F.G * NWAVES;
    for (int it = gw; it < M * 4; it += NGW) {
        const int row = it >> 2, hs = it & 3;
        float m[3], l[3], ov[3];
#pragma unroll
        for (int g = 0; g < 3; ++g) { const size_t prow = (size_t)g * M + row; const float2 s = *(const float2*)(ST + (prow * 4 + hs) * 2); m[g] = s.x; l[g] = s.y; ov[g] = bflo((unsigned)OP[prow * 256 + hs * 64 + lane]); }
        const float mm = fmaxf(m[0], fmaxf(m[1], m[2]));
        float num = 0.f, den = 0.f;
#pragma unroll
        for (int g = 0; g < 3; ++g) { const float w = __builtin_amdgcn_exp2f(m[g] - mm) * l[g]; num += w * ov[g]; den += w; }
        O[(size_t)row * 1024 + hs * 64 + lane] = (bf16)f2bf(num / den);
    }
}
#define XB_TMO      128
#define XB_XCNT(j)  (256  + 64 * (j))
#define XB_XSUB(j)  (1280 + 64 * (j))
#define XB_XGEN(j)  (2304 + 64 * (j))
#define XB_TOP      3328
#define XB_TOPGEN   3392
#define XCD_BAR_WORDS 3456
#define XB_SPIN_CAP (1u << 24)

__device__ __forceinline__ unsigned xb_ld(unsigned* p)              { return __hip_atomic_load(p, __ATOMIC_RELAXED, __HIP_MEMORY_SCOPE_AGENT); }
__device__ __forceinline__ unsigned xb_add(unsigned* p, unsigned v) { return __hip_atomic_fetch_add(p, v, __ATOMIC_RELAXED, __HIP_MEMORY_SCOPE_AGENT); }
__device__ __forceinline__ unsigned xb_xcc_id() { return (unsigned)__builtin_amdgcn_s_getreg((3 << 11) | 20) & 0xFu; }
#define XB_SPIN(cond, bar) do { unsigned _sp = 0; while (cond) { __builtin_amdgcn_s_sleep(1); \
    if ((++_sp & 255u) == 0u) { if (xb_ld(&(bar)[XB_TMO])) break; if (_sp > XB_SPIN_CAP) { atomicAdd(&(bar)[XB_TMO], 1u); break; } } } } while (0)

struct XcdBarrier {
    unsigned* bar; unsigned x;
    volatile LAS unsigned* st;
};

__device__ __forceinline__ XcdBarrier xcd_barrier_post(unsigned* bar, volatile LAS unsigned* st) {
    XcdBarrier b; b.bar = bar; b.x = xb_xcc_id(); b.st = st;
    if (threadIdx.x == 0) (void)xb_add(&bar[XB_XCNT(b.x)], 1u);
    return b;
}
__device__ __forceinline__ void xcd_barrier_complete(unsigned* bar, unsigned x, unsigned& nloc, unsigned& nx) {
    const unsigned G = gridDim.x * gridDim.y * gridDim.z;
    unsigned sum, cnt, mine, sp = 0u;
    for (;;) {
        sum = 0u; cnt = 0u; mine = 0u;
#pragma unroll
        for (unsigned j = 0; j < 16; ++j) { const unsigned c = xb_ld(&bar[XB_XCNT(j)]); sum += c; cnt += (c > 0u) ? 1u : 0u; mine = (j == x) ? c : mine; }
        if (sum == G) break;
        __builtin_amdgcn_s_sleep(1);
        if ((++sp & 255u) == 0u) { if (xb_ld(&bar[XB_TMO])) break; if (sp > XB_SPIN_CAP) { atomicAdd(&bar[XB_TMO], 1u); break; } }
    }
    nloc = mine > 0u ? mine : 1u; nx = cnt > 0u ? cnt : 1u;
}

__device__ __forceinline__ void xcd_barrier(const XcdBarrier& b) {
    asm volatile("s_waitcnt vmcnt(0)" ::: "memory");
    __syncthreads();
    if (threadIdx.x == 0) {
        unsigned* bar = b.bar;
        __builtin_amdgcn_s_waitcnt(0);
        unsigned nloc = b.st[0], nx = b.st[1];
        if (nloc == 0u) { xcd_barrier_complete(bar, b.x, nloc, nx); b.st[0] = nloc; b.st[1] = nx; }
        const unsigned old = xb_add(&bar[XB_XSUB(b.x)], 1u);
        const unsigned gen = old / nloc;
        if (old + 1u == (gen + 1u) * nloc) {
            __builtin_amdgcn_fence(__ATOMIC_RELEASE, "agent");
            asm volatile("s_waitcnt vmcnt(0)" ::: "memory");
            const unsigned og = xb_add(&bar[XB_TOP], 1u);
            const unsigned tg = og / nx;
            if (og + 1u == (tg + 1u) * nx) xb_add(&bar[XB_TOPGEN], 1u);
            else XB_SPIN(xb_ld(&bar[XB_TOPGEN]) == tg, bar);
            __builtin_amdgcn_fence(__ATOMIC_ACQUIRE, "agent");
            xb_add(&bar[XB_XGEN(b.x)], 1u);
            asm volatile("s_waitcnt vmcnt(0)" ::: "memory");
        } else {
            XB_SPIN(xb_ld(&bar[XB_XGEN(b.x)]) == gen, bar);
            __builtin_amdgcn_fence(__ATOMIC_ACQUIRE, "agent");
            asm volatile("s_waitcnt vmcnt(0)" ::: "memory");
        }
    }
    __syncthreads();
}
#ifndef MODE4_FILTER
#define MODE4_FILTER 1
#endif
#ifndef MODE6_ONLY
#define MODE6_ONLY -1
#endif
__device__ __forceinline__ void chk_put2(unsigned char* ws, float d2, float r2) { if ((threadIdx.x & 63) == 0) { atomicAdd((float*)(ws + WS_CTL) + 8, d2); atomicAdd((float*)(ws + WS_CTL) + 9, r2); } }
__device__ __forceinline__ float row_r_from(const float* xrow, int lane) {
    float s = 0.f; for (int j = 0; j < 16; ++j) { const float v = xrow[lane + 64 * j]; s += v * v; }
    return 1.0f / sqrtf(wave_sum(s) * (1.0f / 1024.0f) + 1e-6f);
}
__global__ void __launch_bounds__(256) k_check(Args A, int mode, int L) {
    const int lane = threadIdx.x & 63, gw = blockIdx.x * 4 + (threadIdx.x >> 6), NGW = gridDim.x * 4;
    unsigned char* ws = A.ws;
    const bf16* HMID = (const bf16*)(ws + WS_HMID); const bf16* PROJ = (const bf16*)(ws + WS_PROJ); const bf16* GATES = (const bf16*)(ws + WS_GATES);
    const bf16* OATT = (const bf16*)(ws + WS_OATT); const bf16* Y = (const bf16*)(ws + WS_Y); const bf16* XB = (const bf16*)(ws + WS_XB); const float* ROWSS = (const float*)(ws + WS_ROWSS);
    for (int s = gw; s < 8192; s += NGW) {
        const int row = (int)(((unsigned)s * 2654435761u) >> 18) & 16383;
        if (mode == 1) {
            const float* x = A.in[0] + (size_t)row * D; const float r = row_r_from(x, lane); const float* gam = A.in[2] + (size_t)L * D;
            const int c = (s * 37) % FF; const float* Wg = A.in[3] + (size_t)L * D * FF; const float* Wu = A.in[4] + (size_t)L * D * FF;
            float g = 0.f, u = 0.f;
            for (int j = 0; j < 16; ++j) { const int k = lane + 64 * j; const float xn = x[k] * r * gam[k]; g += xn * Wg[(size_t)k * FF + c]; u += xn * Wu[(size_t)k * FF + c]; }
            g = wave_sum(g); u = wave_sum(u);
            const float ref = g / (1.0f + expf(-g)) * u, mine = bflo((unsigned)HMID[(size_t)row * FF + c]);
            chk_put2(ws, (mine - ref) * (mine - ref), ref * ref);
        } else if (mode == 2) {
            const int c = (s * 37) % D; const float* Wd = A.in[5] + (size_t)L * FF * D;
            float a = 0.f;
            for (int j = lane; j < FF; j += 64) a += bflo((unsigned)HMID[(size_t)row * FF + j]) * Wd[(size_t)j * D + c];
            a = wave_sum(a);
            const float ref = A.in[0][(size_t)row * D + c] + 0.5f * a, mine = A.out[(size_t)row * D + c];
            float d2 = (mine - ref) * (mine - ref);
            const float xbv = bflo((unsigned)XB[(size_t)row * D + c]); d2 += (xbv - mine) * (xbv - mine);
            float ss = 0.f; for (int j = 0; j < 16; ++j) { const float v = A.out[(size_t)row * D + lane + 64 * j]; ss += v * v; } ss = wave_sum(ss);
            float ps = 0.f; if (lane < 16) ps = ROWSS[(size_t)lane * M + row]; ps = wave_sum(ps);
            d2 += (ps - ss) * (ps - ss) / (ss * ss) * ref * ref;
            chk_put2(ws, d2, ref * ref);
        } else if (mode == 3) {
            const int hidx = (s * 13) % 75; const float* x = A.out + (size_t)row * D; const float r = row_r_from(x, lane); const float* gam = A.in[6] + (size_t)L * D;
            const float* W = A.in[7] + (size_t)L * D * NIN; const int c = 64 * hidx + lane;
            float a = 0.f; for (int k = 0; k < D; ++k) a += x[k] * r * gam[k] * W[(size_t)k * NIN + c];
            int gi = -1; float post = 1.f; const float C2 = 0.125f * LOG2E;
            if (hidx < 12) { gi = 0; post = C2; } else if (hidx < 24) gi = 1; else if (hidx < 36) {} else if (hidx < 44) { gi = 2; post = C2; } else if (hidx < 52) gi = 3; else if (hidx < 60) {}
            else if (hidx < 64) { gi = 4; post = C2; } else if (hidx == 64) gi = 5; else if (hidx == 65) {} else if (hidx < 74) post = 0.125f;
            float ref = a * post;
            if (gi >= 0) { const float ms = wave_sum(a * a) * (1.0f / 64.0f); ref = a / sqrtf(ms + 1e-6f) * (A.in[8] + (size_t)L * 384)[gi * 64 + lane] * post; }
            const float mine = bflo((unsigned)PROJ[(size_t)row * PP + c]);
            chk_put2(ws, wave_sum((mine - ref) * (mine - ref)), wave_sum(ref * ref));
        } else if (mode == 4) {
            const float* x = A.out + (size_t)row * D; const float r = row_r_from(x, lane); const float* gam = A.in[6] + (size_t)L * D;
            const float* W = A.in[7] + (size_t)L * D * NIN; const int c = ((s * 29) % 48) * 64 + lane;
            float a = 0.f; for (int k = 0; k < D; ++k) a += x[k] * r * gam[k] * W[(size_t)k * NIN + GATE_COL0 + c];
            float ref = 1.0f / (1.0f + expf(-a)), mine = bflo((unsigned)GATES[(size_t)row * NGATE + c]);
            if (!(MODE4_FILTER)) { ref = 0.f; mine = 0.f; }
#ifdef MODE4_HALF
            mine = mine - 0.5f + ref;
#endif
            chk_put2(ws, wave_sum((mine - ref) * (mine - ref)), wave_sum(ref * ref));
        } else if (mode == 5) {
            const int c = ((s * 29) % 16) * 64 + lane;
            const float* Wa = A.in[11] + (size_t)L * 256 * D; const float* Wb = A.in[12] + (size_t)L * 512 * D; const float* Wc = A.in[13] + (size_t)L * 256 * D;
            float ya = 0.f, yb = 0.f, yc = 0.f;
            for (int j = 0; j < 256; ++j) ya += bflo((unsigned)OATT[(size_t)row * 1024 + j]) * Wa[(size_t)j * D + c];
            for (int j = 0; j < 512; ++j) yb += bflo((unsigned)OATT[(size_t)row * 1024 + 256 + j]) * Wb[(size_t)j * D + c];
            for (int j = 0; j < 256; ++j) yc += bflo((unsigned)OATT[(size_t)row * 1024 + 768 + j]) * Wc[(size_t)j * D + c];
            const float ref = bflo((unsigned)GATES[(size_t)row * NGATE + c]) * ya + bflo((unsigned)GATES[(size_t)row * NGATE + 1024 + c]) * yb + bflo((unsigned)GATES[(size_t)row * NGATE + 2048 + c]) * yc;
            const float mine = bflo((unsigned)Y[(size_t)row * 1024 + c]);
            chk_put2(ws, wave_sum((mine - ref) * (mine - ref)), wave_sum(ref * ref));
        } else if (mode == 6) {
            const int id = s % 10; const unsigned hsh = ((unsigned)s * 64u + (unsigned)lane) * 2246822519u; const unsigned char* wb = ws + WS_W;
            float ref = 0.f, mine = 0.f;
            if (id == 0 || id == 8) { const int n = (hsh >> 8) % 5632, k = (hsh >> 21) % 1024, tile = n >> 8, l = n & 255; const bool second = id == 8;
                const float* W = (l < 128) ? (second ? A.in[16] : A.in[3]) : (second ? A.in[17] : A.in[4]); const float* gam = second ? A.in[15] : A.in[2];
                ref = W[(size_t)L * D * FF + (size_t)k * FF + 128 * tile + (l & 127)] * gam[(size_t)L * D + k]; mine = bflo((unsigned)((const bf16*)(wb + (second ? O_GU2 : O_GU1)))[(size_t)n * D + k]); }
            else if (id == 1 || id == 9) { const int n = (hsh >> 8) % 1024, k = (hsh >> 19) % FF; const float* W = (id == 9) ? A.in[18] : A.in[5];
                ref = W[(size_t)L * FF * D + (size_t)k * D + n]; mine = bflo((unsigned)((const bf16*)(wb + (id == 9 ? O_DN2 : O_DN1)))[(size_t)n * FF + k]); }
            else if (id == 2) { const int n = (hsh >> 8) % 4864, k = (hsh >> 21) % 1024, tile = n >> 8, l = n & 255, bj = l >> 7, wc = (l & 127) >> 5, col = 256 * tile + 64 * wc + 32 * bj + (l & 31);
                ref = (col < 4808) ? A.in[7][(size_t)L * D * NIN + (size_t)k * NIN + col] * A.in[6][(size_t)L * D + k] : 0.f; mine = bflo((unsigned)((const bf16*)(wb + O_QKV))[(size_t)n * D + k]); }
            else if (id == 3) { const int n = (hsh >> 8) % 3072, k = (hsh >> 21) % 1024;
                ref = A.in[7][(size_t)L * D * NIN + (size_t)k * NIN + GATE_COL0 + n] * A.in[6][(size_t)L * D + k]; mine = bflo((unsigned)((const bf16*)(wb + O_GATE))[(size_t)n * D + k]); }
            else if (id == 4 || id == 6) { const int n = (hsh >> 8) % 1024, k = (hsh >> 19) % 256; const float* W = (id == 4) ? A.in[11] : A.in[13];
                ref = W[(size_t)L * 256 * D + (size_t)k * D + n]; mine = bflo((unsigned)((const bf16*)(wb + (id == 4 ? O_BA : O_BC)))[(size_t)n * 256 + k]); }
            else if (id == 5) { const int n = (hsh >> 8) % 1024, k = (hsh >> 19) % 512; ref = A.in[12][(size_t)L * 512 * D + (size_t)k * D + n]; mine = bflo((unsigned)((const bf16*)(wb + O_BB))[(size_t)n * 512 + k]); }
            else { const int n = (hsh >> 8) % 1024, k = (hsh >> 19) % 1024; ref = A.in[14][(size_t)L * D * D + (size_t)k * D + n]; mine = bflo((unsigned)((const bf16*)(wb + O_OUT))[(size_t)n * D + k]); }
            if (MODE6_ONLY >= 0 && id != MODE6_ONLY) { ref = 0.f; mine = 0.f; }
            chk_put2(ws, wave_sum((mine - ref) * (mine - ref)), wave_sum(ref * ref));
        } else { chk_put2(ws, 1.0f, 1.0f); }
    }
}
__global__ void __launch_bounds__(256) k_report(unsigned char* ws, float* out) {
    const float sd = ((const float*)(ws + WS_CTL))[8], sr = ((const float*)(ws + WS_CTL))[9]; const float v = sqrtf(sd / fmaxf(sr, 1e-30f)); const float K = 1.0e5f * fminf(v, 1.0e3f);
    for (size_t i = (size_t)blockIdx.x * 256 + threadIdx.x; i < (size_t)M * D; i += (size_t)gridDim.x * 256) out[i] = K;
}
#ifndef FAST_B
#define FAST_B 1
#endif
#ifndef GATE_ALIGN
#define GATE_ALIGN true
#endif
#ifndef MERGE_CALLS
#define MERGE_CALLS 3
#endif
#ifndef ORACLE_MASK
#define ORACLE_MASK 7
#endif
#ifndef PHASE_MASK
#define PHASE_MASK 0x7ff
#endif
constexpr int NPH_LAYER = 11, NPHASE = 1 + NLAYER * NPH_LAYER;
__global__ void __launch_bounds__(NWAVES * 64, 2) mk_fwd(const Args A) {
    extern __shared__ __attribute__((aligned(16))) unsigned char lds[];
    Frame F;
    F.lds = (LAS unsigned char*)lds;
    F.MISC = (volatile LAS unsigned*)(F.lds + MISC_OFF);
    F.tid = threadIdx.x; F.lane = F.tid & 63; F.wave = __builtin_amdgcn_readfirstlane(F.tid >> 6);
    F.G = gridDim.x; F.bx = blockIdx.x;
    gu32* const ctl = (gu32*)(A.ws + WS_CTL);
    for (int u = F.tid; u < (LDS_BYTES - MISC_OFF) / 4; u += NWAVES * 64) ((LAS unsigned*)(F.lds + MISC_OFF))[u] = 0u;
    __syncthreads();
    const int lo = A.lo, hi = A.hi;
    XcdBarrier bar; bar.bar = (unsigned*)(ctl + CW_BAR); bar.x = 0; bar.st = nullptr;
    if (hi - lo > 1) bar = xcd_barrier_post((unsigned*)(ctl + CW_BAR), F.MISC + 8);
#define IN(k) (lo <= (k) && (k) < hi)
#define SEAM(k) do { if (IN(k) && IN((k) + 1)) xcd_barrier(bar); } while (0)
    bf16* const XB = (bf16*)(A.ws + WS_XB); bf16* const PROJ = (bf16*)(A.ws + WS_PROJ); bf16* const HMID = (bf16*)(A.ws + WS_HMID); bf16* const GATES = (bf16*)(A.ws + WS_GATES);
    bf16* const OATT = (bf16*)(A.ws + WS_OATT); bf16* const Y = (bf16*)(A.ws + WS_Y); float* const ROWSS = (float*)(A.ws + WS_ROWSS); float* const WIDX = (float*)(A.ws + WS_WIDX);
    unsigned char* const wb = A.ws + WS_W;

    if (IN(0)) { phase_prologue(F, A); } SEAM(0);

    for (int L = 0; L < NLAYER; ++L) {
        const int g0 = 1 + L * NPH_LAYER;
        if (hi <= g0 || lo >= g0 + NPH_LAYER) continue;
        if (((PHASE_MASK >> 0) & 1) && IN(g0 + 0)) { phase_convert(F, A, L); } SEAM(g0 + 0);
        if (((PHASE_MASK >> 1) & 1) && IN(g0 + 1)) {
            pg8::Gemm g{XB, (const bf16*)(wb + O_GU1), M, 2 * FF, D, D}; pg8::StaticOrder S; S.init(M, 2 * FF, F.G, F.bx);
            epi::EpiSwiGLU E{HMID, FF, ROWSS};
            pg8::gemm_phase<epi::EpiSwiGLU, pg8::StaticOrder, true, true>(F.lds + RING_OFF, g, S, E);
        } SEAM(g0 + 1);
        if (((PHASE_MASK >> 2) & 1) && IN(g0 + 2)) {
            pg8::Gemm g{HMID, (const bf16*)(wb + O_DN1), M, D, FF, FF}; pg8::StaticOrder S; S.init(M, D, F.G, F.bx);
            epi::EpiResidual E{(L == 0) ? A.in[0] : (const float*)A.out, A.out, XB, ROWSS, 0.5f};
            pg8::gemm_phase<epi::EpiResidual, pg8::StaticOrder, false, true>(F.lds + RING_OFF, g, S, E);
        } SEAM(g0 + 2);
        if (((PHASE_MASK >> 3) & 1) && IN(g0 + 3)) {
            pg8::Gemm g{XB, (const bf16*)(wb + O_QKV), M, PP, D, D}; pg8::StaticOrder S; S.init(M, PP, F.G, F.bx);
            epi::EpiQKV E{PROJ, PP, ROWSS, A.in[8] + (size_t)L * 384, WIDX};
            pg8::gemm_phase<epi::EpiQKV, pg8::StaticOrder, true, true>(F.lds + RING_OFF, g, S, E);
        } SEAM(g0 + 3);
        if (((PHASE_MASK >> 4) & 1) && IN(g0 + 4)) {
            phase_attn_B(F, A);
            phase_attn_A(F, A);
            phase_C1(F, A);
        } SEAM(g0 + 4);
        if (((PHASE_MASK >> 5) & 1) && IN(g0 + 5)) {
            phase_C2(F, A);
            phase_combine_B(F, A, L);
            phase_merge_A(F, A);
        } SEAM(g0 + 5);
        if (((PHASE_MASK >> 6) & 1) && IN(g0 + 6)) {
            pg8::Gemm g{XB, (const bf16*)(wb + O_GATE), M, NGATE, D, D}; pg8::StaticOrder S; S.init(M, NGATE, F.G, F.bx);
            epi::EpiSigmoid E{GATES, NGATE, ROWSS};
            pg8::gemm_phase<epi::EpiSigmoid, pg8::StaticOrder, GATE_ALIGN, true>(F.lds + RING_OFF, g, S, E);
        } SEAM(g0 + 6);
        if (((PHASE_MASK >> 7) & 1) && IN(g0 + 7)) {
            pg8::StaticOrder S; S.init(M, D, F.G, F.bx);
            { pg8::Gemm g{OATT, (const bf16*)(wb + O_BA), M, D, 256, 1024}; epi::EpiMerge E{Y, GATES, NGATE, 0};
              pg8::gemm_phase<epi::EpiMerge, pg8::StaticOrder, false, true>(F.lds + RING_OFF, g, S, E); }
#if MERGE_CALLS > 1
            { pg8::Gemm g{OATT + 256, (const bf16*)(wb + O_BB), M, D, 512, 1024}; epi::EpiMerge E{Y, GATES + 1024, NGATE, 1};
              pg8::gemm_phase<epi::EpiMerge, pg8::StaticOrder, false, true>(F.lds + RING_OFF, g, S, E); }
            { pg8::Gemm g{OATT + 768, (const bf16*)(wb + O_BC), M, D, 256, 1024}; epi::EpiMerge E{Y, GATES + 2048, NGATE, 1};
              pg8::gemm_phase<epi::EpiMerge, pg8::StaticOrder, false, true>(F.lds + RING_OFF, g, S, E); }
#endif
        } SEAM(g0 + 7);
        if (((PHASE_MASK >> 8) & 1) && IN(g0 + 8)) {
            pg8::Gemm g{Y, (const bf16*)(wb + O_OUT), M, D, D, D}; pg8::StaticOrder S; S.init(M, D, F.G, F.bx);
            epi::EpiResidual E{(const float*)A.out, A.out, XB, ROWSS, 1.0f};
            pg8::gemm_phase<epi::EpiResidual, pg8::StaticOrder, false, true>(F.lds + RING_OFF, g, S, E);
        } SEAM(g0 + 8);
        if (((PHASE_MASK >> 9) & 1) && IN(g0 + 9)) {
            pg8::Gemm g{XB, (const bf16*)(wb + O_GU2), M, 2 * FF, D, D}; pg8::StaticOrder S; S.init(M, 2 * FF, F.G, F.bx);
            epi::EpiSwiGLU E{HMID, FF, ROWSS};
            pg8::gemm_phase<epi::EpiSwiGLU, pg8::StaticOrder, true, true>(F.lds + RING_OFF, g, S, E);
        } SEAM(g0 + 9);
        if (((PHASE_MASK >> 10) & 1) && IN(g0 + 10)) {
            pg8::Gemm g{HMID, (const bf16*)(wb + O_DN2), M, D, FF, FF}; pg8::StaticOrder S; S.init(M, D, F.G, F.bx);
            epi::EpiResidual E{(const float*)A.out, A.out, XB, ROWSS, 0.5f};
            pg8::gemm_phase<epi::EpiResidual, pg8::StaticOrder, false, true>(F.lds + RING_OFF, g, S, E);
        } SEAM(g0 + 10);
    }
#undef IN
#undef SEAM
}

__global__ void __launch_bounds__(256) k_oracle_A(unsigned char* ws) { oracle_A(ws, blockIdx.x * 4 + (threadIdx.x >> 6), gridDim.x * 4, threadIdx.x & 63); }
__global__ void __launch_bounds__(256) k_oracle_B(unsigned char* ws, const float* lv, const float* dn, int L) { oracle_B(ws, blockIdx.x * 4 + (threadIdx.x >> 6), gridDim.x * 4, lv + (size_t)L * 256, dn + (size_t)L * 128, L, threadIdx.x & 63); }
__global__ void __launch_bounds__(128, 1) k_oracle_C(unsigned char* ws) { extern __shared__ __attribute__((aligned(16))) unsigned char olds[]; oracle_C(ws, blockIdx.x * 2 + (threadIdx.x >> 6), gridDim.x * 2, (LAS unsigned char*)olds + (threadIdx.x >> 6) * 18944, threadIdx.x & 63); }
__global__ void __launch_bounds__(256) k_fill(unsigned char* ws) { const bf16* P = (const bf16*)(ws + WS_PROJ); bf16* O = (bf16*)(ws + WS_OATT);
    for (size_t i = (size_t)blockIdx.x * 256 + threadIdx.x; i < (size_t)M * 1024; i += (size_t)gridDim.x * 256) { const size_t row = i >> 10, c = i & 1023; O[row * 1024 + c] = P[row * PP + c]; } }
extern "C" void kernel_launch(void* const* d_in, const int* in_sizes, int n_in, void* d_out, int out_size, void* d_ws, size_t ws_size, hipStream_t stream) {
    static int grid = 0;
    if (grid == 0) {
        if (n_in != 19 || in_sizes[0] != M * D || out_size != M * D || ws_size < WS_END) { fprintf(stderr, "kernel_launch: unexpected shapes / workspace (n_in %d, ws %zu)\n", n_in, ws_size); grid = -1; return; }
        int dev = 0, cus = 0, per_cu = 0;
        if (hipGetDevice(&dev) != hipSuccess || hipDeviceGetAttribute(&cus, hipDeviceAttributeMultiprocessorCount, dev) != hipSuccess) { grid = -1; return; }
        if (hipFuncSetAttribute((const void*)mk_fwd, hipFuncAttributeMaxDynamicSharedMemorySize, LDS_BYTES) != hipSuccess) { fprintf(stderr, "kernel_launch: hipFuncSetAttribute failed\n"); grid = -1; return; }
        if (hipOccupancyMaxActiveBlocksPerMultiprocessor(&per_cu, (const void*)mk_fwd, NWAVES * 64, LDS_BYTES) != hipSuccess || per_cu < 1) { fprintf(stderr, "kernel_launch: occupancy query says %d\n", per_cu); }
        (void)hipGetLastError();
        grid = cus;
    }
    if (grid < 0) return;
    (void)hipMemsetAsync((char*)d_ws + WS_CTL, 0, CTL_ZERO_BYTES, stream);
    Args a{};
    for (int i = 0; i < 19; ++i) a.in[i] = (const float*)d_in[i];
    a.out = (float*)d_out; a.ws = (unsigned char*)d_ws;
#if defined(CHECK_MODE)
    for (int g = 0; g <= CHECK_UPTO; ++g) { a.lo = g; a.hi = g + 1; hipLaunchKernelGGL(mk_fwd, dim3(grid), dim3(NWAVES * 64), LDS_BYTES, stream, a);
        if (g >= 1 && (g - 1) % NPH_LAYER == 4) hipLaunchKernelGGL(k_fill, dim3(2048), dim3(256), 0, stream, a.ws); }
    a.lo = 0; a.hi = 0;
    hipLaunchKernelGGL(k_check, dim3(512), dim3(256), 0, stream, a, (int)CHECK_MODE, 0);
    hipLaunchKernelGGL(k_report, dim3(2048), dim3(256), 0, stream, a.ws, a.out);
#elif MK_N_LAUNCHES == 1
    a.lo = 0; a.hi = NPHASE;
    hipLaunchKernelGGL(mk_fwd, dim3(grid), dim3(NWAVES * 64), LDS_BYTES, stream, a);
#else
    for (int g = 0; g < NPHASE; ++g) { a.lo = g; a.hi = g + 1; hipLaunchKernelGGL(mk_fwd, dim3(grid), dim3(NWAVES * 64), LDS_BYTES, stream, a);
        if (ORACLE_MASK && ((PHASE_MASK >> 4) & 1) && g >= 1 && (g - 1) % NPH_LAYER == 4) { const int L = (g - 1) / NPH_LAYER;
            if (ORACLE_MASK & 8) hipLaunchKernelGGL(k_fill, dim3(2048), dim3(256), 0, stream, a.ws);
            if (ORACLE_MASK & 1) hipLaunchKernelGGL(k_oracle_A, dim3(4096), dim3(256), 0, stream, a.ws);
            if ((ORACLE_MASK & 2) && !FAST_B) hipLaunchKernelGGL(k_oracle_B, dim3(4096), dim3(256), 0, stream, a.ws, a.in[9], a.in[10], L);
            if (ORACLE_MASK & 4) hipLaunchKernelGGL(k_oracle_C, dim3(4096), dim3(128), 2 * 18944, stream, a.ws); } }
#endif
}
```

```cpp
#include <hip/hip_runtime.h>
#include <cstdio>
#include <cstdint>
#include <cmath>
#ifndef MK_N_LAUNCHES
#define MK_N_LAUNCHES 1
#endif
namespace pg8 {
#define PG8_LAS __attribute__((address_space(3)))
typedef unsigned short bf16_t;
typedef short bf16x8 __attribute__((ext_vector_type(8)));
typedef float f32x4 __attribute__((ext_vector_type(4)));
typedef unsigned u32x4 __attribute__((ext_vector_type(4)));
typedef unsigned u32x2 __attribute__((ext_vector_type(2)));
constexpr int BM = 256, BK = 64, HALF = 128, HTB = HALF * BK * 2  , STAGE_BYTES = 8 * HTB, NXCD = 8, WGM = 8;

__host__ __device__ __forceinline__ int lds_byte(int r, int c) { const int st = (r >> 4) * 2 + (c >> 5), rr = r & 15, cc = c & 31, ob = rr * 64 + cc * 2; return st * 1024 + (ob ^ (((ob >> 9) & 1) << 5)); }
__host__ __device__ __forceinline__ void stage_rc(int b, int& R, int& C) { const int st = b / 1024, sb = b % 1024, swz = sb ^ (((sb >> 9) & 1) << 5); R = (st >> 1) * 16 + swz / 64; C = (st & 1) * 32 + (swz % 64) / 2; }
__host__ __device__ __forceinline__ int perm32(int rho) { const int n = rho >> 4, i = rho & 15; return 8 * (i >> 2) + 4 * n + (i & 3); }

struct Unit { int pm, pn; };
struct Gemm { const bf16_t* A; const bf16_t* Bt; int M, N, K, lda; };

struct StaticOrder {
    int nM, nN, nwg, G, c;
    __host__ __device__ void init(int M, int N, int G_, int c_) { nM = M / BM; nN = N / BM; nwg = nM * nN; G = G_; c = c_; }
    __host__ __device__ bool next(int i, Unit& u) const {
        const long L = (long)i * G + c; if (L >= nwg) return false;
        int wgid = (int)L; { const int q = nwg / NXCD, r = nwg % NXCD, xcd = wgid % NXCD, off = wgid / NXCD; wgid = (xcd < r ? xcd * (q + 1) : r * (q + 1) + (xcd - r) * q) + off; }
        const int nig = WGM * nN, gid = wgid / nig, fm = gid * WGM, gsz = (nM - fm) < WGM ? (nM - fm) : WGM;
        u.pm = fm + ((wgid % nig) % gsz); u.pn = (wgid % nig) / gsz; return true;
    }
    __device__ __forceinline__ void a_ready(const Unit&) const {}
    __device__ __forceinline__ void done(const Unit&) const {}
};
#ifndef QKV_F8MASK
#define QKV_F8MASK 0x803Fu
#endif
template <bool F8SET> struct SubsetOrder {
    int nM, nN, nwg, G, c;
    static constexpr unsigned MASK = F8SET ? (QKV_F8MASK & 0x7FFFFu) : (~QKV_F8MASK & 0x7FFFFu);
    static constexpr int LEN = __builtin_popcount(MASK);
    __host__ __device__ static int map(int p) { int cnt = 0, res = 0;
        _Pragma("unroll") for (int t = 0; t < 19; ++t) if ((MASK >> t) & 1u) { res = (cnt == p) ? t : res; ++cnt; }
        return res; }
    __host__ __device__ void init(int M, int G_, int c_) { nM = M / BM; nN = LEN; nwg = nM * nN; G = G_; c = c_; }
    __host__ __device__ bool next(int i, Unit& u) const {
        const long L = (long)i * G + c; if (L >= nwg) return false;
        int wgid = (int)L; { const int q = nwg / NXCD, r = nwg % NXCD, xcd = wgid % NXCD, off = wgid / NXCD; wgid = (xcd < r ? xcd * (q + 1) : r * (q + 1) + (xcd - r) * q) + off; }
        const int nig = WGM * nN, gid = wgid / nig, fm = gid * WGM, gsz = (nM - fm) < WGM ? (nM - fm) : WGM;
        u.pm = fm + ((wgid % nig) % gsz); u.pn = map((wgid % nig) / gsz); return true;
    }
    __device__ __forceinline__ void a_ready(const Unit&) const {}
    __device__ __forceinline__ void done(const Unit&) const {}
};

typedef float f32x2_t __attribute__((ext_vector_type(2))); typedef __bf16 bf16x2_t __attribute__((ext_vector_type(2)));
__device__ __forceinline__ unsigned cvt_pk_bf16(float lo, float hi) { f32x2_t v = {lo, hi}; bf16x2_t b = __builtin_convertvector(v, bf16x2_t); return __builtin_bit_cast(unsigned, b); }

__device__ __forceinline__ int hw_lane() { int l; asm volatile("v_mbcnt_lo_u32_b32 %0, -1, 0\n\tv_mbcnt_hi_u32_b32 %0, -1, %0" : "=v"(l)); return l; }
typedef int v4i_t_ __attribute__((ext_vector_type(4))); typedef int v8i_t_ __attribute__((ext_vector_type(8)));
__device__ __forceinline__ v8i_t_ cat8(bf16x8 a, bf16x8 b) { const v4i_t_ x = __builtin_bit_cast(v4i_t_, a), y = __builtin_bit_cast(v4i_t_, b); return __builtin_shufflevector(x, y, 0, 1, 2, 3, 4, 5, 6, 7); }
template <class Epi, class Sched, bool ALIGN_EPI = false, bool SP2 = false, bool FP8 = false>
__device__ __forceinline__ void gemm_phase(PG8_LAS unsigned char* lds, const Gemm g, const Sched& S, const Epi& E, int wave_) {
    int tid_ = wave_ * 64 + hw_lane();
    const int tid = tid_, wid = __builtin_amdgcn_readfirstlane(tid >> 6), lane = tid & 63, wr = wid >> 2, wc = wid & 3, fr = lane & 15, fq = lane >> 4;
    const int K = g.K, nt = K / BK, lda = g.lda;
    unsigned voffA[2], voffB[2];
#pragma unroll
    for (int i = 0; i < 2; ++i) { int R, C; stage_rc(tid * 16 + i * 8192, R, C); const int Rb = Epi::PERM ? ((R & ~31) + perm32(R & 31)) : R;
        voffA[i] = (unsigned)(R * lda + C) * 2u; voffB[i] = (unsigned)(Rb * K + C) * 2u; }
    const size_t kstep = (size_t)(BK * 2);
    const size_t hstepA = (size_t)HALF * lda * 2, hstepB = (size_t)HALF * K * 2;
    const size_t tstepA = 2 * hstepA, tstepB = 2 * hstepB;
    const unsigned ldsw = (unsigned)wid * 1024u;
    const int aoff = lds_byte(wr * 64 + fr, fq * 8), boff = lds_byte(wc * 32 + fr, fq * 8);
#define PG8_SA(b, h) (((b) * 2 + (h)) * HTB)
#define PG8_SB(b, h) ((4 + (b) * 2 + (h)) * HTB)
#define PG8_STAGE(bufoff, gbase, voff) do { _Pragma("unroll") for (int _i = 0; _i < 2; ++_i) { unsigned vo_ = (voff)[_i]; if constexpr (FP8) asm volatile("" : "+v"(vo_));     \
        __builtin_amdgcn_global_load_lds((const unsigned*)((const char*)(gbase) + vo_), (PG8_LAS unsigned*)(lds + (bufoff) + ldsw + _i * 8192), 16, 0, 0); } } while (0)
#define PG8_LDA(dst, b, h) do { _Pragma("unroll") for (int m = 0; m < 4; ++m) _Pragma("unroll") for (int k = 0; k < 2; ++k) dst[m][k] = *(const PG8_LAS bf16x8*)(lds + PG8_SA(b, h) + aoff + m * 2048 + k * 1024); } while (0)
#define PG8_LDB(dst, b, h) do { _Pragma("unroll") for (int n = 0; n < 2; ++n) _Pragma("unroll") for (int k = 0; k < 2; ++k) dst[n][k] = *(const PG8_LAS bf16x8*)(lds + PG8_SB(b, h) + boff + n * 2048 + k * 1024); } while (0)
#define PG8_MMA(ai, bj, At, Bt) do { __builtin_amdgcn_s_setprio(1); _Pragma("unroll") for (int m = 0; m < 4; ++m) _Pragma("unroll") for (int n = 0; n < 2; ++n) { \
        if constexpr (FP8) acc[ai][bj][m][n] = __builtin_amdgcn_mfma_scale_f32_16x16x128_f8f6f4(cat8(Bt[n][0], Bt[n][1]), cat8(At[m][0], At[m][1]), acc[ai][bj][m][n], 0, 0, 0, 0x7f7f7f7f, 0, 0x7f7f7f7f); \
        else { _Pragma("unroll") for (int k = 0; k < 2; ++k) acc[ai][bj][m][n] = __builtin_amdgcn_mfma_f32_16x16x32_bf16(Bt[n][k], At[m][k], acc[ai][bj][m][n], 0, 0, 0); } } \
        __builtin_amdgcn_s_setprio(0); } while (0)
#define PG8_WAIT_V(n) asm volatile("s_waitcnt vmcnt(" #n ")" ::: "memory")
#define PG8_WAIT_L(n) asm volatile("s_waitcnt lgkmcnt(" #n ")" ::: "memory")
#define PG8_WAIT_VF() asm volatile("s_cmp_lg_u32 %0, 0\n\ts_cbranch_scc1 .Lpg8w%=\n\ts_waitcnt vmcnt(8)\n.Lpg8w%=:\n\ts_waitcnt vmcnt(%1)" :: "s"(fst), "n"(8 + Epi::NST) : "scc", "memory")
#define PG8_BAR __builtin_amdgcn_s_barrier()
#define PG8_SCHED __builtin_amdgcn_sched_barrier(0)
    Unit cur, nxt; int ui = 0;
    if (!S.next(0, cur)) return;
    f32x4 acc[2][2][4][2];
#pragma unroll
    for (int a = 0; a < 2; ++a)
#pragma unroll
        for (int b = 0; b < 2; ++b)
#pragma unroll
            for (int m = 0; m < 4; ++m)
#pragma unroll
                for (int n = 0; n < 2; ++n) acc[a][b][m][n] = (f32x4){0.f, 0.f, 0.f, 0.f};
    bf16x8 At[4][2], B0[2][2], B1[2][2];
    const char* cA = (const char*)g.A + (size_t)cur.pm * tstepA; const char* cB = (const char*)g.Bt + (size_t)cur.pn * tstepB;
    S.a_ready(cur);
    if constexpr (SP2) {
        PG8_STAGE(PG8_SB(0, 0), cB, voffB); PG8_STAGE(PG8_SB(0, 1), cB + hstepB, voffB); PG8_STAGE(PG8_SA(0, 0), cA, voffA); PG8_STAGE(PG8_SA(0, 1), cA + hstepA, voffA);
        if (wr == 1) PG8_BAR;
        PG8_WAIT_V(2); PG8_BAR;
        PG8_STAGE(PG8_SB(1, 0), cB + kstep, voffB); PG8_STAGE(PG8_SA(1, 0), cA + kstep, voffA); PG8_STAGE(PG8_SB(1, 1), cB + hstepB + kstep, voffB);
        PG8_WAIT_V(6); PG8_BAR;
    } else {
        PG8_STAGE(PG8_SB(0, 0), cB, voffB); PG8_STAGE(PG8_SA(0, 0), cA, voffA); PG8_STAGE(PG8_SB(0, 1), cB + hstepB, voffB); PG8_STAGE(PG8_SA(0, 1), cA + hstepA, voffA);
        if (wr == 1) PG8_BAR;
        PG8_WAIT_V(4); PG8_BAR;
        PG8_STAGE(PG8_SB(1, 0), cB + kstep, voffB); PG8_STAGE(PG8_SA(1, 0), cA + kstep, voffA); PG8_STAGE(PG8_SB(1, 1), cB + hstepB + kstep, voffB);
        PG8_WAIT_V(6); PG8_BAR;
    }
    for (;;) {
        const bool has_next = S.next(ui + 1, nxt);
        const char* nA = has_next ? (const char*)g.A + (size_t)nxt.pm * tstepA : cA; const char* nB = has_next ? (const char*)g.Bt + (size_t)nxt.pn * tstepB : cB;
        for (int t = 0; t < nt; t += 2) {
            const bool last = (t == nt - 2);
            const char* a1 = cA + (size_t)(t + 1) * kstep;
            const char* a2 = last ? nA : cA + (size_t)(t + 2) * kstep; const char* b2 = last ? nB : cB + (size_t)(t + 2) * kstep;
            const char* a3 = a2 + kstep; const char* b3 = b2 + kstep;
            if (last && has_next) S.a_ready(nxt);
            if constexpr (SP2) {
            const int fst = __builtin_amdgcn_readfirstlane(((t == 0) && (ui > 0)) ? 1 : 0);
            PG8_LDB(B0, 0, 0); PG8_LDB(B1, 0, 1); PG8_SCHED; PG8_LDA(At, 0, 0); PG8_STAGE(PG8_SA(1, 1), a1 + hstepA, voffA);
            PG8_WAIT_VF(); PG8_WAIT_L(0); PG8_BAR; PG8_MMA(0, 0, At, B0); PG8_MMA(0, 1, At, B1); PG8_BAR; PG8_SCHED;
            PG8_LDA(At, 0, 1); PG8_STAGE(PG8_SB(0, 0), b2, voffB); PG8_STAGE(PG8_SB(0, 1), b2 + hstepB, voffB); PG8_STAGE(PG8_SA(0, 0), a2, voffA);
            PG8_WAIT_VF(); PG8_WAIT_L(0); PG8_BAR; PG8_MMA(1, 0, At, B0); PG8_MMA(1, 1, At, B1); PG8_BAR; PG8_SCHED;
            PG8_LDB(B0, 1, 0); PG8_LDB(B1, 1, 1); PG8_SCHED; PG8_LDA(At, 1, 0); PG8_STAGE(PG8_SA(0, 1), a2 + hstepA, voffA);
            PG8_WAIT_V(8); PG8_WAIT_L(0); PG8_BAR; PG8_MMA(0, 0, At, B0); PG8_MMA(0, 1, At, B1); PG8_BAR; PG8_SCHED;
            PG8_LDA(At, 1, 1); PG8_STAGE(PG8_SB(1, 0), b3, voffB); PG8_STAGE(PG8_SB(1, 1), b3 + hstepB, voffB); PG8_STAGE(PG8_SA(1, 0), a3, voffA);
            PG8_WAIT_V(8); PG8_WAIT_L(0); PG8_BAR; PG8_MMA(1, 0, At, B0); PG8_MMA(1, 1, At, B1); PG8_BAR; PG8_SCHED;
            } else {
            PG8_LDB(B0, 0, 0); PG8_SCHED; PG8_LDA(At, 0, 0); PG8_STAGE(PG8_SA(1, 1), a1 + hstepA, voffA);
            PG8_WAIT_L(8); PG8_BAR; PG8_WAIT_L(0); PG8_MMA(0, 0, At, B0); PG8_BAR; PG8_SCHED;
            PG8_LDB(B1, 0, 1); PG8_STAGE(PG8_SB(0, 0), b2, voffB);
            PG8_BAR; PG8_WAIT_L(0); PG8_MMA(0, 1, At, B1); PG8_BAR;
            PG8_LDA(At, 0, 1); PG8_STAGE(PG8_SA(0, 0), a2, voffA);
            PG8_BAR; PG8_WAIT_L(0); PG8_MMA(1, 0, At, B0); PG8_BAR; PG8_SCHED;
            PG8_STAGE(PG8_SB(0, 1), b2 + hstepB, voffB);
            PG8_WAIT_V(6); PG8_BAR; PG8_MMA(1, 1, At, B1); PG8_BAR;
            PG8_LDB(B0, 1, 0); PG8_SCHED; PG8_LDA(At, 1, 0); PG8_STAGE(PG8_SA(0, 1), a2 + hstepA, voffA);
            PG8_WAIT_L(8); PG8_BAR; PG8_WAIT_L(0); PG8_MMA(0, 0, At, B0); PG8_BAR; PG8_SCHED;
            PG8_LDB(B1, 1, 1); PG8_STAGE(PG8_SB(1, 0), b3, voffB);
            PG8_BAR; PG8_WAIT_L(0); PG8_MMA(0, 1, At, B1); PG8_BAR;
            PG8_LDA(At, 1, 1); PG8_STAGE(PG8_SA(1, 0), a3, voffA);
            PG8_BAR; PG8_WAIT_L(0); PG8_MMA(1, 0, At, B0); PG8_BAR; PG8_SCHED;
            PG8_STAGE(PG8_SB(1, 1), b3 + hstepB, voffB);
            PG8_WAIT_V(6); PG8_BAR; PG8_MMA(1, 1, At, B1); PG8_BAR;
            }
        }
        if constexpr (ALIGN_EPI) { if (wr == 0) PG8_BAR; }
        if constexpr (FP8) { int le_; asm volatile("v_mbcnt_lo_u32_b32 %0, -1, 0\n\tv_mbcnt_hi_u32_b32 %0, -1, %0" : "=v"(le_));
            E(acc, cur, wr, wc, le_ & 15, le_ >> 4); }
        else E(acc, cur, wr, wc, fr, fq);
        S.done(cur);
        if (!has_next) break;
#pragma unroll
        for (int a = 0; a < 2; ++a)
#pragma unroll
            for (int b = 0; b < 2; ++b)
#pragma unroll
                for (int m = 0; m < 4; ++m)
#pragma unroll
                    for (int n = 0; n < 2; ++n) acc[a][b][m][n] = (f32x4){0.f, 0.f, 0.f, 0.f};
        cur = nxt; cA = nA; cB = nB; ++ui;
        if constexpr (ALIGN_EPI) { if (wr == 1) PG8_BAR; }
    }
    PG8_WAIT_V(0);
    if constexpr (!ALIGN_EPI) { if (wr == 0) PG8_BAR; }
    PG8_BAR;
#undef PG8_SA
#undef PG8_SB
#undef PG8_STAGE
#undef PG8_LDA
#undef PG8_LDB
#undef PG8_MMA
#undef PG8_WAIT_V
#undef PG8_WAIT_L
#undef PG8_WAIT_VF
#undef PG8_BAR
#undef PG8_SCHED
}
}
using pg8::hw_lane;
template <class T> __device__ __forceinline__ T mk_shfl(T v, int src) { static_assert(sizeof(T) == 4, "32-bit only"); return __builtin_bit_cast(T, __builtin_amdgcn_ds_bpermute(src << 2, __builtin_bit_cast(int, v))); }
template <class T> __device__ __forceinline__ T mk_shfl_xor(T v, int m) { static_assert(sizeof(T) == 4, "32-bit only"); return __builtin_bit_cast(T, __builtin_amdgcn_ds_bpermute((hw_lane() ^ m) << 2, __builtin_bit_cast(int, v))); }
#define __shfl mk_shfl
#define __shfl_xor mk_shfl_xor
namespace epi {
using pg8::f32x4; using pg8::u32x4; using pg8::u32x2; using pg8::Unit; using pg8::bf16_t; using pg8::cvt_pk_bf16;
constexpr int MROWS = 16384;
constexpr float RMS_EPS = 1e-6f;
__device__ __forceinline__ float bflo(unsigned u) { return __uint_as_float(u << 16); }
__device__ __forceinline__ float bfhi(unsigned u) { return __uint_as_float(u & 0xffff0000u); }
__device__ __forceinline__ float xsum16(float a) { const unsigned u = __builtin_bit_cast(unsigned, a); const auto q = __builtin_amdgcn_permlane16_swap(u, u, false, false); return __uint_as_float((unsigned)q[0]) + __uint_as_float((unsigned)q[1]); }
__device__ __forceinline__ float xsum32(float a) { const unsigned u = __builtin_bit_cast(unsigned, a); const auto q = __builtin_amdgcn_permlane32_swap(u, u, false, false); return __uint_as_float((unsigned)q[0]) + __uint_as_float((unsigned)q[1]); }
__device__ __forceinline__ void row_rs8(const float* rowss, int row0, int fq, float (&r)[2][4]) {
#pragma unroll
    for (int ai = 0; ai < 2; ++ai) { f32x4 v[4];
#pragma unroll
        for (int m = 0; m < 4; ++m) v[m] = *(const f32x4*)(rowss + (size_t)(row0 + ai * 128 + m * 16) * 16 + 4 * fq);
        asm volatile("" : "+v"(v[0]), "+v"(v[1]), "+v"(v[2]), "+v"(v[3]));
#pragma unroll
        for (int m = 0; m < 4; ++m) { const f32x4 t = v[m]; float a = (t[0] + t[1]) + (t[2] + t[3]); a = xsum16(a); a = xsum32(a); r[ai][m] = __builtin_amdgcn_rsqf(a * (1.0f / 1024.0f) + RMS_EPS); } }
}
__device__ __forceinline__ float sigmoidf_(float v) { return __builtin_amdgcn_rcpf(1.0f + __builtin_amdgcn_exp2f(-1.4426950408889634f * v)); }

struct EpiSwiGLU {
    static constexpr int NST = 8;
    static constexpr bool PERM = true;
    bf16_t* H; int ldh; const float* rowss; float post  ;
    __device__ __forceinline__ void operator()(const f32x4 (&acc)[2][2][4][2], const Unit& u, int wr, int wc, int fr_, int fq_) const {
        int fr = fr_, fq = fq_; asm volatile("" : "+v"(fr), "+v"(fq));
        const int row0 = u.pm * 256 + wr * 64 + fr, col0 = u.pn * 128 + wc * 32 + 8 * fq;
        float rs[2][4]; row_rs8(rowss, row0, fq, rs);
#pragma unroll
        for (int ai = 0; ai < 2; ++ai)
#pragma unroll
            for (int m = 0; m < 4; ++m) { const int row = row0 + ai * 128 + m * 16; const float r = rs[ai][m] * post;
                const float c1 = -1.4426950408889634f * r, ir2 = __builtin_amdgcn_rcpf(r * r);
                float h[8];
#pragma unroll
                for (int n = 0; n < 2; ++n)
#pragma unroll
                    for (int i = 0; i < 4; ++i) { const float ag = acc[ai][0][m][n][i], au = acc[ai][1][m][n][i];
                        float t = ag * c1; asm("" : "+v"(t));
                        const float e = __builtin_amdgcn_exp2f(t);
                        float d = __builtin_fmaf(e, ir2, ir2); asm("" : "+v"(d));
                        h[n * 4 + i] = (ag * au) * __builtin_amdgcn_rcpf(d); }
                u32x4 w; w.x = cvt_pk_bf16(h[0], h[1]); w.y = cvt_pk_bf16(h[2], h[3]); w.z = cvt_pk_bf16(h[4], h[5]); w.w = cvt_pk_bf16(h[6], h[7]);
                *(u32x4*)(H + (size_t)row * ldh + col0) = w; asm volatile("" ::: "memory"); }
    }
};

struct EpiResidual {
    static constexpr int NST = 32;
    static constexpr bool PERM = false;
    float* out; bf16_t* xb; float* rowss; unsigned char* x8  ; float scale;
    __device__ __forceinline__ void operator()(const f32x4 (&acc)[2][2][4][2], const Unit& u, int wr, int wc, int fr, int fq) const {
        const int row0 = u.pm * 256 + wr * 64 + fr, col0 = u.pn * 256 + wc * 32 + 4 * fq;
        u32x2 nb[2][2];
#pragma unroll
        for (int bj = 0; bj < 2; ++bj)
#pragma unroll
            for (int n = 0; n < 2; ++n) nb[bj][n] = *(const u32x2*)(xb + (size_t)row0 * 1024 + col0 + bj * 128 + n * 16);
#pragma unroll
        for (int g = 0; g < 8; ++g) { const int ai = g >> 2, m = g & 3; const int row = row0 + ai * 128 + m * 16; const size_t off = (size_t)row * 1024 + col0; float ss = 0.f;
            u32x2 cb[2][2];
#pragma unroll
            for (int bj = 0; bj < 2; ++bj)
#pragma unroll
                for (int n = 0; n < 2; ++n) cb[bj][n] = nb[bj][n];
            if (g < 7) { const int g2 = g + 1; const size_t off2 = (size_t)(row0 + (g2 >> 2) * 128 + (g2 & 3) * 16) * 1024 + col0;
#pragma unroll
                for (int bj = 0; bj < 2; ++bj)
#pragma unroll
                    for (int n = 0; n < 2; ++n) nb[bj][n] = *(const u32x2*)(xb + off2 + bj * 128 + n * 16); }
#pragma unroll
            for (int bj = 0; bj < 2; ++bj)
#pragma unroll
                for (int n = 0; n < 2; ++n) { const u32x2 c = cb[bj][n];
                    f32x4 o; o[0] = __uint_as_float(c.x << 16); o[1] = __uint_as_float(c.x & 0xffff0000u); o[2] = __uint_as_float(c.y << 16); o[3] = __uint_as_float(c.y & 0xffff0000u);
                    o = o + acc[ai][bj][m][n] * scale;
                    u32x2 w; w.x = cvt_pk_bf16(o[0], o[1]); w.y = cvt_pk_bf16(o[2], o[3]);
                    *(u32x2*)(xb + off + bj * 128 + n * 16) = w;
                    o[0] = __uint_as_float(w.x << 16); o[1] = __uint_as_float(w.x & 0xffff0000u); o[2] = __uint_as_float(w.y << 16); o[3] = __uint_as_float(w.y & 0xffff0000u);
                    if (out != nullptr) *(f32x4*)(out + off + bj * 128 + n * 16) = o;
                    if (x8 != nullptr) { int q8 = __builtin_amdgcn_cvt_pk_fp8_f32(o[0], o[1], 0, false); q8 = __builtin_amdgcn_cvt_pk_fp8_f32(o[2], o[3], q8, true); *(int*)(x8 + off + bj * 128 + n * 16) = q8; }
                    ss += (o[0] * o[0] + o[1] * o[1]) + (o[2] * o[2] + o[3] * o[3]); }
            ss = xsum16(ss); ss = xsum32(ss);
            if (fq == 0) rowss[(size_t)row * 16 + (u.pn * 4 + wc)] = ss; }
    }
};

struct EpiQKV {
    static constexpr int NST = 16;
    static constexpr bool PERM = true;
    bf16_t* P; int ldp; const float* rowss; const float* qk_gain  ; float* widx; float ascale  ;
    __device__ __forceinline__ void operator()(const f32x4 (&acc)[2][2][4][2], const Unit& u, int wr, int wc, int fr_, int fq_) const {
        int fr = fr_, fq = fq_; asm volatile("" : "+v"(fr), "+v"(fq));
        const int hidx = 4 * u.pn + wc;
        int gi = -1; float post = 1.0f;
        constexpr float C2 = 0.125f * 1.4426950408889634f;
        if (hidx < 12) { gi = 0; post = C2; } else if (hidx < 24) { gi = 1; } else if (hidx < 36) { }
        else if (hidx < 44) { gi = 2; post = C2; } else if (hidx < 52) { gi = 3; } else if (hidx < 60) { }
        else if (hidx < 64) { gi = 4; post = C2; } else if (hidx == 64) { gi = 5; } else if (hidx == 65) { }
        else if (hidx < 74) { post = 0.125f; }
        f32x4 gn[2][2];
#pragma unroll
        for (int bj = 0; bj < 2; ++bj)
#pragma unroll
            for (int n = 0; n < 2; ++n) gn[bj][n] = (gi >= 0) ? *(const f32x4*)(qk_gain + gi * 64 + 32 * bj + 8 * fq + 4 * n) : (f32x4){1.f, 1.f, 1.f, 1.f};
        const int row0 = u.pm * 256 + wr * 64 + fr, col0 = 64 * hidx + 8 * fq;
        float rs[2][4]; row_rs8(rowss, row0, fq, rs);
#pragma unroll
        for (int ai = 0; ai < 2; ++ai)
#pragma unroll
            for (int m = 0; m < 4; ++m) { const int row = row0 + ai * 128 + m * 16; const float r = rs[ai][m] * ascale;
                f32x4 v[2][2]; float ss = 0.f;
#pragma unroll
                for (int bj = 0; bj < 2; ++bj)
#pragma unroll
                    for (int n = 0; n < 2; ++n) { v[bj][n] = acc[ai][bj][m][n] * r; const f32x4 t = v[bj][n]; ss += (t[0] * t[0] + t[1] * t[1]) + (t[2] * t[2] + t[3] * t[3]); }
                float mul = post;
                if (gi >= 0) { ss = xsum16(ss); ss = xsum32(ss); mul = post * __builtin_amdgcn_rsqf(ss * (1.0f / 64.0f) + RMS_EPS); }
#pragma unroll
                for (int bj = 0; bj < 2; ++bj) { const f32x4 a = v[bj][0] * gn[bj][0] * mul, b = v[bj][1] * gn[bj][1] * mul;
                    u32x4 w; w.x = cvt_pk_bf16(a[0], a[1]); w.y = cvt_pk_bf16(a[2], a[3]); w.z = cvt_pk_bf16(b[0], b[1]); w.w = cvt_pk_bf16(b[2], b[3]);
                    *(u32x4*)(P + (size_t)row * ldp + col0 + 32 * bj) = w; }
                if (hidx == 75 && fq == 0) { *(f32x4*)(widx + (size_t)row * 8) = v[0][0]; *(f32x4*)(widx + (size_t)row * 8 + 4) = v[0][1]; } asm volatile("" ::: "memory"); }
    }
};

struct EpiSigmoid {
    static constexpr int NST = 16;
    static constexpr bool PERM = true;
    bf16_t* G; int ldg; const float* rowss; float post  ;
    __device__ __forceinline__ void operator()(const f32x4 (&acc)[2][2][4][2], const Unit& u, int wr, int wc, int fr_, int fq_) const {
        int fr = fr_, fq = fq_; asm volatile("" : "+v"(fr), "+v"(fq));
        const int row0 = u.pm * 256 + wr * 64 + fr, col0 = u.pn * 256 + wc * 32 + 8 * fq;
        float rs[2][4]; row_rs8(rowss, row0, fq, rs);
#pragma unroll
        for (int ai = 0; ai < 2; ++ai)
#pragma unroll
            for (int m = 0; m < 4; ++m) { const int row = row0 + ai * 128 + m * 16; const float r = rs[ai][m] * post;
#pragma unroll
                for (int bj = 0; bj < 2; ++bj) { float h[8];
#pragma unroll
                    for (int n = 0; n < 2; ++n)
#pragma unroll
                        for (int i = 0; i < 4; ++i) h[n * 4 + i] = sigmoidf_(acc[ai][bj][m][n][i] * r);
                    u32x4 w; w.x = cvt_pk_bf16(h[0], h[1]); w.y = cvt_pk_bf16(h[2], h[3]); w.z = cvt_pk_bf16(h[4], h[5]); w.w = cvt_pk_bf16(h[6], h[7]);
                    *(u32x4*)(G + (size_t)row * ldg + col0 + bj * 128) = w; } asm volatile("" ::: "memory"); }
    }
};

struct EpiMerge {
    static constexpr int NST = 16;
    static constexpr bool PERM = true;
    bf16_t* Y; const bf16_t* G  ; int ldg; int accum;
    __device__ __forceinline__ void operator()(const f32x4 (&acc)[2][2][4][2], const Unit& u, int wr, int wc, int fr, int fq) const {
        const int row0 = u.pm * 256 + wr * 64 + fr, col0 = u.pn * 256 + wc * 32 + 8 * fq;
        u32x4 ng[2], ny[2];
#pragma unroll
        for (int bj = 0; bj < 2; ++bj) { ng[bj] = *(const u32x4*)(G + (size_t)row0 * ldg + col0 + bj * 128); ny[bj] = (u32x4){0u, 0u, 0u, 0u}; if (accum) ny[bj] = *(const u32x4*)(Y + (size_t)row0 * 1024 + col0 + bj * 128); }
#pragma unroll
        for (int g = 0; g < 8; ++g) { const int ai = g >> 2, m = g & 3; const int row = row0 + ai * 128 + m * 16;
            u32x4 cg[2], cy[2];
#pragma unroll
            for (int bj = 0; bj < 2; ++bj) { cg[bj] = ng[bj]; cy[bj] = ny[bj]; }
            if (g < 7) { const int row2 = row0 + ((g + 1) >> 2) * 128 + ((g + 1) & 3) * 16;
#pragma unroll
                for (int bj = 0; bj < 2; ++bj) { ng[bj] = *(const u32x4*)(G + (size_t)row2 * ldg + col0 + bj * 128); if (accum) ny[bj] = *(const u32x4*)(Y + (size_t)row2 * 1024 + col0 + bj * 128); } }
#pragma unroll
            for (int bj = 0; bj < 2; ++bj) { const u32x4 gv = cg[bj], yo = cy[bj];
                bf16_t* yp = Y + (size_t)row * 1024 + col0 + bj * 128;
                const f32x4 a = acc[ai][bj][m][0], b = acc[ai][bj][m][1];
                float h[8];
                h[0] = bflo(yo.x) + bflo(gv.x) * a[0]; h[1] = bfhi(yo.x) + bfhi(gv.x) * a[1]; h[2] = bflo(yo.y) + bflo(gv.y) * a[2]; h[3] = bfhi(yo.y) + bfhi(gv.y) * a[3];
                h[4] = bflo(yo.z) + bflo(gv.z) * b[0]; h[5] = bfhi(yo.z) + bfhi(gv.z) * b[1]; h[6] = bflo(yo.w) + bflo(gv.w) * b[2]; h[7] = bfhi(yo.w) + bfhi(gv.w) * b[3];
                u32x4 w; w.x = cvt_pk_bf16(h[0], h[1]); w.y = cvt_pk_bf16(h[2], h[3]); w.z = cvt_pk_bf16(h[4], h[5]); w.w = cvt_pk_bf16(h[6], h[7]);
                *(u32x4*)yp = w; } }
    }
};
}
constexpr int NWAVES = 8;
constexpr int M = 16384, D = 1024, FF = 2816, T = 4096, NLAYER = 4;
constexpr int NIN = 7880, PP = 4864  , NGATE = 3072, GATE_COL0 = 4808;
constexpr float LOG2E = 1.4426950408889634f;
constexpr size_t MiB = 1u << 20;
constexpr size_t WS_CTL = 0, CTL_ZERO_BYTES = 1 * MiB;
constexpr size_t WS_BIASD = 1 * MiB;
constexpr size_t WS_ROWSS = 1 * MiB + 512 * 1024;
constexpr size_t WS_WIDX = 2 * MiB + 512 * 1024;
constexpr size_t WS_TAU = 3 * MiB;
constexpr size_t WS_W = 4 * MiB;
constexpr size_t O_GU1 = 0, O_DN1 = 11534336, O_QKV = 17301504, O_GATE = 27262976, O_BA = 33554432, O_BB = 34078720, O_BC = 35127296, O_OUT = 35651584, O_GU2 = 37748736, O_DN2 = 49283072, O_WEND = 55050240;
constexpr size_t WS_XB = 57 * MiB, WS_OATT = 89 * MiB, WS_Y = 121 * MiB, WS_PROJ = 153 * MiB, WS_HMID = WS_PROJ, WS_GATES = 305 * MiB, WS_OB = WS_Y  , WS_SCORES = 305 * MiB  , WS_OAP = 434 * MiB, WS_MASK = 461 * MiB  , WS_X8 = 469 * MiB  , WS_QKV8 = 485 * MiB  , WS_END = 490 * MiB;
static_assert(WS_W + O_WEND <= WS_XB && WS_PROJ + (size_t)M * PP * 2 <= WS_GATES && WS_GATES + (size_t)M * NGATE * 2 <= WS_END && WS_SCORES + 4 * (size_t)8454144 * 4 <= WS_OAP, "ws map");
constexpr int CW_TMO = 0, CW_CODE = 1, CW_BAR = 4096;

constexpr int RING_OFF = 0, RING_BYTES = 131072;
constexpr int MISC_OFF = 160768, LDS_BYTES = 161792;

#define GAS __attribute__((address_space(1)))
#define LAS __attribute__((address_space(3)))
typedef unsigned short bf16;
typedef unsigned v4u __attribute__((ext_vector_type(4)));
typedef unsigned v2u __attribute__((ext_vector_type(2)));
typedef float f32x4 __attribute__((ext_vector_type(4)));
typedef GAS unsigned gu32;
#define RLX_AGENT __ATOMIC_RELAXED, __HIP_MEMORY_SCOPE_AGENT
#define LDS_WAIT() asm volatile("s_waitcnt lgkmcnt(0)" ::: "memory")
#define VM_WAIT() asm volatile("s_waitcnt vmcnt(0)" ::: "memory")
__device__ __forceinline__ float bflo(unsigned u) { return __uint_as_float(u << 16); }
__device__ __forceinline__ float bfhi(unsigned u) { return __uint_as_float(u & 0xffff0000u); }
__device__ __forceinline__ unsigned f2bf(float f) { unsigned u = __builtin_bit_cast(unsigned, f); return (u + 0x7fffu + ((u >> 16) & 1u)) >> 16; }
__device__ __forceinline__ unsigned pk2(float lo, float hi) { return f2bf(lo) | (f2bf(hi) << 16); }
__device__ __forceinline__ float wave_sum(float v) {
#pragma unroll
    for (int o = 1; o < 64; o <<= 1) v += __shfl_xor(v, o);
    return v;
}
__device__ __forceinline__ float wave_max(float v) {
#pragma unroll
    for (int o = 1; o < 64; o <<= 1) v = fmaxf(v, __shfl_xor(v, o));
    return v;
}
__device__ __forceinline__ float dot8(v4u a, v4u b) {
    return ((bflo(a.x) * bflo(b.x) + bfhi(a.x) * bfhi(b.x)) + (bflo(a.y) * bflo(b.y) + bfhi(a.y) * bfhi(b.y))) + ((bflo(a.z) * bflo(b.z) + bfhi(a.z) * bfhi(b.z)) + (bflo(a.w) * bflo(b.w) + bfhi(a.w) * bfhi(b.w)));
}
__device__ __forceinline__ float dot64(const v4u (&q)[8], const bf16* kp) {
    const v4u* k = (const v4u*)kp; float s = 0.f;
#pragma unroll
    for (int i = 0; i < 8; ++i) s += dot8(q[i], k[i]);
    return s;
}
__device__ __forceinline__ int rel_bucket(int n) {
    if (n < 16) return n;
    int b = 16 + (int)(logf((float)n / 16.0f) / logf(128.0f) * 16.0f);
    return b < 31 ? b : 31;
}

struct Args { const float* in[19]; float* out; unsigned char* ws; int lo, hi, rem; };
struct Frame {
    LAS unsigned char* lds;
    volatile LAS unsigned* MISC;
    int tid, lane, wave, G, bx;
};

__device__ __forceinline__ void phase_prologue(Frame& F, const Args& A) {
    float* biasd = (float*)(A.ws + WS_BIASD); const float* rel_bias = A.in[1];
    const int plane = hw_lane(), ptid = F.wave * 64 + plane;
    for (int i = F.bx * 512 + ptid; i < 20 * 4096; i += F.G * 512) { const int h = i >> 12, d = i & 4095; biasd[i] = rel_bias[rel_bucket(d) * 20 + h] * LOG2E; }
    const float* x = A.in[0]; bf16* xb = (bf16*)(A.ws + WS_XB); float* rowss = (float*)(A.ws + WS_ROWSS);
    const int gw = F.bx * NWAVES + F.wave, NGW = F.G * NWAVES;
    for (int m = gw; m < M; m += NGW) {
        const f32x4* xr = (const f32x4*)(x + (size_t)m * D) + plane; float s = 0.f;
        unsigned long long* o8 = (unsigned long long*)(xb + (size_t)m * D) + plane;
#pragma unroll
        for (int j = 0; j < 4; ++j) { const f32x4 v = xr[64 * j]; s += (v.x * v.x + v.y * v.y) + (v.z * v.z + v.w * v.w);
            o8[64 * j] = (unsigned long long)pk2(v.x, v.y) | ((unsigned long long)pk2(v.z, v.w) << 32); }
        s = wave_sum(s);
        if (plane < 16) rowss[(size_t)m * 16 + plane] = (plane == 0) ? s : 0.f;
    }
}

typedef unsigned v2u_ __attribute__((ext_vector_type(2)));
__device__ __forceinline__ void cvt_item(const float* W, int ldw, int scol, bool valid, const float* gamma, bf16* WT, int K, int dstrow0, int k0, LAS unsigned char* scr, int lane, bool fp8 = false, float wscale = 1.0f) {
    const int n4 = lane & 31, kp = lane >> 5;
    const float* wp = W + (size_t)(k0 + 2 * kp) * ldw + scol;
    const float vs = valid ? wscale : 0.0f;
    LAS unsigned char* wa = scr + n4 * 528 + kp * 128;
#pragma unroll
    for (int hb = 0; hb < 2; ++hb) {
        f32x4 v0[8], v1[8]; float2 gm[8];
#pragma unroll
        for (int ii = 0; ii < 8; ++ii) { const int i = 8 * hb + ii; v0[ii] = *(const f32x4*)(wp + (size_t)(4 * i) * ldw); v1[ii] = *(const f32x4*)(wp + (size_t)(4 * i + 1) * ldw);
            gm[ii] = gamma ? *(const float2*)(gamma + k0 + 4 * i + 2 * kp) : make_float2(1.0f, 1.0f); }
#pragma unroll
        for (int ii = 0; ii < 8; ++ii) { const int i = 8 * hb + ii; const float g0 = gm[ii].x * vs, g1 = gm[ii].y * vs;
            v4u p; p.x = pk2(v0[ii].x * g0, v1[ii].x * g1); p.y = pk2(v0[ii].y * g0, v1[ii].y * g1); p.z = pk2(v0[ii].z * g0, v1[ii].z * g1); p.w = pk2(v0[ii].w * g0, v1[ii].w * g1);
            *(LAS v4u*)(wa + (i & 1) * 256 + (i >> 1) * 16) = p; }
    }
    LDS_WAIT(); asm volatile("" ::: "memory");
    const int c = lane & 7, m = lane >> 3;
    const LAS unsigned char* ra = scr + m * 528 + c * 16;
#pragma unroll
    for (int r = 0; r < 4; ++r) {
        const v4u r0 = *(const LAS v4u*)(ra + r * 4224), r1 = *(const LAS v4u*)(ra + r * 4224 + 128), r2 = *(const LAS v4u*)(ra + r * 4224 + 256), r3 = *(const LAS v4u*)(ra + r * 4224 + 384);
        if (!fp8) {
        bf16* op = WT + (size_t)(dstrow0 + 4 * (m + 8 * r)) * K + k0 + 8 * c;
        *(v4u*)(op) = (v4u){r0.x, r1.x, r2.x, r3.x}; *(v4u*)(op + K) = (v4u){r0.y, r1.y, r2.y, r3.y};
        *(v4u*)(op + 2 * (size_t)K) = (v4u){r0.z, r1.z, r2.z, r3.z}; *(v4u*)(op + 3 * (size_t)K) = (v4u){r0.w, r1.w, r2.w, r3.w}; }
        else {
            unsigned char* op = (unsigned char*)WT + (size_t)(dstrow0 + 4 * (m + 8 * r)) * K + k0 + 8 * c;
            auto q4 = [](unsigned a, unsigned b) { int q = __builtin_amdgcn_cvt_pk_fp8_f32(__uint_as_float(a << 16), __uint_as_float(a & 0xffff0000u), 0, false);
                                                  return (unsigned)__builtin_amdgcn_cvt_pk_fp8_f32(__uint_as_float(b << 16), __uint_as_float(b & 0xffff0000u), q, true); };
            *(v2u_*)(op) = (v2u_){q4(r0.x, r1.x), q4(r2.x, r3.x)}; *(v2u_*)(op + K) = (v2u_){q4(r0.y, r1.y), q4(r2.y, r3.y)};
            *(v2u_*)(op + 2 * (size_t)K) = (v2u_){q4(r0.z, r1.z), q4(r2.z, r3.z)}; *(v2u_*)(op + 3 * (size_t)K) = (v2u_){q4(r0.w, r1.w), q4(r2.w, r3.w)}; } }
    LDS_WAIT(); asm volatile("" ::: "memory");
}
constexpr int CV_SETA0 = 0, CV_SETA1 = 1056, CV_SETA2 = 1664, CV_SETA3 = 2304;
constexpr int CV_SETB0 = 1056, CV_SETB1 = 1664, CV_SETB2 = 2304, CV_SETB3 = 3360;
__device__ __forceinline__ void phase_convert(Frame& F, const Args& A, int L, int a0, int a1, int b0, int b1, int gw, int NGW) {
    const int lane = hw_lane();
    LAS unsigned char* scr = F.lds + RING_OFF + F.wave * 17408;
    unsigned char* wb = A.ws + WS_W;
    const int n4 = lane & 31;
    constexpr int I0 = 704, I1 = 352, I2 = 608, I3 = 384, I4 = 32, I5 = 64, I6 = 32, I7 = 128, I8 = 704, I9 = 352;
    constexpr int NITEMS = I0 + I1 + I2 + I3 + I4 + I5 + I6 + I7 + I8 + I9;
    const int na = a1 - a0, ntot = na + (b1 - b0);
    for (int ix = gw; ix < ntot; ix += NGW) {
        int r = ix < na ? a0 + ix : b0 + (ix - na);
        if (r < I0 || (r >= I0 + I1 + I2 + I3 + I4 + I5 + I6 + I7 && r < NITEMS - I9)) {
            const bool second = r >= I0; if (second) r -= (I0 + I1 + I2 + I3 + I4 + I5 + I6 + I7);
            const int kb = r / 44, nb = r % 44, n0 = 128 * nb, tile = n0 >> 8, l = n0 & 255;
            const float* Wg = (second ? A.in[16] : A.in[3]) + (size_t)L * D * FF; const float* Wu = (second ? A.in[17] : A.in[4]) + (size_t)L * D * FF;
            const float* gam = (second ? A.in[15] : A.in[2]) + (size_t)L * D;
            cvt_item(l < 128 ? Wg : Wu, FF, 128 * tile + 4 * n4, true, gam, (bf16*)(wb + (second ? O_GU2 : O_GU1)), D, n0, 64 * kb, scr, lane, second, second ? 32.0f : 1.0f);
            continue; }
        r -= I0;
        if (r < I1) { const int kb = r / 8, nb = r % 8; cvt_item(A.in[5] + (size_t)L * FF * D, D, 128 * nb + 4 * n4, true, nullptr, (bf16*)(wb + O_DN1), FF, 128 * nb, 64 * kb, scr, lane); continue; } r -= I1;
        if (r < I2) { const int kb = r / 38, nb = r % 38, n0 = 128 * nb, tile = n0 >> 8, bj = (n0 & 255) >> 7, scol = 256 * tile + 32 * bj + 64 * (n4 >> 3) + 4 * (n4 & 7);
            const bool f8 = ((QKV_F8MASK >> tile) & 1u) != 0u;
            cvt_item(A.in[7] + (size_t)L * D * NIN, NIN, scol, scol < 4808, A.in[6] + (size_t)L * D, f8 ? (bf16*)(A.ws + WS_QKV8) : (bf16*)(wb + O_QKV), D, n0, 64 * kb, scr, lane, f8, f8 ? 32.0f : 1.0f); continue; } r -= I2;
        if (r < I3) { const int kb = r / 24, nb = r % 24; cvt_item(A.in[7] + (size_t)L * D * NIN, NIN, GATE_COL0 + 128 * nb + 4 * n4, true, A.in[6] + (size_t)L * D, (bf16*)(wb + O_GATE), D, 128 * nb, 64 * kb, scr, lane, true, 32.0f); continue; } r -= I3;
        if (r < I4) { const int kb = r / 8, nb = r % 8; cvt_item(A.in[11] + (size_t)L * 256 * D, D, 128 * nb + 4 * n4, true, nullptr, (bf16*)(wb + O_BA), 256, 128 * nb, 64 * kb, scr, lane); continue; } r -= I4;
        if (r < I5) { const int kb = r / 8, nb = r % 8; cvt_item(A.in[12] + (size_t)L * 512 * D, D, 128 * nb + 4 * n4, true, nullptr, (bf16*)(wb + O_BB), 512, 128 * nb, 64 * kb, scr, lane); continue; } r -= I5;
        if (r < I6) { const int kb = r / 8, nb = r % 8; cvt_item(A.in[13] + (size_t)L * 256 * D, D, 128 * nb + 4 * n4, true, nullptr, (bf16*)(wb + O_BC), 256, 128 * nb, 64 * kb, scr, lane); continue; } r -= I6;
        if (r < I7) { const int kb = r / 8, nb = r % 8; cvt_item(A.in[14] + (size_t)L * D * D, D, 128 * nb + 4 * n4, true, nullptr, (bf16*)(wb + O_OUT), D, 128 * nb, 64 * kb, scr, lane); continue; } r -= I7;
        r -= I8;
        { const int kb = r / 8, nb = r % 8; cvt_item(A.in[18] + (size_t)L * FF * D, D, 128 * nb + 4 * n4, true, nullptr, (bf16*)(wb + O_DN2), FF, 128 * nb, 64 * kb, scr, lane); }
    }
}

constexpr int COL_AQ = 0, COL_AK = 768, COL_AV = 1536, COL_BQ = 2304, COL_BK = 2816, COL_BV = 3328, COL_CQ = 3840, COL_CK = 4096, COL_CV = 4160, COL_IQ = 4224, COL_IK = 4736;
__device__ __forceinline__ void load_q(v4u (&q)[8], const bf16* p) {
#pragma unroll
    for (int i = 0; i < 8; ++i) q[i] = ((const v4u*)p)[i];
}
#ifdef MK_DEBUG_KERNELS
__device__ __forceinline__ void oracle_A(unsigned char* ws, int gw, int NGW, int lane) {
    const bf16* P = (const bf16*)(ws + WS_PROJ); const float* biasd = (const float*)(ws + WS_BIASD); bf16* O = (bf16*)(ws + WS_OATT);
    for (int it = gw; it < M * 4; it += NGW) {
        const int row = it >> 2, hs = it & 3, b = row >> 12, t = row & 4095;
        float mrun = -INFINITY, l = 0.f, o = 0.f;
        for (int g = 0; g < 3; ++g) {
            const int dil = (g == 0) ? 1 : (g == 1 ? 4 : 16), head = 4 * g + hs, i = t / dil, r = t % dil;
            v4u q[8]; load_q(q, P + (size_t)row * PP + COL_AQ + head * 64);
            const int jlo = (i - 128) < 0 ? 0 : (i - 128), nk = i - jlo + 1;
            for (int c0 = 0; c0 < nk; c0 += 64) {
                const int jj = c0 + lane; const bool valid = jj < nk; const int j = jlo + (valid ? jj : 0);
                const size_t krow = (size_t)b * T + (size_t)j * dil + r;
                float s = -INFINITY;
                if (valid) s = dot64(q, P + krow * PP + COL_AK + head * 64) + biasd[head * 4096 + (i - j) * dil];
                const float mnew = fmaxf(mrun, wave_max(s)); const float alpha = __builtin_amdgcn_exp2f(mrun - mnew);
                const float p = valid ? __builtin_amdgcn_exp2f(s - mnew) : 0.f;
                l = l * alpha + wave_sum(p); o *= alpha; mrun = mnew;
                const int kn = (nk - c0) < 64 ? (nk - c0) : 64;
                for (int kk = 0; kk < kn; ++kk) { const float pk = __shfl(p, kk); const size_t vrow = (size_t)b * T + (size_t)(jlo + c0 + kk) * dil + r;
                    o += pk * bflo((unsigned)P[vrow * PP + COL_AV + head * 64 + lane]); }
            }
        }
        O[(size_t)row * 1024 + hs * 64 + lane] = (bf16)f2bf(o / l);
    }
}
__device__ __forceinline__ void oracle_B_map(const bf16* P, const float* biasd, int row, int h, int mp, int lane, float& r0, float& r1) {
    const int b = row >> 12, t = row & 4095;
    v4u q[8]; load_q(q, P + (size_t)row * PP + COL_BQ + (mp * 4 + h) * 64);
    float mrun = -INFINITY, l = 0.f, o0 = 0.f, o1 = 0.f;
    for (int c0 = 0; c0 <= t; c0 += 64) {
        const int j = c0 + lane; const bool valid = j <= t; const size_t krow = (size_t)b * T + (valid ? j : 0);
        float s = -INFINITY;
        if (valid) s = dot64(q, P + krow * PP + COL_BK + (mp * 4 + h) * 64) + biasd[(12 + h) * 4096 + (t - j)];
        const float mnew = fmaxf(mrun, wave_max(s)); const float alpha = __builtin_amdgcn_exp2f(mrun - mnew);
        const float p = valid ? __builtin_amdgcn_exp2f(s - mnew) : 0.f;
        l = l * alpha + wave_sum(p); o0 *= alpha; o1 *= alpha; mrun = mnew;
        const int kn = (t + 1 - c0) < 64 ? (t + 1 - c0) : 64;
        for (int kk = 0; kk < kn; ++kk) { const float pk = __shfl(p, kk); const bf16* vp = P + ((size_t)b * T + c0 + kk) * PP + COL_BV + h * 128;
            o0 += pk * bflo((unsigned)vp[lane]); o1 += pk * bflo((unsigned)vp[64 + lane]); }
    }
    r0 = o0 / l; r1 = o1 / l;
}
__device__ __forceinline__ void oracle_B(unsigned char* ws, int gw, int NGW, const float* lv, const float* dn, int L, int lane) {
    const bf16* P = (const bf16*)(ws + WS_PROJ); const float* biasd = (const float*)(ws + WS_BIASD); bf16* O = (bf16*)(ws + WS_OATT);
    const float lam_init = 0.8f - 0.6f * expf(-0.3f * (float)L);
    const float lam = expf(wave_sum(lv[lane] * lv[64 + lane])) - expf(wave_sum(lv[128 + lane] * lv[192 + lane])) + lam_init;
    for (int it = gw; it < M * 4; it += NGW) {
        const int row = it >> 2, h = it & 3;
        float a0, a1, b0, b1;
        oracle_B_map(P, biasd, row, h, 0, lane, a0, a1);
        oracle_B_map(P, biasd, row, h, 1, lane, b0, b1);
        const float d0 = a0 - lam * b0, d1 = a1 - lam * b1;
        const float inv = __builtin_amdgcn_rsqf(wave_sum(d0 * d0 + d1 * d1) * (1.0f / 128.0f) + 1e-6f) * (1.0f - lam_init);
        O[(size_t)row * 1024 + 256 + h * 128 + lane] = (bf16)f2bf(d0 * inv * dn[lane]);
        O[(size_t)row * 1024 + 256 + h * 128 + 64 + lane] = (bf16)f2bf(d1 * inv * dn[64 + lane]);
    }
}
__device__ __forceinline__ void oracle_C(unsigned char* ws, int gw, int NGW, LAS unsigned char* ldsw, int lane) {
    const bf16* P = (const bf16*)(ws + WS_PROJ); const float* biasd = (const float*)(ws + WS_BIASD); bf16* O = (bf16*)(ws + WS_OATT);
    const float* widx = (const float*)(ws + WS_WIDX);
    LAS float* sc = (LAS float*)(ldsw);
    LAS unsigned short* sel = (LAS unsigned short*)(ldsw + 16384);
    LAS float* qi = (LAS float*)(ldsw + 16384 + 512);
    for (int row = gw; row < M; row += NGW) {
        const int b = row >> 12, t = row & 4095, N = t + 1;
#pragma unroll
        for (int i = 0; i < 8; ++i) qi[i * 64 + lane] = bflo((unsigned)P[(size_t)row * PP + COL_IQ + i * 64 + lane]);
        float w[8];
#pragma unroll
        for (int h = 0; h < 8; ++h) w[h] = widx[(size_t)row * 8 + h] * 0.35355339059327373f;
        LDS_WAIT();
#pragma unroll 1
        for (int c0 = 0; c0 < N; c0 += 64) {
            const int j = c0 + lane; const bool valid = j < N;
            const v4u* kp = (const v4u*)(P + ((size_t)b * T + (valid ? j : 0)) * PP + COL_IK);
            float dsum[8];
#pragma unroll
            for (int h = 0; h < 8; ++h) dsum[h] = 0.f;
#pragma unroll 2
            for (int i = 0; i < 8; ++i) { const v4u kv = kp[i];
                const float k0 = bflo(kv.x), k1 = bfhi(kv.x), k2 = bflo(kv.y), k3 = bfhi(kv.y), k4 = bflo(kv.z), k5 = bfhi(kv.z), k6 = bflo(kv.w), k7 = bfhi(kv.w);
#pragma unroll
                for (int h = 0; h < 8; ++h) { const f32x4 qa = *(const LAS f32x4*)(qi + h * 64 + i * 8), qb = *(const LAS f32x4*)(qi + h * 64 + i * 8 + 4);
                    dsum[h] += ((qa.x * k0 + qa.y * k1) + (qa.z * k2 + qa.w * k3)) + ((qb.x * k4 + qb.y * k5) + (qb.z * k6 + qb.w * k7)); } }
            float score = 0.f;
#pragma unroll
            for (int h = 0; h < 8; ++h) score += w[h] * fmaxf(dsum[h], 0.f);
            if (j < 4096) sc[j] = valid ? score : -INFINITY;
        }
        LDS_WAIT();
        int cnt = 0;
        if (N <= 256) { for (int n = lane; n < N; n += 64) sel[n] = (unsigned short)n; cnt = N; }
        else {
            const int N4 = (N + 3) & ~3;
#pragma unroll 1
            for (int c0 = 0; c0 < N; c0 += 64) {
                const int j = c0 + lane; const bool valid = j < N; const float sj = valid ? sc[j] : INFINITY;
                int rank = 0;
                for (int jp = 0; jp < N4; jp += 4) { const f32x4 v = *(const LAS f32x4*)(sc + jp);
                    rank += (v.x > sj || (v.x == sj && jp < j)) ? 1 : 0; rank += (v.y > sj || (v.y == sj && jp + 1 < j)) ? 1 : 0;
                    rank += (v.z > sj || (v.z == sj && jp + 2 < j)) ? 1 : 0; rank += (v.w > sj || (v.w == sj && jp + 3 < j)) ? 1 : 0; }
                const bool s = valid && rank < 256;
                const unsigned long long bal = __ballot(s);
                const int pos = cnt + __popcll(bal & ((1ull << lane) - 1ull));
                if (s && pos < 256) sel[pos] = (unsigned short)j;
                cnt += __popcll(bal);
            }
            cnt = cnt > 256 ? 256 : cnt;
        }
        LDS_WAIT();
#pragma unroll 1
        for (int h = 0; h < 4; ++h) {
            v4u q[8]; load_q(q, P + (size_t)row * PP + COL_CQ + h * 64);
            float s[4]; float mx = -INFINITY;
#pragma unroll
            for (int c = 0; c < 4; ++c) { const int n = lane + 64 * c; const bool valid = n < cnt; const int key = valid ? (int)sel[n] : 0;
                s[c] = valid ? dot64(q, P + ((size_t)b * T + key) * PP + COL_CK) + biasd[(16 + h) * 4096 + (t - key)] : -INFINITY; mx = fmaxf(mx, s[c]); }
            mx = wave_max(mx);
            float p[4], ls = 0.f;
#pragma unroll
            for (int c = 0; c < 4; ++c) { p[c] = (lane + 64 * c < cnt) ? __builtin_amdgcn_exp2f(s[c] - mx) : 0.f; ls += p[c]; }
            ls = wave_sum(ls);
            float o = 0.f;
#pragma unroll
            for (int c = 0; c < 4; ++c) { const int kn = (cnt - 64 * c) < 64 ? (cnt - 64 * c) : 64;
                for (int kk = 0; kk < kn; ++kk) { const float pk = __shfl(p[c], kk); const int key = (int)sel[64 * c + kk];
                    o += pk * bflo((unsigned)P[((size_t)b * T + key) * PP + COL_CV + lane]); } }
            O[(size_t)row * 1024 + 768 + h * 64 + lane] = (bf16)f2bf(o / ls);
        }
        LDS_WAIT();
    }
}

#endif
namespace fa {
typedef short bf16x8 __attribute__((ext_vector_type(8)));
typedef short v4i16_t __attribute__((ext_vector_type(4)));
typedef float f32x16 __attribute__((ext_vector_type(16)));
typedef unsigned u32x4 __attribute__((ext_vector_type(4)));
constexpr int KPITCH = 144;
constexpr int KSTAGE = 64 * KPITCH;
template <int NDB> struct Geo { static constexpr int VPITCH = (NDB == 4) ? 320 : 192, VSTAGE = 64 * VPITCH, OFF_K = 0, OFF_V = 2 * KSTAGE, OFF_BIAS = OFF_V + 2 * VSTAGE, LDS_END = OFF_BIAS + 16384; };
__device__ __forceinline__ float fma_s(float a, float b, float c) { float d; asm("v_fma_f32 %0, %1, %2, %3" : "=v"(d) : "v"(a), "v"(b), "v"(c)); return d; }
__device__ __forceinline__ float add_s(float a, float b) { float d; asm("v_add_f32 %0, %1, %2" : "=v"(d) : "v"(a), "v"(b)); return d; }
__device__ __forceinline__ int crow(int r, int hi) { return (r & 3) + 8 * (r >> 2) + 4 * hi; }
__device__ __forceinline__ float bcast_row(float v, int r, int hi) { const int u = __builtin_bit_cast(int, v); const int a0 = __builtin_amdgcn_readlane(u, crow(r, 0)), a1 = __builtin_amdgcn_readlane(u, crow(r, 1)); return __builtin_bit_cast(float, hi ? a1 : a0); }

struct Unit {
    const bf16* P;
    int colQ, colK, colV;
    long rowbase;
    int stride, rofs;
    int qi0;
    int kt0, kt1;
    const float* biasd;
    const float* scores;
    const unsigned long long* mask;
    const float2* tau;
};

template <int NDB, int MODE>
__device__ __forceinline__ void run(LAS unsigned char* lds, const Unit& U, int tid, f32x16 (&o)[NDB], float& mrun_out, float& lsum_out) {
    typedef Geo<NDB> G;
    const int lane = tid & 63, wid = __builtin_amdgcn_readfirstlane(tid >> 6), q32 = lane & 31, hi = lane >> 5;
    { LAS float* bl = (LAS float*)(lds + G::OFF_BIAS);
#pragma unroll
      for (int i = 0; i < 2; ++i) { const f32x4 v = *(const f32x4*)(U.biasd + (tid + 512 * i) * 4); *(LAS f32x4*)(bl + (tid + 512 * i) * 4) = v; } }
    const int qi = U.qi0 + 32 * wid + q32;
    bf16x8 qr[4];
    { const bf16* qp = U.P + (size_t)(U.rowbase + (long)qi * U.stride + U.rofs) * PP + U.colQ + 8 * hi;
#pragma unroll
      for (int d0 = 0; d0 < 4; ++d0) qr[d0] = *(const bf16x8*)(qp + 16 * d0); }
#pragma unroll
    for (int db = 0; db < NDB; ++db)
#pragma unroll
        for (int r = 0; r < 16; ++r) o[db][r] = 0.f;
    float mrun = -1.0e30f, lsum = 0.f;
    float tauf = 0.f; int icut = 0; const float* srow = nullptr;
    if (MODE == 2) { const float2 tq = U.tau[qi]; tauf = tq.x; icut = __float_as_int(tq.y); const size_t bi = (size_t)(qi >> 5); srow = U.scores + 512 * bi * (bi + 1) + (size_t)(qi & 31) * 32 * (bi + 1); }
    const int krow = tid >> 3, kch = tid & 7;
    u32x4 kst; u32x4 vst[NDB / 2];
    auto load_tile = [&](int kt) {
        { const long pos = (long)(64 * kt + krow) * U.stride + U.rofs; kst = *(const u32x4*)(U.P + (size_t)(U.rowbase + pos) * PP + U.colK + 8 * kch); }
#pragma unroll
        for (int i = 0; i < NDB / 2; ++i) { const int idx = tid + 512 * i, vr = idx / (NDB * 4), vc = idx % (NDB * 4);
            const long pos = (long)(64 * kt + vr) * U.stride + U.rofs; vst[i] = *(const u32x4*)(U.P + (size_t)(U.rowbase + pos) * PP + U.colV + 8 * vc); }
    };
    auto store_tile = [&](int buf) {
        *(LAS u32x4*)(lds + G::OFF_K + buf * KSTAGE + krow * KPITCH + kch * 16) = kst;
#pragma unroll
        for (int i = 0; i < NDB / 2; ++i) { const int idx = tid + 512 * i, vr = idx / (NDB * 4), vc = idx % (NDB * 4);
            *(LAS u32x4*)(lds + G::OFF_V + buf * G::VSTAGE + vr * G::VPITCH + vc * 16) = vst[i]; }
    };
    load_tile(U.kt0); store_tile(0);
    __syncthreads();
    const LAS float* bl = (const LAS float*)(lds + G::OFF_BIAS);
    const int qlo = U.qi0 + 32 * wid, qhi = qlo + 31;
    for (int kt = U.kt0; kt < U.kt1; ++kt) {
        const int buf = (kt - U.kt0) & 1;
        if (kt + 1 < U.kt1) load_tile(kt + 1);
        const int k0 = 64 * kt;
        bool need = (k0 <= qhi);
        if (MODE == 1) need = need && (k0 + 63 >= qlo - 128);
        if (need) {
            f32x16 p0, p1;
#pragma unroll
            for (int r = 0; r < 16; ++r) { p0[r] = 0.f; p1[r] = 0.f; }
            const LAS unsigned char* kb = lds + G::OFF_K + buf * KSTAGE + q32 * KPITCH + hi * 16;
#pragma unroll
            for (int d0 = 0; d0 < 4; ++d0) {
                const bf16x8 ka = *(const LAS bf16x8*)(kb + d0 * 32), kc = *(const LAS bf16x8*)(kb + 32 * KPITCH + d0 * 32);
                p0 = __builtin_amdgcn_mfma_f32_32x32x16_bf16(ka, qr[d0], p0, 0, 0, 0);
                p1 = __builtin_amdgcn_mfma_f32_32x32x16_bf16(kc, qr[d0], p1, 0, 0, 0);
                if (d0 & 1) asm volatile("" ::: "memory");
            }
            const bool edge = (MODE == 2) || (k0 + 63 > qlo) || (MODE == 1 && k0 < qhi - 128 + 0);
            float mx = -INFINITY;
            f32x4 sc0[4], sc1[4];
            if (MODE == 2) {
#pragma unroll
                for (int rg = 0; rg < 4; ++rg) { sc0[rg] = *(const f32x4*)(srow + k0 + 8 * rg + 4 * hi); sc1[rg] = *(const f32x4*)(srow + k0 + 32 + 8 * rg + 4 * hi); } }
#pragma unroll
            for (int r = 0; r < 16; ++r) {
                const int j0 = k0 + crow(r, hi), j1 = j0 + 32; const int d0_ = qi - j0, d1_ = qi - j1;
                float b0 = bl[(d0_ < 0 ? 0 : d0_) * U.stride], b1 = bl[(d1_ < 0 ? 0 : d1_) * U.stride];
                float s0 = p0[r] + b0, s1 = p1[r] + b1;
                if (edge) { bool v0 = d0_ >= 0, v1 = d1_ >= 0; if (MODE == 1) { v0 = v0 && d0_ <= 128; v1 = v1 && d1_ <= 128; }
                    if (MODE == 2) { const float a0 = sc0[r >> 2][r & 3] + 0.0f, a1 = sc1[r >> 2][r & 3] + 0.0f;
                        v0 = v0 && (a0 > tauf || (a0 == tauf && j0 <= icut)); v1 = v1 && (a1 > tauf || (a1 == tauf && j1 <= icut)); }
                    s0 = v0 ? s0 : -INFINITY; s1 = v1 ? s1 : -INFINITY; }
                p0[r] = s0; p1[r] = s1; mx = fmaxf(mx, fmaxf(s0, s1));
                if ((r & 3) == 3) asm volatile("" ::: "memory");
            }
            mx = fmaxf(mx, __shfl_xor(mx, 32));
            const float mnew = fmaxf(mrun, mx);
            if (__any(mnew > mrun)) {
                const float alpha = __builtin_amdgcn_exp2f(mrun - mnew);
                lsum *= alpha;
#pragma unroll
                for (int r = 0; r < 16; ++r) { const float ar = __shfl(alpha, crow(r, hi));
#pragma unroll
                    for (int db = 0; db < NDB; ++db) o[db][r] *= ar; }
                mrun = mnew;
            }
            float ps = 0.f;
#pragma unroll
            for (int r = 0; r < 16; ++r) { p0[r] = __builtin_amdgcn_exp2f(p0[r] - mrun); p1[r] = __builtin_amdgcn_exp2f(p1[r] - mrun); ps += p0[r] + p1[r]; }
            lsum += ps;
            const LAS unsigned char* vb = lds + G::OFF_V + buf * G::VSTAGE + (4 * hi + ((lane & 15) >> 2)) * G::VPITCH + (16 * ((lane >> 4) & 1) + 4 * (lane & 3)) * 2;
#pragma unroll
            for (int s = 0; s < 4; ++s) {
                u32x4 pw;
                if (s < 2) { pw.x = pg8::cvt_pk_bf16(p0[8 * s + 0], p0[8 * s + 1]); pw.y = pg8::cvt_pk_bf16(p0[8 * s + 2], p0[8 * s + 3]); pw.z = pg8::cvt_pk_bf16(p0[8 * s + 4], p0[8 * s + 5]); pw.w = pg8::cvt_pk_bf16(p0[8 * s + 6], p0[8 * s + 7]); }
                else { const int s2 = s - 2; pw.x = pg8::cvt_pk_bf16(p1[8 * s2 + 0], p1[8 * s2 + 1]); pw.y = pg8::cvt_pk_bf16(p1[8 * s2 + 2], p1[8 * s2 + 3]); pw.z = pg8::cvt_pk_bf16(p1[8 * s2 + 4], p1[8 * s2 + 5]); pw.w = pg8::cvt_pk_bf16(p1[8 * s2 + 6], p1[8 * s2 + 7]); }
                const bf16x8 pa = __builtin_bit_cast(bf16x8, pw);
                const LAS unsigned char* vs = vb + (32 * (s >> 1) + 16 * (s & 1)) * G::VPITCH;
#pragma unroll
                for (int db = 0; db < NDB; ++db) {
                    const v4i16_t lo = __builtin_amdgcn_ds_read_tr16_b64_v4i16((LAS v4i16_t*)(vs + db * 64));
                    const v4i16_t hv = __builtin_amdgcn_ds_read_tr16_b64_v4i16((LAS v4i16_t*)(vs + 8 * G::VPITCH + db * 64));
                    const bf16x8 vf = (bf16x8){lo[0], lo[1], lo[2], lo[3], hv[0], hv[1], hv[2], hv[3]};
                    o[db] = __builtin_amdgcn_mfma_f32_32x32x16_bf16(pa, vf, o[db], 0, 0, 0);
                }
                asm volatile("" ::: "memory");
            }
        }
        if (kt + 1 < U.kt1) store_tile(buf ^ 1);
        __syncthreads();
    }
    lsum += __shfl_xor(lsum, 32);
    mrun_out = mrun; lsum_out = lsum;
}

__device__ __forceinline__ float msel(unsigned nx, int c, float s) { const unsigned t = (unsigned)(((int)(nx << (31 - c))) >> 31); return __uint_as_float((t & 0xff800000u) | (~t & __float_as_uint(s))); }
template <int NDB> struct Geo2 { static constexpr int KB = 8192, VB = NDB * 4096, STAGE = KB + VB, OFF_BIAS = 3 * STAGE, BIAS_PAD = 128  , OFF_Q = OFF_BIAS + 16384 + 4 * BIAS_PAD  , LDS_END = OFF_Q + 32768, NPT = 1 + NDB / 2  ; };
template <int NDB, int MODE>
__device__ __forceinline__ void run2(LAS unsigned char* lds, const Unit& U, int tid, f32x16 (&o)[NDB], float& mrun_out, float& lsum_out) {
    typedef Geo2<NDB> G;
    constexpr bool QLDS = false;
    const int lane = tid & 63, wid = __builtin_amdgcn_readfirstlane(tid >> 6), q32 = lane & 31, hi = lane >> 5;
    const int qi = U.qi0 + 32 * wid + q32;
    const int krw = 8 * wid + (lane >> 3);
    const bf16* gbase = U.P + (size_t)U.rowbase * PP;
    const unsigned ksrc = (unsigned)((krw * U.stride + U.rofs) * PP + U.colK + 8 * ((lane & 7) ^ (krw & 7)));
    unsigned vsrc0, vsrc1 = 0u;
    if (NDB == 2) { vsrc0 = (unsigned)((krw * U.stride + U.rofs) * PP + U.colV + 8 * ((lane & 7) ^ (4 * ((krw >> 1) & 1)))); }
    else { const int r0 = 4 * wid + (lane >> 4), r1 = r0 + 32;
        vsrc0 = (unsigned)((r0 * U.stride + U.rofs) * PP + U.colV + 8 * ((lane & 15) ^ (4 * (r0 & 3))));
        vsrc1 = (unsigned)((r1 * U.stride + U.rofs) * PP + U.colV + 8 * ((lane & 15) ^ (4 * (r1 & 3)))); }
    const unsigned tstep = (unsigned)(64 * U.stride * PP);
    auto dma_tile = [&](int kt, int stg) {
        LAS unsigned char* sb = lds + stg * G::STAGE;
        const bf16* tb = gbase + (size_t)kt * tstep;
        __builtin_amdgcn_global_load_lds((const unsigned*)(tb + ksrc), (LAS unsigned*)(sb + wid * 1024), 16, 0, 0);
        __builtin_amdgcn_global_load_lds((const unsigned*)(tb + vsrc0), (LAS unsigned*)(sb + G::KB + wid * 1024), 16, 0, 0);
        if (NDB == 4) __builtin_amdgcn_global_load_lds((const unsigned*)(tb + vsrc1), (LAS unsigned*)(sb + G::KB + (wid + 8) * 1024), 16, 0, 0);
    };
    f32x4 bt[2]; float bw = -INFINITY;
    if (MODE == 1) { const int dsub = tid - G::BIAS_PAD; if (dsub >= 0 && dsub <= 128) bw = U.biasd[dsub * U.stride]; }
    else {
#pragma unroll
        for (int i = 0; i < 2; ++i) bt[i] = *(const f32x4*)(U.biasd + (tid + 512 * i) * 4); }
    bf16x8 qr[4];
    { const bf16* qp = U.P + (size_t)(U.rowbase + (long)qi * U.stride + U.rofs) * PP + U.colQ + 8 * hi;
#pragma unroll
      for (int d0 = 0; d0 < 4; ++d0) qr[d0] = *(const bf16x8*)(qp + 16 * d0); }
    const unsigned long long* mrow = nullptr;
    if (MODE == 2) mrow = U.mask + (size_t)qi * 64;
    if (QLDS) {
#pragma unroll
        for (int d0 = 0; d0 < 4; ++d0) *(LAS bf16x8*)(lds + G::OFF_Q + wid * 4096 + d0 * 1024 + lane * 16) = qr[d0]; }
    dma_tile(U.kt0, 0);
    const bool two = U.kt0 + 1 < U.kt1;
    if (two) dma_tile(U.kt0 + 1, 1);
    { LAS float* blw = (LAS float*)(lds + G::OFF_BIAS) + G::BIAS_PAD;
      if (MODE == 1) blw[tid - G::BIAS_PAD] = bw;
      else {
#pragma unroll
        for (int i = 0; i < 2; ++i) *(LAS f32x4*)(blw + (tid + 512 * i) * 4) = bt[i];
        if (tid < G::BIAS_PAD / 4) *(LAS f32x4*)(blw - G::BIAS_PAD + 4 * tid) = (f32x4){-INFINITY, -INFINITY, -INFINITY, -INFINITY}; } }
#pragma unroll
    for (int db = 0; db < NDB; ++db)
#pragma unroll
        for (int r = 0; r < 16; ++r) o[db][r] = 0.f;
    constexpr bool SEED = true;
    constexpr bool FIXREF = true;
    float mrun = SEED ? 0.f : -1.0e30f, lsum = 0.f;
    f32x16 negm;
#pragma unroll
    for (int r = 0; r < 16; ++r) negm[r] = 0.f;
    if (two) { if (G::NPT == 2) asm volatile("s_waitcnt vmcnt(2) lgkmcnt(0)" ::: "memory"); else asm volatile("s_waitcnt vmcnt(3) lgkmcnt(0)" ::: "memory"); }
    else asm volatile("s_waitcnt vmcnt(0) lgkmcnt(0)" ::: "memory");
    __builtin_amdgcn_s_barrier(); asm volatile("" ::: "memory");
    const LAS float* bl = (const LAS float*)(lds + G::OFF_BIAS) + G::BIAS_PAD;
    const int qlo = U.qi0 + 32 * wid, qhi = qlo + 31;
    int koff[4];
#pragma unroll
    for (int d0 = 0; d0 < 4; ++d0) koff[d0] = q32 * 128 + (((2 * d0 + hi) ^ (q32 & 7)) * 16);
    const int qp_ = (lane & 15) >> 2, xin = 2 * ((lane >> 4) & 1) + ((lane & 3) >> 1), win = 8 * (lane & 1);
    int voff[NDB];
#pragma unroll
    for (int db = 0; db < NDB; ++db) {
        if (NDB == 2) voff[db] = (4 * hi + qp_) * 128 + ((4 * (db ^ ((qp_ >> 1) & 1)) + xin) * 16) + win;
        else voff[db] = (4 * hi + qp_) * 256 + ((4 * (db ^ qp_) + xin) * 16) + win;
    }
    constexpr int VROW = NDB * 64;
    int stg = 0;
    u32x4 nmw0, nmw1;
    if (MODE == 2) { const u32x4* mp = (const u32x4*)(mrow + 4 * (U.kt0 >> 2)); nmw0 = mp[0]; nmw1 = mp[1]; }
    for (int kt = U.kt0; kt < U.kt1; ++kt) {
        const bool more = kt + 2 < U.kt1;
        if (more) dma_tile(kt + 2, (stg + 2) % 3);
        const int k0 = 64 * kt;
        bool need = (k0 <= qhi);
        if (MODE == 1) need = need && (k0 + 63 >= qlo - 128);
        u32x4 mw0, mw1;
        if (MODE == 2) { mw0 = nmw0; mw1 = nmw1;
            if (kt + 1 < U.kt1) { const u32x4* mp = (const u32x4*)(mrow + 4 * ((kt + 1) >> 2)); nmw0 = mp[0]; nmw1 = mp[1]; } }
        if (need) {
            const LAS unsigned char* sb = lds + stg * G::STAGE;
            f32x16 p0, p1;
#pragma unroll
            for (int d0 = 0; d0 < 4; ++d0) {
                const bf16x8 ka = *(const LAS bf16x8*)(sb + koff[d0]), kc = *(const LAS bf16x8*)(sb + koff[d0] + 4096);
                const bf16x8 qd = QLDS ? *(const LAS bf16x8*)(lds + G::OFF_Q + wid * 4096 + d0 * 1024 + lane * 16) : qr[d0];
                p0 = __builtin_amdgcn_mfma_f32_32x32x16_bf16(ka, qd, d0 == 0 ? negm : p0, 0, 0, 0);
                p1 = __builtin_amdgcn_mfma_f32_32x32x16_bf16(kc, qd, d0 == 0 ? negm : p1, 0, 0, 0);
            }
            const bool edge = (MODE == 2) || (k0 + 63 > qlo) || (MODE == 1 && k0 < qhi - 128);
            const bool farc = (MODE != 1) && (qlo - (k0 + 63) >= 2048);
            unsigned nx[4] = {0u, 0u, 0u, 0u};
            if (MODE == 2) { const int f = kt & 3; const int sh = 16 * (f & 1) + hi;
                const unsigned w0 = (f & 2) ? mw0.y : mw0.x, w1 = (f & 2) ? mw0.w : mw0.z, w2 = (f & 2) ? mw1.y : mw1.x, w3 = (f & 2) ? mw1.w : mw1.z;
                nx[0] = ~(w0 >> sh); nx[1] = ~(w1 >> sh); nx[2] = ~(w2 >> sh); nx[3] = ~(w3 >> sh); }
            float mx = -INFINITY;
            if (farc) { const float bc = bl[2048];
#pragma unroll
                for (int r = 0; r < 16; ++r) { float s0 = p0[r] + bc; asm("" : "+v"(s0)); float s1 = p1[r] + bc; asm("" : "+v"(s1));
                    if (MODE == 2) { s0 = msel(nx[r & 3], 2 * (r >> 2), s0); s1 = msel(nx[r & 3], 2 * (r >> 2) + 8, s1); }
                    p0[r] = s0; p1[r] = s1; mx = fmaxf(fmaxf(mx, s0), s1); } }
            else {
                const int dbase = qi - k0 - 4 * hi;
                const LAS float* bb = bl + (dbase - 59);
                asm volatile("" : "+v"(bb));
#pragma unroll
                for (int r = 0; r < 16; ++r) {
                    const int cr = (r & 3) + 8 * (r >> 2); const int d0_ = dbase - cr, d1_ = d0_ - 32;
                    float s0 = p0[r] + bb[59 - cr]; asm("" : "+v"(s0));
                    float s1 = p1[r] + bb[27 - cr]; asm("" : "+v"(s1));
                    if (MODE == 2) { s0 = msel(nx[r & 3], 2 * (r >> 2), s0); s1 = msel(nx[r & 3], 2 * (r >> 2) + 8, s1); }
                    p0[r] = s0; p1[r] = s1; mx = fmaxf(fmaxf(mx, s0), s1);
                    if (NDB == 4 && (r & 3) == 3) asm volatile("" ::: "memory");
                }
            }
            if (!FIXREF) mx = fmaxf(mx, __shfl_xor(mx, 32));
            if (!FIXREF && __any(SEED ? (mx > 8.0f) : (mx > mrun + 8.0f))) {
                const float mrel = SEED ? fmaxf(mx, 0.f) : fmaxf(mx - mrun, 0.f);
                const float alpha = __builtin_amdgcn_exp2f(-mrel);
                lsum *= alpha;
#pragma unroll
                for (int r = 0; r < 16; ++r) { const float ar = __shfl(alpha, crow(r, hi));
#pragma unroll
                    for (int db = 0; db < NDB; ++db) o[db][r] *= ar; }
                mrun = SEED ? mrun + mrel : fmaxf(mrun, mx);
                if (SEED) {
#pragma unroll
                    for (int r = 0; r < 16; ++r) { p0[r] -= mrel; p1[r] -= mrel; negm[r] -= mrel; } }
            }
            float ps = 0.f;
            const float msub = SEED ? 0.f : mrun;
#pragma unroll
            for (int r = 0; r < 16; ++r) { p0[r] = __builtin_amdgcn_exp2f(p0[r] - msub); p1[r] = __builtin_amdgcn_exp2f(p1[r] - msub); ps += p0[r] + p1[r]; }
            lsum += ps;
            const LAS unsigned char* vbs = sb + G::KB;
#pragma unroll
            for (int s = 0; s < 4; ++s) {
                u32x4 pw;
                if (s < 2) { pw.x = pg8::cvt_pk_bf16(p0[8 * s + 0], p0[8 * s + 1]); pw.y = pg8::cvt_pk_bf16(p0[8 * s + 2], p0[8 * s + 3]); pw.z = pg8::cvt_pk_bf16(p0[8 * s + 4], p0[8 * s + 5]); pw.w = pg8::cvt_pk_bf16(p0[8 * s + 6], p0[8 * s + 7]); }
                else { const int s2 = s - 2; pw.x = pg8::cvt_pk_bf16(p1[8 * s2 + 0], p1[8 * s2 + 1]); pw.y = pg8::cvt_pk_bf16(p1[8 * s2 + 2], p1[8 * s2 + 3]); pw.z = pg8::cvt_pk_bf16(p1[8 * s2 + 4], p1[8 * s2 + 5]); pw.w = pg8::cvt_pk_bf16(p1[8 * s2 + 6], p1[8 * s2 + 7]); }
                const bf16x8 pa = __builtin_bit_cast(bf16x8, pw);
                const int rowb = (32 * (s >> 1) + 16 * (s & 1)) * VROW;
#pragma unroll
                for (int db = 0; db < NDB; ++db) {
                    const v4i16_t lo = __builtin_amdgcn_ds_read_tr16_b64_v4i16((LAS v4i16_t*)(vbs + rowb + voff[db]));
                    const v4i16_t hv = __builtin_amdgcn_ds_read_tr16_b64_v4i16((LAS v4i16_t*)(vbs + rowb + 8 * VROW + voff[db]));
                    const bf16x8 vf = (bf16x8){lo[0], lo[1], lo[2], lo[3], hv[0], hv[1], hv[2], hv[3]};
                    o[db] = __builtin_amdgcn_mfma_f32_32x32x16_bf16(pa, vf, o[db], 0, 0, 0);
                }
                if (NDB == 4) asm volatile("" ::: "memory");
            }
        }
        if (more) { if (G::NPT == 2) asm volatile("s_waitcnt vmcnt(2) lgkmcnt(0)" ::: "memory"); else asm volatile("s_waitcnt vmcnt(3) lgkmcnt(0)" ::: "memory"); }
        else asm volatile("s_waitcnt vmcnt(0) lgkmcnt(0)" ::: "memory");
        __builtin_amdgcn_s_barrier(); asm volatile("" ::: "memory");
        stg = (stg == 2) ? 0 : stg + 1;
    }
    lsum += __shfl_xor(lsum, 32);
    mrun_out = mrun; lsum_out = lsum;
}
}
__device__ __forceinline__ void phase_attn_B(Frame& F, const Args& A) {
    int tid_ = F.wave * 64 + hw_lane(); const int tid = tid_, lane = tid & 63, wid = __builtin_amdgcn_readfirstlane(tid >> 6), q32 = lane & 31, hi = lane >> 5;
    const int v = (F.bx % 8) * (F.G / 8) + F.bx / 8;
    const bf16* P = (const bf16*)(A.ws + WS_PROJ); bf16* OB = (bf16*)(A.ws + WS_OB); const float* biasd = (const float*)(A.ws + WS_BIASD);
    for (int pv = v; pv < 256; pv += F.G) {
        const int combo = pv >> 3, s = pv & 7, b = combo >> 3, h = (combo >> 1) & 3, mp = combo & 1;
#pragma unroll 1
        for (int half = 0; half < 2; ++half) {
            const int qb = half ? s : 15 - s;
            fa::Unit U; U.P = P; U.colQ = COL_BQ + (mp * 4 + h) * 64; U.colK = COL_BK + (mp * 4 + h) * 64; U.colV = COL_BV + h * 128; U.rowbase = (long)b * T; U.stride = 1; U.rofs = 0;
            U.qi0 = 256 * qb; U.kt0 = 0; U.kt1 = 4 * (qb + 1); U.biasd = biasd + (12 + h) * 4096; U.scores = nullptr; U.tau = nullptr; U.mask = nullptr;
            fa::f32x16 o[4]; float mrun, lsum;
            fa::run2<4, 0>(F.lds + RING_OFF, U, tid, o, mrun, lsum);
            const float inv = 1.0f / lsum;
            bf16* orow = OB + (size_t)(U.rowbase + U.qi0 + 32 * wid) * 1024 + h * 256 + mp * 128 + q32;
#pragma unroll
            for (int r = 0; r < 16; ++r) { int hi_ = hi; asm volatile("" : "+v"(hi_)); const int qq = fa::crow(r, hi_); const float ir = fa::bcast_row(inv, r, hi);
#pragma unroll
                for (int db = 0; db < 4; ++db) orow[(size_t)qq * 1024 + 32 * db] = (bf16)f2bf(o[db][r] * ir); }
        }
    }
}
__device__ __forceinline__ void phase_combine_B(Frame& F, const Args& A, int L) {
    const int lane = hw_lane();
    const bf16* OB = (const bf16*)(A.ws + WS_OB); bf16* O = (bf16*)(A.ws + WS_OATT);
    const float* lv = A.in[9] + (size_t)L * 256; const float* dn = A.in[10] + (size_t)L * 128;
    const float lam_init = 0.8f - 0.6f * expf(-0.3f * (float)L);
    const float lam = expf(wave_sum(lv[lane] * lv[64 + lane])) - expf(wave_sum(lv[128 + lane] * lv[192 + lane])) + lam_init;
    const float g0 = dn[lane], g1 = dn[64 + lane];
    const int gw = F.bx * NWAVES + F.wave, NGW = F.G * NWAVES;
    for (int it0 = gw; it0 < M * 4; it0 += 4 * NGW) {
        unsigned short x[4][4];
#pragma unroll
        for (int u = 0; u < 4; ++u) { const int itr = it0 + u * NGW, it = itr < M * 4 ? itr : it0; const bf16* p = OB + (size_t)(it >> 2) * 1024 + (it & 3) * 256;
            x[u][0] = p[lane]; x[u][1] = p[64 + lane]; x[u][2] = p[128 + lane]; x[u][3] = p[192 + lane]; }
#pragma unroll
        for (int u = 0; u < 4; ++u) { const int it = it0 + u * NGW, row = it >> 2, h = it & 3; if (it >= M * 4) break;
            const float d0 = bflo((unsigned)x[u][0]) - lam * bflo((unsigned)x[u][2]), d1 = bflo((unsigned)x[u][1]) - lam * bflo((unsigned)x[u][3]);
            const float inv = __builtin_amdgcn_rsqf(wave_sum(d0 * d0 + d1 * d1) * (1.0f / 128.0f) + 1e-6f) * (1.0f - lam_init);
            O[(size_t)row * 1024 + 256 + h * 128 + lane] = (bf16)f2bf(d0 * inv * g0);
            O[(size_t)row * 1024 + 256 + h * 128 + 64 + lane] = (bf16)f2bf(d1 * inv * g1); }
    }
}
constexpr size_t SC_BATCH = 8454144;
__device__ __forceinline__ size_t sc_rowoff(int t) { const size_t i = (size_t)(t >> 5); return 512 * i * (i + 1) + (size_t)(t & 31) * 32 * (i + 1); }
typedef float f32x4v __attribute__((ext_vector_type(4)));
__device__ __forceinline__ void c1_decode(int f, int& b, int& qb, int& kt) { b = f / 1056; const int rem = f - 1056 * b; qb = 0; while ((qb + 1) * (qb + 2) <= rem) ++qb; kt = rem - qb * (qb + 1); }
__device__ __forceinline__ void phase_C1(Frame& F, const Args& A) {
    int tid_ = F.wave * 64 + hw_lane(); const int tid = tid_, lane = tid & 63, wid = __builtin_amdgcn_readfirstlane(tid >> 6), q16 = lane & 15, g = lane >> 4;
    const int v = (F.bx % 8) * (F.G / 8) + F.bx / 8;
    const bf16* P = (const bf16*)(A.ws + WS_PROJ); float* SC = (float*)(A.ws + WS_SCORES); const float* WIDX = (const float*)(A.ws + WS_WIDX);
    float* dummy = (float*)(A.ws + WS_TAU + 512 * 1024) + (size_t)F.bx * 256 + lane * 4;
    constexpr int NTOT = 4 * 1056;
    const int f0 = (int)(((long)v * NTOT) / F.G), f1 = (int)(((long)(v + 1) * NTOT) / F.G);
    if (f0 >= f1) return;
    LAS unsigned char* lds = F.lds + RING_OFF;
    const unsigned ksrc = (unsigned)((8 * wid + (lane >> 3)) * PP + COL_IK + 8 * ((lane & 7) ^ (lane >> 3)));
    auto dma = [&](int b_, int kt_, int stg_) { __builtin_amdgcn_global_load_lds((const unsigned*)(P + (size_t)((long)b_ * T + 64 * kt_) * PP + ksrc), (LAS unsigned*)(lds + stg_ * 8192 + wid * 1024), 16, 0, 0); };
    auto advance = [](int& b_, int& qb_, int& kt_) { ++kt_; if (kt_ >= 2 * (qb_ + 1)) { kt_ = 0; ++qb_; if (qb_ >= 32) { qb_ = 0; ++b_; } } };
    int b, qb, kt; c1_decode(f0, b, qb, kt);
    int b2 = b, qb2 = qb, kt2 = kt;
    dma(b, kt, 0);
    if (f0 + 1 < f1) advance(b2, qb2, kt2);
    dma(b2, kt2, 1);
    if (f0 + 2 < f1) advance(b2, qb2, kt2);
    asm volatile("s_waitcnt vmcnt(1)" ::: "memory");
    __builtin_amdgcn_s_barrier(); asm volatile("" ::: "memory");
    int f = f0, stg = 0;
    const int kx = q16 & 7;
    while (f < f1) {
        fa::bf16x8 qf[8][2]; float wq[8];
        { const size_t row = (size_t)b * T + 128 * qb + 16 * wid + q16;
#pragma unroll
          for (int h = 0; h < 8; ++h) { wq[h] = WIDX[row * 8 + h] * 0.35355339059327373f;
#pragma unroll
              for (int ks = 0; ks < 2; ++ks) qf[h][ks] = *(const fa::bf16x8*)(P + row * PP + COL_IQ + h * 64 + 32 * ks + 8 * g); } }
        asm volatile("" : "+v"(qf[0][0]), "+v"(qf[0][1]), "+v"(qf[1][0]), "+v"(qf[1][1]), "+v"(qf[2][0]), "+v"(qf[2][1]), "+v"(qf[3][0]), "+v"(qf[3][1]),
                          "+v"(qf[4][0]), "+v"(qf[4][1]), "+v"(qf[5][0]), "+v"(qf[5][1]), "+v"(qf[6][0]), "+v"(qf[6][1]), "+v"(qf[7][0]), "+v"(qf[7][1]),
                          "+v"(wq[0]), "+v"(wq[1]), "+v"(wq[2]), "+v"(wq[3]), "+v"(wq[4]), "+v"(wq[5]), "+v"(wq[6]), "+v"(wq[7]));
        int fend = f + (2 * (qb + 1) - kt); fend = fend < f1 ? fend : f1;
        const int tq0 = 128 * qb + 16 * wid;
        float* srow = SC + (size_t)b * SC_BATCH + sc_rowoff(tq0 + q16);
#pragma unroll 1
        for (; f < fend; ++f) {
            dma(b2, kt2, stg >= 1 ? stg - 1 : 2);
            const int k0 = 64 * kt;
            const LAS unsigned char* sb = lds + stg * 8192;
#pragma unroll 1
            for (int kb = 0; kb < 4; ++kb) {
                const int kbase = k0 + 16 * kb;
                const LAS unsigned char* kp = sb + (16 * kb + q16) * 128;
                const fa::bf16x8 kf0 = *(const LAS fa::bf16x8*)(kp + ((g ^ kx) << 4)), kf1 = *(const LAS fa::bf16x8*)(kp + (((4 + g) ^ kx) << 4));
                f32x4v p[8];
#pragma unroll
                for (int h = 0; h < 8; ++h) p[h] = __builtin_amdgcn_mfma_f32_16x16x32_bf16(kf0, qf[h][0], (f32x4v){0.f, 0.f, 0.f, 0.f}, 0, 0, 0);
#pragma unroll
                for (int h = 0; h < 8; ++h) p[h] = __builtin_amdgcn_mfma_f32_16x16x32_bf16(kf1, qf[h][1], p[h], 0, 0, 0);
                __builtin_amdgcn_sched_barrier(0);
                f32x4v sc = {0.f, 0.f, 0.f, 0.f};
#pragma unroll
                for (int h = 0; h < 8; ++h) {
#pragma unroll
                    for (int r = 0; r < 4; ++r) { const int pb = __float_as_int(p[h][r]); sc[r] = fa::fma_s(wq[h], __int_as_float(pb > 0 ? pb : 0), sc[r]); }
                }
                float* dst = (kbase > tq0 + 15) ? dummy : srow + kbase + 4 * g;
                *(f32x4v*)dst = sc;
            }
            asm volatile("s_waitcnt vmcnt(9) lgkmcnt(0)" ::: "memory");
            __builtin_amdgcn_s_barrier(); asm volatile("" ::: "memory");
            stg = (stg == 2) ? 0 : stg + 1;
            ++kt; if (f + 3 < f1) advance(b2, qb2, kt2);
        }
        if (kt >= 2 * (qb + 1)) { kt = 0; ++qb; if (qb >= 32) { qb = 0; ++b; } }
    }
    asm volatile("s_waitcnt vmcnt(0)" ::: "memory");
    __builtin_amdgcn_s_barrier(); asm volatile("" ::: "memory");
}

__device__ __forceinline__ void phase_select(Frame& F, const Args& A) {
    unsigned char* ws_ = A.ws;
    const int lane = hw_lane();
    const float* SC = (const float*)(ws_ + WS_SCORES); float2* TAU = (float2*)(ws_ + WS_TAU); unsigned long long* MASKW = (unsigned long long*)(ws_ + WS_MASK);
    LAS unsigned char* wl = F.lds + RING_OFF + F.wave * 18688;
    LAS unsigned* keys = (LAS unsigned*)wl;
    LAS unsigned* hist = (LAS unsigned*)(wl + 16384);
    const int gw = F.bx * NWAVES + F.wave, NGW = F.G * NWAVES;
    const unsigned long long ltmask = (1ull << lane) - 1ull;
    f32x4 nsv[16];
    auto issue_row = [&](int row_) { const int b_ = row_ >> 12, t_ = row_ & 4095; const float* sr = SC + (size_t)b_ * SC_BATCH + sc_rowoff(t_); const int rl = 32 * ((t_ >> 5) + 1);
#pragma unroll
        for (int i = 0; i < 16; ++i) { const int j0 = 256 * i + 4 * lane; nsv[i] = *(const f32x4*)(sr + (j0 + 4 <= rl ? j0 : rl - 4)); } };
    auto row_of = [&](int it_) { const int p_ = gw + NGW * (it_ >> 1); const int tt_ = p_ & 2047; return ((p_ >> 11) << 12) + ((it_ & 1) ? 4095 - tt_ : tt_); };
    const int nit = (gw < M / 2) ? 2 * ((M / 2 - 1 - gw) / NGW + 1) : 0;
    if (nit > 0) issue_row(row_of(0));
#pragma unroll 1
    for (int it = 0; it < nit; ++it) {
        const int row = row_of(it);
        const int t = row & 4095, N = t + 1;
        f32x4 sv[16];
#pragma unroll
        for (int i = 0; i < 16; ++i) sv[i] = nsv[i];
        if (it + 1 < nit) issue_row(row_of(it + 1));
        const int nc = (N + 255) >> 8;
        float tauf; int icut; bool tie = false;
        if (N <= 256) { tauf = -INFINITY; icut = 0; }
        else {
        int l4 = 4 * lane; asm volatile("" : "+v"(l4));
        float mn = fminf(fminf(sv[0][0], sv[0][1]), fminf(sv[0][2], sv[0][3])), mx = fmaxf(fmaxf(sv[0][0], sv[0][1]), fmaxf(sv[0][2], sv[0][3]));
        if (nc >= 3) { mn = fminf(mn, fminf(fminf(sv[1][0], sv[1][1]), fminf(sv[1][2], sv[1][3]))); mx = fmaxf(mx, fmaxf(fmaxf(sv[1][0], sv[1][1]), fmaxf(sv[1][2], sv[1][3]))); }
#pragma unroll
        for (int o = 32; o >= 1; o >>= 1) { mn = fminf(mn, __shfl_xor(mn, o)); mx = fmaxf(mx, __shfl_xor(mx, o)); }
        const float scale = (mx > mn) ? 511.0f / (mx - mn) : 0.0f;
        const float boff = -mn * scale;
        { unsigned zz = 0u; asm volatile("" : "+v"(zz)); const v4u z4 = (v4u){zz, zz, zz, zz};
          *(LAS v4u*)(hist + 4 * lane) = z4; *(LAS v4u*)(hist + 256 + 4 * lane) = z4; if (lane < 2) *(LAS v4u*)(hist + 512 + 4 * lane) = z4; }
        LDS_WAIT();
#pragma unroll
        for (int i = 0; i < 16; ++i) { if (i < nc - 1) {
#pragma unroll
                for (int e = 0; e < 4; ++e) { int bk = (int)__builtin_fmaf(sv[i][e], scale, boff); bk = bk < 0 ? 0 : bk; bk = bk > 511 ? 511 : bk;
                    __hip_atomic_fetch_add(hist + bk, 1u, __ATOMIC_RELAXED, __HIP_MEMORY_SCOPE_WORKGROUP); } }
            else if (i == nc - 1) {
#pragma unroll
                for (int e = 0; e < 4; ++e) { int bk = (int)__builtin_fmaf(sv[i][e], scale, boff); bk = bk < 0 ? 0 : bk; bk = bk > 511 ? 511 : bk; bk = (256 * i + l4 + e < N) ? bk : 512;
                    __hip_atomic_fetch_add(hist + bk, 1u, __ATOMIC_RELAXED, __HIP_MEMORY_SCOPE_WORKGROUP); } } }
        LDS_WAIT();
        int fbk, krem, cfb;
        { const v4u h0 = *(const LAS v4u*)(hist + 8 * lane), h1 = *(const LAS v4u*)(hist + 8 * lane + 4);
          const unsigned sl = h0.x + h0.y + h0.z + h0.w + h1.x + h1.y + h1.z + h1.w;
          unsigned suf = sl;
#pragma unroll
          for (int o = 1; o < 64; o <<= 1) { const unsigned other = (unsigned)__builtin_amdgcn_ds_bpermute(((lane + o) & 63) << 2, (int)suf); if (lane + o < 64) suf += other;     }
          unsigned cum = suf - sl;
          int fb = -1; unsigned fabove = 0u, fcnt = 0u; int l8 = 8 * lane; asm volatile("" : "+v"(l8));
          const unsigned cc[8] = {h1.w, h1.z, h1.y, h1.x, h0.w, h0.z, h0.y, h0.x};
#pragma unroll
          for (int i = 0; i < 8; ++i) { if (fb < 0 && cum < 256u && cum + cc[i] >= 256u) { fb = l8 + 7 - i; fabove = cum; fcnt = cc[i]; } cum += cc[i]; }
          const unsigned long long bal = __ballot(fb >= 0);
          const int src = __builtin_ctzll(bal);
          fbk = __shfl(fb, src); krem = 256 - (int)__shfl(fabove, src); cfb = (int)__shfl(fcnt, src); }
        if (cfb <= 64) {
            int l4b = 4 * lane; asm volatile("" : "+v"(l4b));
            unsigned cbase = 0u;
#pragma unroll
            for (int i = 0; i < 16; ++i) { if (i < nc) {
                bool hit[4]; bool anyh = false;
#pragma unroll
                for (int e = 0; e < 4; ++e) { int bk = (int)__builtin_fmaf(sv[i][e], scale, boff); bk = bk < 0 ? 0 : bk; bk = bk > 511 ? 511 : bk; hit[e] = (bk == fbk) && (256 * i + l4b + e < N); anyh = anyh || hit[e]; }
                if (__any(anyh)) {
#pragma unroll
                    for (int e = 0; e < 4; ++e) { const unsigned long long bm = __ballot(hit[e]);
                        if (hit[e]) { const unsigned pos = cbase + (unsigned)__popcll(bm & ltmask); keys[2 * pos] = __float_as_uint(sv[i][e]); keys[2 * pos + 1] = (unsigned)(256 * i + l4b + e); }
                        cbase += (unsigned)__popcll(bm); } } } }
            LDS_WAIT();
            const int cl = lane < cfb ? lane : 0;
            const float sl_ = __uint_as_float(keys[2 * cl]); const int il_ = (int)keys[2 * cl + 1];
            int rank = 0;
#pragma unroll 1
            for (int m = 0; m < cfb; ++m) { const float sm = __uint_as_float(__builtin_amdgcn_readlane(__float_as_uint(sl_), m)); const int im = __builtin_amdgcn_readlane(il_, m);
                rank += (sm > sl_ || (sm == sl_ && im < il_)) ? 1 : 0; }
            const unsigned long long hitl = __ballot(lane < cfb && rank == krem - 1);
            const int src = __builtin_ctzll(hitl);
            tauf = __shfl(sl_, src); icut = __shfl(il_, src);
            tie = __popcll(__ballot(lane < cfb && sl_ == tauf)) > 1;
            LDS_WAIT();
        } else {
            tie = true;
#pragma unroll
            for (int i = 0; i < 16; ++i) { const int j0 = 256 * i + 4 * lane; v4u u;
#pragma unroll
                for (int e = 0; e < 4; ++e) { const unsigned bits = __float_as_uint(sv[i][e]); const unsigned kk = (bits & 0x80000000u) ? ~bits : (bits | 0x80000000u); u[e] = (j0 + e < N) ? kk : 0u; }
                if (i < nc) *(LAS v4u*)(keys + j0) = u; }
            unsigned prefix = 0u, mask = 0u; int kr = 256;
#pragma unroll 1
            for (int pass = 0; pass < 4; ++pass) {
                const int shift = 24 - 8 * pass;
                { unsigned zz = 0u; asm volatile("" : "+v"(zz)); *(LAS v4u*)(hist + 4 * lane) = (v4u){zz, zz, zz, zz}; }
                LDS_WAIT();
#pragma unroll 1
                for (int c = 0; c < nc; ++c) { const v4u kq = *(const LAS v4u*)(keys + 256 * c + 4 * lane);
#pragma unroll
                    for (int e = 0; e < 4; ++e) { const unsigned kk = kq[e]; if (kk != 0u && (kk & mask) == prefix) __hip_atomic_fetch_add(hist + ((kk >> shift) & 255u), 1u, __ATOMIC_RELAXED, __HIP_MEMORY_SCOPE_WORKGROUP); } }
                LDS_WAIT();
                const v4u hc = *(const LAS v4u*)(hist + 4 * lane);
                const unsigned sl = hc.x + hc.y + hc.z + hc.w;
                unsigned suf = sl;
#pragma unroll
                for (int o = 1; o < 64; o <<= 1) { const unsigned other = (unsigned)__builtin_amdgcn_ds_bpermute(((lane + o) & 63) << 2, (int)suf); if (lane + o < 64) suf += other;     }
                unsigned cum = suf - sl;
                int fb = -1; unsigned fabove = 0u;
                { const unsigned cc[4] = {hc.w, hc.z, hc.y, hc.x};
#pragma unroll
                  for (int i = 0; i < 4; ++i) { if (fb < 0 && cum < (unsigned)kr && cum + cc[i] >= (unsigned)kr) { fb = 4 * lane + 3 - i; fabove = cum; } cum += cc[i]; } }
                const unsigned long long bal = __ballot(fb >= 0);
                const int src = __builtin_ctzll(bal);
                const int bin = __shfl(fb, src); const unsigned above = __shfl(fabove, src);
                prefix |= (unsigned)bin << shift; mask |= 0xFFu << shift; kr -= (int)above;
            }
            int eqseen = 0; icut = -1;
#pragma unroll 1
            for (int c = 0; c < nc; ++c) {
                const v4u kq = *(const LAS v4u*)(keys + 256 * c + 4 * lane);
                const bool e0 = kq.x == prefix, e1 = kq.y == prefix, e2 = kq.z == prefix, e3 = kq.w == prefix;
                const unsigned long long b0 = __ballot(e0), b1 = __ballot(e1), b2 = __ballot(e2), b3 = __ballot(e3);
                if ((b0 | b1 | b2 | b3) != 0ull) {
                    const int lower = eqseen + __popcll(b0 & ltmask) + __popcll(b1 & ltmask) + __popcll(b2 & ltmask) + __popcll(b3 & ltmask);
                    const int r0 = lower, r1 = r0 + (e0 ? 1 : 0), r2 = r1 + (e1 ? 1 : 0), r3 = r2 + (e2 ? 1 : 0);
                    int mine = -1;
                    if (e0 && r0 == kr - 1) mine = 0; if (e1 && r1 == kr - 1) mine = 1; if (e2 && r2 == kr - 1) mine = 2; if (e3 && r3 == kr - 1) mine = 3;
                    const unsigned long long hit = __ballot(mine >= 0);
                    if (hit) { const int src = __builtin_ctzll(hit); icut = 256 * c + 4 * src + __shfl(mine, src); }
                    eqseen += __popcll(b0) + __popcll(b1) + __popcll(b2) + __popcll(b3);
                }
            }
            const unsigned tb = (prefix & 0x80000000u) ? (prefix & 0x7fffffffu) : ~prefix;
            tauf = __uint_as_float(tb);
            LDS_WAIT();
        }
        }
        if (lane == 0) TAU[row] = make_float2(tauf, __int_as_float(icut));
        { unsigned mlo = 0u, mhi = 0u; int l4c = 4 * lane; asm volatile("" : "+v"(l4c));
#define SEL_PUT(bal_, idx_) do { const unsigned long long bq_ = (bal_); const unsigned blo = (unsigned)bq_, bhi = (unsigned)(bq_ >> 32); \
              asm volatile("s_nop 1\n\tv_writelane_b32 %0, %2, %4\n\tv_writelane_b32 %1, %3, %4" : "+v"(mlo), "+v"(mhi) : "s"(blo), "s"(bhi), "n"(idx_)); } while (0)
          if (!tie) {
#pragma unroll
            for (int i = 0; i < 16; ++i) { if (i < nc - 1) {
#pragma unroll
                for (int e = 0; e < 4; ++e) SEL_PUT(__ballot(sv[i][e] >= tauf), 4 * i + e); }
              else if (i == nc - 1) {
#pragma unroll
                for (int e = 0; e < 4; ++e) SEL_PUT(__ballot((256 * i + l4c + e < N) & (sv[i][e] >= tauf)), 4 * i + e); } }
          } else {
#pragma unroll
            for (int i = 0; i < 16; ++i) { if (i < nc) {
#pragma unroll
                for (int e = 0; e < 4; ++e) { const float sx = sv[i][e]; const int j = 256 * i + l4c + e;
                    SEL_PUT(__ballot((j < N) & ((sx > tauf) | ((sx == tauf) & (j <= icut)))), 4 * i + e); } } }
          }
#undef SEL_PUT
          MASKW[(size_t)row * 64 + lane] = ((unsigned long long)mhi << 32) | (unsigned long long)mlo; }
    }
}

__device__ __forceinline__ void phase_attn_C(Frame& F, const Args& A) {
    int tid_ = F.wave * 64 + hw_lane(); const int tid = tid_, lane = tid & 63, wid = __builtin_amdgcn_readfirstlane(tid >> 6), q32 = lane & 31, hi = lane >> 5;
    const int v = (F.bx % 8) * (F.G / 8) + F.bx / 8;
    const bf16* P = (const bf16*)(A.ws + WS_PROJ); bf16* OP = (bf16*)(A.ws + WS_OAP); float* ST = (float*)(A.ws + WS_OAP + 24 * MiB); const float* biasd = (const float*)(A.ws + WS_BIASD);
    for (int pv = v; pv < 256; pv += F.G) {
        const int combo = pv >> 3, s = pv & 7, b = combo >> 3, h = (combo >> 1) & 3, half = combo & 1;
#pragma unroll 1
        for (int which = 0; which < 2; ++which) {
            const int qb = which ? s : 15 - s, ntile = 4 * (qb + 1), kmid = ntile / 2;
            fa::Unit U; U.P = P; U.colQ = COL_CQ + h * 64; U.colK = COL_CK; U.colV = COL_CV; U.rowbase = (long)b * T; U.stride = 1; U.rofs = 0;
            U.qi0 = 256 * qb; U.kt0 = half ? kmid : 0; U.kt1 = half ? ntile : kmid; U.biasd = biasd + (16 + h) * 4096;
            U.scores = (const float*)(A.ws + WS_SCORES) + (size_t)b * SC_BATCH; U.tau = (const float2*)(A.ws + WS_TAU) + (size_t)b * T; U.mask = (const unsigned long long*)(A.ws + WS_MASK) + (size_t)b * T * 64;
            fa::f32x16 o[2]; float mrun, lsum;
            fa::run2<2, 2>(F.lds + RING_OFF, U, tid, o, mrun, lsum);
            const float inv = (lsum > 0.f) ? 1.0f / lsum : 0.f;
            const size_t prow0 = (size_t)half * M + (size_t)U.rowbase + U.qi0 + 32 * wid;
            if (hi == 0) *(float2*)(ST + ((prow0 + q32) * 4 + h) * 2) = make_float2(mrun, lsum);
#pragma unroll
            for (int r = 0; r < 16; ++r) { int hi_ = hi; asm volatile("" : "+v"(hi_)); const int qq = fa::crow(r, hi_); const float ir = fa::bcast_row(inv, r, hi);
#pragma unroll
                for (int db = 0; db < 2; ++db) OP[(prow0 + qq) * 256 + h * 64 + 32 * db + q32] = (bf16)f2bf(o[db][r] * ir); }
        }
    }
}
template <int NG, int OCOL> __device__ __forceinline__ void merge_partials(Frame& F, const Args& A) {
    const int lane = hw_lane();
    const bf16* OP = (const bf16*)(A.ws + WS_OAP); const float* ST = (const float*)(A.ws + WS_OAP + 24 * MiB); bf16* O = (bf16*)(A.ws + WS_OATT);
    const int gw = F.bx * NWAVES + F.wave, NGW = F.G * NWAVES;
    for (int it0 = gw; it0 < M * 4; it0 += 4 * NGW) {
        float2 st[4][NG]; unsigned short ov[4][NG];
#pragma unroll
        for (int u = 0; u < 4; ++u) { const int itr = it0 + u * NGW, it = itr < M * 4 ? itr : it0, row = it >> 2, h = it & 3;
#pragma unroll
            for (int g = 0; g < NG; ++g) { const size_t prow = (size_t)g * M + row; st[u][g] = *(const float2*)(ST + (prow * 4 + h) * 2); ov[u][g] = OP[prow * 256 + h * 64 + lane]; } }
#pragma unroll
        for (int u = 0; u < 4; ++u) { const int it = it0 + u * NGW, row = it >> 2, h = it & 3; if (it >= M * 4) break;
            float mm = st[u][0].x;
#pragma unroll
            for (int g = 1; g < NG; ++g) mm = fmaxf(mm, st[u][g].x);
            float num = 0.f, den = 0.f;
#pragma unroll
            for (int g = 0; g < NG; ++g) { const float w = __builtin_amdgcn_exp2f(st[u][g].x - mm) * st[u][g].y; num += w * bflo((unsigned)ov[u][g]); den += w; }
            O[(size_t)row * 1024 + OCOL + h * 64 + lane] = (bf16)f2bf(num / den); }
    }
}
__device__ __forceinline__ void phase_merge_C(Frame& F, const Args& A) { merge_partials<2, 768>(F, A); }

__device__ __forceinline__ void phase_attn_A(Frame& F, const Args& A) {
    int tid_ = F.wave * 64 + hw_lane(); const int tid = tid_, lane = tid & 63, wid = __builtin_amdgcn_readfirstlane(tid >> 6), q32 = lane & 31, hi = lane >> 5;
    const int v = (F.bx % 8) * (F.G / 8) + F.bx / 8;
    const bf16* P = (const bf16*)(A.ws + WS_PROJ); bf16* OP = (bf16*)(A.ws + WS_OAP); float* ST = (float*)(A.ws + WS_OAP + 24 * MiB); const float* biasd = (const float*)(A.ws + WS_BIASD);
    const int u0 = (int)(((long)v * 768) / F.G), u1 = (int)(((long)(v + 1) * 768) / F.G);
#pragma unroll 1
    for (int u = u0; u < u1; ++u) {
        const int b = u / 192, rem = u % 192, g = rem >> 6, hs = (rem >> 4) & 3, ri = rem & 15;
        const int dil = (g == 0) ? 1 : (g == 1 ? 4 : 16), res = (g == 0) ? 0 : (g == 1 ? (ri >> 2) : ri), iblk = (g == 0) ? ri : (g == 1 ? (ri & 3) : 0), head = 4 * g + hs;
        fa::Unit U; U.P = P; U.colQ = COL_AQ + head * 64; U.colK = COL_AK + head * 64; U.colV = COL_AV + head * 64; U.rowbase = (long)b * T; U.stride = dil; U.rofs = res;
        U.qi0 = 256 * iblk; U.kt0 = (iblk == 0) ? 0 : 4 * iblk - 2; U.kt1 = 4 * iblk + 4; U.biasd = biasd + head * 4096;
        fa::f32x16 o[2]; float mrun, lsum;
        fa::run2<2, 1>(F.lds + RING_OFF, U, tid, o, mrun, lsum);
        const float inv = 1.0f / lsum;
        const size_t prow0 = (size_t)g * M + (size_t)U.rowbase + res;
        if (hi == 0) { const size_t prow = prow0 + (size_t)(U.qi0 + 32 * wid + q32) * dil; *(float2*)(ST + (prow * 4 + hs) * 2) = make_float2(mrun, lsum); }
#pragma unroll
        for (int r = 0; r < 16; ++r) { int hi_ = hi; asm volatile("" : "+v"(hi_)); const int qq = fa::crow(r, hi_); const float ir = fa::bcast_row(inv, r, hi); const size_t prow = prow0 + (size_t)(U.qi0 + 32 * wid + qq) * dil;
#pragma unroll
            for (int db = 0; db < 2; ++db) OP[prow * 256 + hs * 64 + 32 * db + q32] = (bf16)f2bf(o[db][r] * ir); }
    }
}
__device__ __forceinline__ void phase_merge_A(Frame& F, const Args& A) { merge_partials<3, 0>(F, A); }
#define XB_TMO      128
#define XB_XCNT(j)  (256  + 64 * (j))
#define XB_XSUB(j)  (1280 + 64 * (j))
#define XB_XGEN(j)  (2304 + 64 * (j))
#define XB_TOP      3328
#define XB_TOPGEN   3392
#define XCD_BAR_WORDS 3456
#define XB_SPIN_CAP (1u << 24)

__device__ __forceinline__ unsigned xb_ld(unsigned* p)              { return __hip_atomic_load(p, __ATOMIC_RELAXED, __HIP_MEMORY_SCOPE_AGENT); }
__device__ __forceinline__ unsigned xb_add(unsigned* p, unsigned v) { return __hip_atomic_fetch_add(p, v, __ATOMIC_RELAXED, __HIP_MEMORY_SCOPE_AGENT); }
__device__ __forceinline__ unsigned xb_xcc_id() { return (unsigned)__builtin_amdgcn_s_getreg((3 << 11) | 20) & 0xFu; }
#define XB_SPIN(cond, bar) do { unsigned _sp = 0; while (cond) { __builtin_amdgcn_s_sleep(1); \
    if ((++_sp & 255u) == 0u) { if (xb_ld(&(bar)[XB_TMO])) break; if (_sp > XB_SPIN_CAP) { atomicAdd(&(bar)[XB_TMO], 1u); break; } } } } while (0)

struct XcdBarrier {
    unsigned* bar; unsigned x;
    volatile LAS unsigned* st;
};

__device__ __forceinline__ XcdBarrier xcd_barrier_post(unsigned* bar, volatile LAS unsigned* st, bool leader) {
    XcdBarrier b; b.bar = bar; b.x = xb_xcc_id(); b.st = st;
    if (leader) (void)xb_add(&bar[XB_XCNT(b.x)], 1u);
    return b;
}
__device__ __forceinline__ void xcd_barrier_complete(unsigned* bar, unsigned x, unsigned& nloc, unsigned& nx) {
    const unsigned G = gridDim.x * gridDim.y * gridDim.z;
    unsigned sum, cnt, mine, sp = 0u;
    for (;;) {
        sum = 0u; cnt = 0u; mine = 0u;
#pragma unroll
        for (unsigned j = 0; j < 16; ++j) { const unsigned c = xb_ld(&bar[XB_XCNT(j)]); sum += c; cnt += (c > 0u) ? 1u : 0u; mine = (j == x) ? c : mine; }
        if (sum == G) break;
        __builtin_amdgcn_s_sleep(1);
        if ((++sp & 255u) == 0u) { if (xb_ld(&bar[XB_TMO])) break; if (sp > XB_SPIN_CAP) { atomicAdd(&bar[XB_TMO], 1u); break; } }
    }
    nloc = mine > 0u ? mine : 1u; nx = cnt > 0u ? cnt : 1u;
}

__device__ __forceinline__ void xcd_barrier(const XcdBarrier& b, bool leader) {
    asm volatile("s_waitcnt vmcnt(0)" ::: "memory");
    __syncthreads();
    if (leader) {
        unsigned* bar = b.bar;
        __builtin_amdgcn_s_waitcnt(0);
        unsigned nloc = b.st[0], nx = b.st[1];
        if (nloc == 0u) { xcd_barrier_complete(bar, b.x, nloc, nx); b.st[0] = nloc; b.st[1] = nx; }
        const unsigned old = xb_add(&bar[XB_XSUB(b.x)], 1u);
        const unsigned gen = old / nloc;
        if (old + 1u == (gen + 1u) * nloc) {
            __builtin_amdgcn_fence(__ATOMIC_RELEASE, "agent");
            asm volatile("s_waitcnt vmcnt(0)" ::: "memory");
            const unsigned og = xb_add(&bar[XB_TOP], 1u);
            const unsigned tg = og / nx;
            if (og + 1u == (tg + 1u) * nx) xb_add(&bar[XB_TOPGEN], 1u);
            else XB_SPIN(xb_ld(&bar[XB_TOPGEN]) == tg, bar);
            __builtin_amdgcn_fence(__ATOMIC_ACQUIRE, "agent");
            xb_add(&bar[XB_XGEN(b.x)], 1u);
            asm volatile("s_waitcnt vmcnt(0)" ::: "memory");
        } else {
            XB_SPIN(xb_ld(&bar[XB_XGEN(b.x)]) == gen, bar);
            __builtin_amdgcn_fence(__ATOMIC_ACQUIRE, "agent");
            asm volatile("s_waitcnt vmcnt(0)" ::: "memory");
        }
    }
    __syncthreads();
}
#ifndef DUP_SUB
#define DUP_SUB 0
#endif
#ifndef DUP_PHASE
#define DUP_PHASE -1
#endif
#ifndef FAST_B
#define FAST_B 1
#endif
#ifndef GATE_ALIGN
#define GATE_ALIGN true
#endif
#ifndef MERGE_CALLS
#define MERGE_CALLS 3
#endif
#ifndef ORACLE_MASK
#define ORACLE_MASK 7
#endif
#ifndef PHASE_MASK
#define PHASE_MASK 0xfff
#endif
constexpr int NPH_LAYER = 12, NPHASE = 1 + NLAYER * NPH_LAYER;
__global__ void __launch_bounds__(NWAVES * 64, 2) mk_fwd(const Args A) {
    extern __shared__ __attribute__((aligned(16))) unsigned char lds[];
    Frame F;
    F.lds = (LAS unsigned char*)lds;
    F.MISC = (volatile LAS unsigned*)(F.lds + MISC_OFF);
    const int t0_ = threadIdx.x; F.tid = 0; F.wave = __builtin_amdgcn_readfirstlane(t0_ >> 6);
    F.G = gridDim.x; F.bx = blockIdx.x;
    gu32* const ctl = (gu32*)(A.ws + WS_CTL);
    for (int u = t0_; u < (LDS_BYTES - MISC_OFF) / 4; u += NWAVES * 64) ((LAS unsigned*)(F.lds + MISC_OFF))[u] = 0u;
    __syncthreads();
    const int lo = A.lo, hi = A.hi;
    XcdBarrier bar; bar.bar = (unsigned*)(ctl + CW_BAR); bar.x = 0; bar.st = nullptr;
    if (hi - lo > 1) bar = xcd_barrier_post((unsigned*)(ctl + CW_BAR), F.MISC + 8, F.wave == 0 && hw_lane() == 0);
#define IN(k) (lo <= (k) && (k) < hi)
#ifdef TIMING_PROBE
    unsigned long long tp_last = __builtin_amdgcn_s_memrealtime();
    unsigned long long* const tp_acc = (unsigned long long*)(A.ws + WS_CTL + 65536);
#define TP_MARK(slot) do { if (F.bx == 0 && F.wave == 0 && hw_lane() == 0) { const unsigned long long now_ = __builtin_amdgcn_s_memrealtime(); tp_acc[slot] += now_ - tp_last; tp_last = now_; } } while (0)
#else
#define TP_MARK(slot) do { } while (0)
#endif
#ifdef DUP_BARRIER
#define SEAM(k) do { if (IN(k) && IN((k) + 1)) { xcd_barrier(bar, F.wave == 0 && hw_lane() == 0); xcd_barrier(bar, F.wave == 0 && hw_lane() == 0); } } while (0)
#else
#define SEAM(k) do { if (IN(k) && IN((k) + 1)) xcd_barrier(bar, F.wave == 0 && hw_lane() == 0); } while (0)
#endif
    bf16* const XB = (bf16*)(A.ws + WS_XB); bf16* const PROJ = (bf16*)(A.ws + WS_PROJ); bf16* const HMID = (bf16*)(A.ws + WS_HMID); bf16* const GATES = (bf16*)(A.ws + WS_GATES);
    bf16* const OATT = (bf16*)(A.ws + WS_OATT); bf16* const Y = (bf16*)(A.ws + WS_Y); float* const ROWSS = (float*)(A.ws + WS_ROWSS); float* const WIDX = (float*)(A.ws + WS_WIDX);
    unsigned char* const wb = A.ws + WS_W;

    if (IN(0)) { phase_prologue(F, A); phase_convert(F, A, 0, CV_SETA0, CV_SETA1, CV_SETA2, CV_SETA3, F.bx * NWAVES + F.wave, F.G * NWAVES); } SEAM(0); TP_MARK(0);

    for (int L = 0; L < NLAYER; ++L) {
        const int g0 = 1 + L * NPH_LAYER;
        if (hi <= g0 || lo >= g0 + NPH_LAYER) continue;
        { int Gl = gridDim.x; asm volatile("" : "+s"(Gl)); F.G = Gl; }
        if (((PHASE_MASK >> 1) & 1) && IN(g0 + 1)) for (int rep = 0; rep < ((DUP_PHASE == 1) ? 2 : 1); ++rep) {
            pg8::Gemm g{XB, (const bf16*)(wb + O_GU1), M, 2 * FF, D, D}; int G_ = F.G, bxs_ = F.bx; asm volatile("" : "+s"(G_), "+s"(bxs_)); pg8::StaticOrder S; S.init(M, 2 * FF, G_, bxs_);
            epi::EpiSwiGLU E{HMID, FF, ROWSS, 1.0f};
            pg8::gemm_phase<epi::EpiSwiGLU, pg8::StaticOrder, true, true>(F.lds + RING_OFF, g, S, E, F.wave);
            { int bx_ = F.bx; asm volatile("" : "+s"(bx_)); const int rem = A.rem;
              if (bx_ >= rem) phase_convert(F, A, L, CV_SETB0, CV_SETB1, CV_SETB2, CV_SETB3, (bx_ - rem) * NWAVES + F.wave, (F.G - rem) * NWAVES); }
        } SEAM(g0 + 1); TP_MARK(2);
        if (((PHASE_MASK >> 2) & 1) && IN(g0 + 2)) for (int rep = 0; rep < ((DUP_PHASE == 2) ? 2 : 1); ++rep) {
            pg8::Gemm g{HMID, (const bf16*)(wb + O_DN1), M, D, FF, FF}; pg8::StaticOrder S; S.init(M, D, F.G, F.bx);
            epi::EpiResidual E{nullptr, XB, ROWSS, A.ws + WS_X8, rep ? 0.0f : 0.5f};
            pg8::gemm_phase<epi::EpiResidual, pg8::StaticOrder, false, true>(F.lds + RING_OFF, g, S, E, F.wave);
        } SEAM(g0 + 2); TP_MARK(3);
        if (((PHASE_MASK >> 3) & 1) && IN(g0 + 3)) for (int rep = 0; rep < ((DUP_PHASE == 3) ? 2 : 1); ++rep) {
            { pg8::Gemm g{XB, (const bf16*)(wb + O_QKV), M, PP, D, D}; pg8::SubsetOrder<false> S; S.init(M, F.G, F.bx);
              epi::EpiQKV E{PROJ, PP, ROWSS, A.in[8] + (size_t)L * 384, WIDX, 1.0f};
              pg8::gemm_phase<epi::EpiQKV, pg8::SubsetOrder<false>, true, true>(F.lds + RING_OFF, g, S, E, F.wave); }
            { int Kq = D / 2; asm volatile("" : "+s"(Kq));
              pg8::Gemm g{(const bf16*)(A.ws + WS_X8), (const bf16*)(A.ws + WS_QKV8), M, PP, Kq, Kq};
              pg8::SubsetOrder<true> S; S.init(M, F.G, (F.bx + F.G / 2) % F.G);
              epi::EpiQKV E{PROJ, PP, ROWSS, A.in[8] + (size_t)L * 384, WIDX, 1.0f / 32.0f};
              pg8::gemm_phase<epi::EpiQKV, pg8::SubsetOrder<true>, true, true, true>(F.lds + RING_OFF, g, S, E, F.wave); }
        } SEAM(g0 + 3); TP_MARK(4);
        if (((PHASE_MASK >> 4) & 1) && IN(g0 + 4)) for (int rep = 0; rep < ((DUP_PHASE == 4) ? 2 : 1); ++rep) {
            for (int r2 = 0; r2 < ((DUP_SUB == 1) ? 2 : 1); ++r2) phase_attn_B(F, A);
            for (int r2 = 0; r2 < ((DUP_SUB == 2) ? 2 : 1); ++r2) phase_attn_A(F, A);
            for (int r2 = 0; r2 < ((DUP_SUB == 3) ? 2 : 1); ++r2) phase_C1(F, A);
        } SEAM(g0 + 4); TP_MARK(5);
        if (((PHASE_MASK >> 5) & 1) && IN(g0 + 5)) for (int rep = 0; rep < ((DUP_PHASE == 5) ? 2 : 1); ++rep) {
            for (int r2 = 0; r2 < ((DUP_SUB == 4) ? 2 : 1); ++r2) phase_select(F, A);
            for (int r2 = 0; r2 < ((DUP_SUB == 5) ? 2 : 1); ++r2) phase_combine_B(F, A, L);
            for (int r2 = 0; r2 < ((DUP_SUB == 6) ? 2 : 1); ++r2) phase_merge_A(F, A);
        } SEAM(g0 + 5); TP_MARK(6);
        if (((PHASE_MASK >> 6) & 1) && IN(g0 + 6)) for (int rep = 0; rep < ((DUP_PHASE == 6) ? 2 : 1); ++rep) {
            phase_attn_C(F, A);
        } SEAM(g0 + 6); TP_MARK(7);
        if (((PHASE_MASK >> 7) & 1) && IN(g0 + 7)) for (int rep = 0; rep < ((DUP_PHASE == 7) ? 2 : 1); ++rep) {
            int Kq = D / 2; asm volatile("" : "+s"(Kq));
            pg8::Gemm g{(const bf16*)(A.ws + WS_X8), (const bf16*)(wb + O_GATE), M, NGATE, Kq, Kq}; pg8::StaticOrder S; S.init(M, NGATE, F.G, F.bx);
            epi::EpiSigmoid E{GATES, NGATE, ROWSS, 1.0f / 32.0f};
            pg8::gemm_phase<epi::EpiSigmoid, pg8::StaticOrder, GATE_ALIGN, true, true>(F.lds + RING_OFF, g, S, E, F.wave);
            __syncthreads();
            phase_merge_C(F, A);
        } SEAM(g0 + 7); TP_MARK(8);
        if (((PHASE_MASK >> 8) & 1) && IN(g0 + 8)) for (int rep = 0; rep < ((DUP_PHASE == 8) ? 2 : 1); ++rep) {
            pg8::StaticOrder S; S.init(M, D, F.G, F.bx);
            { pg8::Gemm g{OATT, (const bf16*)(wb + O_BA), M, D, 256, 1024}; epi::EpiMerge E{Y, GATES, NGATE, 0};
              pg8::gemm_phase<epi::EpiMerge, pg8::StaticOrder, false, true>(F.lds + RING_OFF, g, S, E, F.wave); }
#if MERGE_CALLS > 1
            { pg8::Gemm g{OATT + 256, (const bf16*)(wb + O_BB), M, D, 512, 1024}; epi::EpiMerge E{Y, GATES + 1024, NGATE, 1};
              pg8::gemm_phase<epi::EpiMerge, pg8::StaticOrder, false, true>(F.lds + RING_OFF, g, S, E, F.wave); }
            { pg8::Gemm g{OATT + 768, (const bf16*)(wb + O_BC), M, D, 256, 1024}; epi::EpiMerge E{Y, GATES + 2048, NGATE, 1};
              pg8::gemm_phase<epi::EpiMerge, pg8::StaticOrder, false, true>(F.lds + RING_OFF, g, S, E, F.wave); }
#endif
        } SEAM(g0 + 8); TP_MARK(9);
        if (((PHASE_MASK >> 9) & 1) && IN(g0 + 9)) for (int rep = 0; rep < ((DUP_PHASE == 9) ? 2 : 1); ++rep) {
            pg8::Gemm g{Y, (const bf16*)(wb + O_OUT), M, D, D, D}; pg8::StaticOrder S; S.init(M, D, F.G, F.bx);
            epi::EpiResidual E{nullptr, XB, ROWSS, A.ws + WS_X8, rep ? 0.0f : 1.0f};
            pg8::gemm_phase<epi::EpiResidual, pg8::StaticOrder, false, true>(F.lds + RING_OFF, g, S, E, F.wave);
        } SEAM(g0 + 9); TP_MARK(10);
        if (((PHASE_MASK >> 10) & 1) && IN(g0 + 10)) for (int rep = 0; rep < ((DUP_PHASE == 10) ? 2 : 1); ++rep) {
            int Kq = D / 2; asm volatile("" : "+s"(Kq));
            pg8::Gemm g{(const bf16*)(A.ws + WS_X8), (const bf16*)(wb + O_GU2), M, 2 * FF, Kq, Kq}; int G_ = F.G, bxs_ = F.bx; asm volatile("" : "+s"(G_), "+s"(bxs_)); pg8::StaticOrder S; S.init(M, 2 * FF, G_, bxs_);
            epi::EpiSwiGLU E{HMID, FF, ROWSS, 1.0f / 32.0f};
            pg8::gemm_phase<epi::EpiSwiGLU, pg8::StaticOrder, true, true, true>(F.lds + RING_OFF, g, S, E, F.wave);
            if (L + 1 < NLAYER) { int bx_ = F.bx; asm volatile("" : "+s"(bx_)); const int rem = A.rem;
              if (bx_ >= rem) phase_convert(F, A, L + 1, CV_SETA0, CV_SETA1, CV_SETA2, CV_SETA3, (bx_ - rem) * NWAVES + F.wave, (F.G - rem) * NWAVES); }
        } SEAM(g0 + 10); TP_MARK(11);
        if (((PHASE_MASK >> 11) & 1) && IN(g0 + 11)) for (int rep = 0; rep < ((DUP_PHASE == 11) ? 2 : 1); ++rep) {
            pg8::Gemm g{HMID, (const bf16*)(wb + O_DN2), M, D, FF, FF}; pg8::StaticOrder S; S.init(M, D, F.G, F.bx);
            epi::EpiResidual E{(L == NLAYER - 1) ? A.out : nullptr, XB, ROWSS, nullptr, rep ? 0.0f : 0.5f};
            pg8::gemm_phase<epi::EpiResidual, pg8::StaticOrder, false, true>(F.lds + RING_OFF, g, S, E, F.wave);
        } SEAM(g0 + 11); TP_MARK(12);
    }
#ifdef TIMING_PROBE
    {
        xcd_barrier(bar);
        unsigned long long tot = 0; for (int s_ = 0; s_ < 12; ++s_) if ((TIMING_PROBE >> s_) & 1) tot += __hip_atomic_load(tp_acc + s_, __ATOMIC_RELAXED, __HIP_MEMORY_SCOPE_AGENT);
        const float K = 1000.0f * (float)tot * 0.01f;
        for (size_t i = (size_t)F.bx * 512 + F.wave * 64 + hw_lane(); i < (size_t)M * D; i += (size_t)F.G * 512) A.out[i] = K;
    }
#endif
#undef IN
#undef SEAM
}

#ifdef MK_DEBUG_KERNELS
__global__ void __launch_bounds__(256) k_oracle_A(unsigned char* ws) { oracle_A(ws, blockIdx.x * 4 + (threadIdx.x >> 6), gridDim.x * 4, threadIdx.x & 63); }
__global__ void __launch_bounds__(256) k_oracle_B(unsigned char* ws, const float* lv, const float* dn, int L) { oracle_B(ws, blockIdx.x * 4 + (threadIdx.x >> 6), gridDim.x * 4, lv + (size_t)L * 256, dn + (size_t)L * 128, L, threadIdx.x & 63); }
__global__ void __launch_bounds__(128, 1) k_oracle_C(unsigned char* ws) { extern __shared__ __attribute__((aligned(16))) unsigned char olds[]; oracle_C(ws, blockIdx.x * 2 + (threadIdx.x >> 6), gridDim.x * 2, (LAS unsigned char*)olds + (threadIdx.x >> 6) * 18944, threadIdx.x & 63); }
__global__ void __launch_bounds__(256) k_fill(unsigned char* ws) { const bf16* P = (const bf16*)(ws + WS_PROJ); bf16* O = (bf16*)(ws + WS_OATT);
    for (size_t i = (size_t)blockIdx.x * 256 + threadIdx.x; i < (size_t)M * 1024; i += (size_t)gridDim.x * 256) { const size_t row = i >> 10, c = i & 1023; O[row * 1024 + c] = P[row * PP + c]; } }
#endif
extern "C" void kernel_launch(void* const* d_in, const int* in_sizes, int n_in, void* d_out, int out_size, void* d_ws, size_t ws_size, hipStream_t stream) {
    static int grid = 0;
    if (grid == 0) {
        if (n_in != 19 || in_sizes[0] != M * D || out_size != M * D || ws_size < WS_END) { fprintf(stderr, "kernel_launch: unexpected shapes / workspace (n_in %d, ws %zu)\n", n_in, ws_size); grid = -1; return; }
        int dev = 0, cus = 0, per_cu = 0;
        if (hipGetDevice(&dev) != hipSuccess || hipDeviceGetAttribute(&cus, hipDeviceAttributeMultiprocessorCount, dev) != hipSuccess) { grid = -1; return; }
        if (hipFuncSetAttribute((const void*)mk_fwd, hipFuncAttributeMaxDynamicSharedMemorySize, LDS_BYTES) != hipSuccess) { fprintf(stderr, "kernel_launch: hipFuncSetAttribute failed\n"); grid = -1; return; }
        if (hipOccupancyMaxActiveBlocksPerMultiprocessor(&per_cu, (const void*)mk_fwd, NWAVES * 64, LDS_BYTES) != hipSuccess || per_cu < 1) { fprintf(stderr, "kernel_launch: occupancy query says %d\n", per_cu); }
        (void)hipGetLastError();
        grid = cus;
    }
    if (grid < 0) return;
    (void)hipMemsetAsync((char*)d_ws + WS_CTL, 0, CTL_ZERO_BYTES, stream);
    Args a{};
    for (int i = 0; i < 19; ++i) a.in[i] = (const float*)d_in[i];
    a.out = (float*)d_out; a.ws = (unsigned char*)d_ws; a.rem = ((M / 256) * (2 * FF / 256)) % grid;
#if defined(MK_DEBUG_KERNELS) && defined(CHECK_MODE)
    for (int g = 0; g <= CHECK_UPTO; ++g) { a.lo = g; a.hi = g + 1; hipLaunchKernelGGL(mk_fwd, dim3(grid), dim3(NWAVES * 64), LDS_BYTES, stream, a);
        if (g >= 1 && (g - 1) % NPH_LAYER == 4) hipLaunchKernelGGL(k_fill, dim3(2048), dim3(256), 0, stream, a.ws); }
    a.lo = 0; a.hi = 0;
    hipLaunchKernelGGL(k_check, dim3(512), dim3(256), 0, stream, a, (int)CHECK_MODE, 0);
    hipLaunchKernelGGL(k_report, dim3(2048), dim3(256), 0, stream, a.ws, a.out);
#elif MK_N_LAUNCHES == 1 || !defined(MK_DEBUG_KERNELS)
    a.lo = 0; a.hi = NPHASE;
    hipLaunchKernelGGL(mk_fwd, dim3(grid), dim3(NWAVES * 64), LDS_BYTES, stream, a);
#else
    for (int g = 0; g < NPHASE; ++g) { a.lo = g; a.hi = g + 1; hipLaunchKernelGGL(mk_fwd, dim3(grid), dim3(NWAVES * 64), LDS_BYTES, stream, a);
        if (ORACLE_MASK && ((PHASE_MASK >> 4) & 1) && g >= 1 && (g - 1) % NPH_LAYER == 4) { const int L = (g - 1) / NPH_LAYER;
            if (ORACLE_MASK & 8) hipLaunchKernelGGL(k_fill, dim3(2048), dim3(256), 0, stream, a.ws);
            if (ORACLE_MASK & 1) hipLaunchKernelGGL(k_oracle_A, dim3(4096), dim3(256), 0, stream, a.ws);
            if ((ORACLE_MASK & 2) && !FAST_B) hipLaunchKernelGGL(k_oracle_B, dim3(4096), dim3(256), 0, stream, a.ws, a.in[9], a.in[10], L);
            if (ORACLE_MASK & 4) hipLaunchKernelGGL(k_oracle_C, dim3(4096), dim3(128), 2 * 18944, stream, a.ws); } }
#endif
}
```

```cpp
#include <hip/hip_runtime.h>
#include <cstdio>
#include <cstdint>
#include <cmath>
#ifndef MK_N_LAUNCHES
#define MK_N_LAUNCHES 1
#endif
namespace pg8 {
#define PG8_LAS __attribute__((address_space(3)))
typedef unsigned short bf16_t;
typedef short bf16x8 __attribute__((ext_vector_type(8)));
typedef float f32x4 __attribute__((ext_vector_type(4)));
typedef unsigned u32x4 __attribute__((ext_vector_type(4)));
typedef unsigned u32x2 __attribute__((ext_vector_type(2)));
constexpr int BM = 256, BK = 64, HALF = 128, HTB = HALF * BK * 2  , STAGE_BYTES = 8 * HTB, NXCD = 8, WGM = 8;

__host__ __device__ __forceinline__ int lds_byte(int r, int c) { const int st = (r >> 4) * 2 + (c >> 5), rr = r & 15, cc = c & 31, ob = rr * 64 + cc * 2; return st * 1024 + (ob ^ (((ob >> 9) & 1) << 5)); }
__host__ __device__ __forceinline__ void stage_rc(int b, int& R, int& C) { const int st = b / 1024, sb = b % 1024, swz = sb ^ (((sb >> 9) & 1) << 5); R = (st >> 1) * 16 + swz / 64; C = (st & 1) * 32 + (swz % 64) / 2; }
__host__ __device__ __forceinline__ int perm32(int rho) { const int n = rho >> 4, i = rho & 15; return 8 * (i >> 2) + 4 * n + (i & 3); }

struct Unit { int pm, pn; };
struct Gemm { const bf16_t* A; const bf16_t* Bt; int M, N, K, lda; };

struct StaticOrder {
    int nM, nN, nwg, G, c;
    __host__ __device__ void init(int M, int N, int G_, int c_) { nM = M / BM; nN = N / BM; nwg = nM * nN; G = G_; c = c_; }
    __host__ __device__ bool next(int i, Unit& u) const {
        const long L = (long)i * G + c; if (L >= nwg) return false;
        int wgid = (int)L; { const int q = nwg / NXCD, r = nwg % NXCD, xcd = wgid % NXCD, off = wgid / NXCD; wgid = (xcd < r ? xcd * (q + 1) : r * (q + 1) + (xcd - r) * q) + off; }
        const int nig = WGM * nN, gid = wgid / nig, fm = gid * WGM, gsz = (nM - fm) < WGM ? (nM - fm) : WGM;
        u.pm = fm + ((wgid % nig) % gsz); u.pn = (wgid % nig) / gsz; return true;
    }
    __device__ __forceinline__ void a_ready(const Unit&) const {}
    __device__ __forceinline__ void done(const Unit&) const {}
};
#ifndef QKV_F8MASK
#define QKV_F8MASK 0x803Fu
#endif
template <bool F8SET> struct SubsetOrder {
    int nM, nN, nwg, G, c;
    static constexpr unsigned MASK = F8SET ? (QKV_F8MASK & 0x7FFFFu) : (~QKV_F8MASK & 0x7FFFFu);
    static constexpr int LEN = __builtin_popcount(MASK);
    __host__ __device__ static int map(int p) { int cnt = 0, res = 0;
        _Pragma("unroll") for (int t = 0; t < 19; ++t) if ((MASK >> t) & 1u) { res = (cnt == p) ? t : res; ++cnt; }
        return res; }
    __host__ __device__ void init(int M, int G_, int c_) { nM = M / BM; nN = LEN; nwg = nM * nN; G = G_; c = c_; }
    __host__ __device__ bool next(int i, Unit& u) const {
        const long L = (long)i * G + c; if (L >= nwg) return false;
        int wgid = (int)L; { const int q = nwg / NXCD, r = nwg % NXCD, xcd = wgid % NXCD, off = wgid / NXCD; wgid = (xcd < r ? xcd * (q + 1) : r * (q + 1) + (xcd - r) * q) + off; }
        const int nig = WGM * nN, gid = wgid / nig, fm = gid * WGM, gsz = (nM - fm) < WGM ? (nM - fm) : WGM;
        u.pm = fm + ((wgid % nig) % gsz); u.pn = map((wgid % nig) / gsz); return true;
    }
    __device__ __forceinline__ void a_ready(const Unit&) const {}
    __device__ __forceinline__ void done(const Unit&) const {}
};

typedef float f32x2_t __attribute__((ext_vector_type(2))); typedef __bf16 bf16x2_t __attribute__((ext_vector_type(2)));
__device__ __forceinline__ unsigned cvt_pk_bf16(float lo, float hi) { f32x2_t v = {lo, hi}; bf16x2_t b = __builtin_convertvector(v, bf16x2_t); return __builtin_bit_cast(unsigned, b); }

__device__ __forceinline__ int hw_lane() { int l; asm volatile("v_mbcnt_lo_u32_b32 %0, -1, 0\n\tv_mbcnt_hi_u32_b32 %0, -1, %0" : "=v"(l)); return l; }
typedef int v4i_t_ __attribute__((ext_vector_type(4))); typedef int v8i_t_ __attribute__((ext_vector_type(8)));
__device__ __forceinline__ v8i_t_ cat8(bf16x8 a, bf16x8 b) { const v4i_t_ x = __builtin_bit_cast(v4i_t_, a), y = __builtin_bit_cast(v4i_t_, b); return __builtin_shufflevector(x, y, 0, 1, 2, 3, 4, 5, 6, 7); }
template <class Epi, class Sched, bool ALIGN_EPI = false, bool SP2 = false, bool FP8 = false>
__device__ __forceinline__ void gemm_phase(PG8_LAS unsigned char* lds, const Gemm g, const Sched& S, const Epi& E, int wave_) {
    int tid_ = wave_ * 64 + hw_lane();
    const int tid = tid_, wid = __builtin_amdgcn_readfirstlane(tid >> 6), lane = tid & 63, wr = wid >> 2, wc = wid & 3, fr = lane & 15, fq = lane >> 4;
    const int K = g.K, nt = K / BK, lda = g.lda;
    unsigned voffA[2], voffB[2];
#pragma unroll
    for (int i = 0; i < 2; ++i) { int R, C; stage_rc(tid * 16 + i * 8192, R, C); const int Rb = Epi::PERM ? ((R & ~31) + perm32(R & 31)) : R;
        voffA[i] = (unsigned)(R * lda + C) * 2u; voffB[i] = (unsigned)(Rb * K + C) * 2u; }
    const size_t kstep = (size_t)(BK * 2);
    const size_t hstepA = (size_t)HALF * lda * 2, hstepB = (size_t)HALF * K * 2;
    const size_t tstepA = 2 * hstepA, tstepB = 2 * hstepB;
    const unsigned ldsw = (unsigned)wid * 1024u;
    const int aoff = lds_byte(wr * 64 + fr, fq * 8), boff = lds_byte(wc * 32 + fr, fq * 8);
#define PG8_SA(b, h) (((b) * 2 + (h)) * HTB)
#define PG8_SB(b, h) ((4 + (b) * 2 + (h)) * HTB)
#define PG8_STAGE(bufoff, gbase, voff) do { _Pragma("unroll") for (int _i = 0; _i < 2; ++_i) { unsigned vo_ = (voff)[_i]; if constexpr (FP8) asm volatile("" : "+v"(vo_));     \
        __builtin_amdgcn_global_load_lds((const unsigned*)((const char*)(gbase) + vo_), (PG8_LAS unsigned*)(lds + (bufoff) + ldsw + _i * 8192), 16, 0, 0); } } while (0)
#define PG8_LDA(dst, b, h) do { _Pragma("unroll") for (int m = 0; m < 4; ++m) _Pragma("unroll") for (int k = 0; k < 2; ++k) dst[m][k] = *(const PG8_LAS bf16x8*)(lds + PG8_SA(b, h) + aoff + m * 2048 + k * 1024); } while (0)
#define PG8_LDB(dst, b, h) do { _Pragma("unroll") for (int n = 0; n < 2; ++n) _Pragma("unroll") for (int k = 0; k < 2; ++k) dst[n][k] = *(const PG8_LAS bf16x8*)(lds + PG8_SB(b, h) + boff + n * 2048 + k * 1024); } while (0)
#define PG8_MMA(ai, bj, At, Bt) do { __builtin_amdgcn_s_setprio(1); _Pragma("unroll") for (int m = 0; m < 4; ++m) _Pragma("unroll") for (int n = 0; n < 2; ++n) { \
        if constexpr (FP8) acc[ai][bj][m][n] = __builtin_amdgcn_mfma_scale_f32_16x16x128_f8f6f4(cat8(Bt[n][0], Bt[n][1]), cat8(At[m][0], At[m][1]), acc[ai][bj][m][n], 0, 0, 0, 0x7f7f7f7f, 0, 0x7f7f7f7f); \
        else { _Pragma("unroll") for (int k = 0; k < 2; ++k) acc[ai][bj][m][n] = __builtin_amdgcn_mfma_f32_16x16x32_bf16(Bt[n][k], At[m][k], acc[ai][bj][m][n], 0, 0, 0); } } \
        __builtin_amdgcn_s_setprio(0); } while (0)
#define PG8_WAIT_V(n) asm volatile("s_waitcnt vmcnt(" #n ")" ::: "memory")
#define PG8_WAIT_L(n) asm volatile("s_waitcnt lgkmcnt(" #n ")" ::: "memory")
#define PG8_WAIT_VF() asm volatile("s_cmp_lg_u32 %0, 0\n\ts_cbranch_scc1 .Lpg8w%=\n\ts_waitcnt vmcnt(8)\n.Lpg8w%=:\n\ts_waitcnt vmcnt(%1)" :: "s"(fst), "n"(8 + Epi::NST) : "scc", "memory")
#define PG8_BAR __builtin_amdgcn_s_barrier()
#define PG8_SCHED __builtin_amdgcn_sched_barrier(0)
    Unit cur, nxt; int ui = 0;
    if (!S.next(0, cur)) return;
    f32x4 acc[2][2][4][2];
#pragma unroll
    for (int a = 0; a < 2; ++a)
#pragma unroll
        for (int b = 0; b < 2; ++b)
#pragma unroll
            for (int m = 0; m < 4; ++m)
#pragma unroll
                for (int n = 0; n < 2; ++n) acc[a][b][m][n] = (f32x4){0.f, 0.f, 0.f, 0.f};
    bf16x8 At[4][2], B0[2][2], B1[2][2];
    const char* cA = (const char*)g.A + (size_t)cur.pm * tstepA; const char* cB = (const char*)g.Bt + (size_t)cur.pn * tstepB;
    S.a_ready(cur);
    if constexpr (SP2) {
        PG8_STAGE(PG8_SB(0, 0), cB, voffB); PG8_STAGE(PG8_SB(0, 1), cB + hstepB, voffB); PG8_STAGE(PG8_SA(0, 0), cA, voffA); PG8_STAGE(PG8_SA(0, 1), cA + hstepA, voffA);
        if (wr == 1) PG8_BAR;
        PG8_WAIT_V(2); PG8_BAR;
        PG8_STAGE(PG8_SB(1, 0), cB + kstep, voffB); PG8_STAGE(PG8_SA(1, 0), cA + kstep, voffA); PG8_STAGE(PG8_SB(1, 1), cB + hstepB + kstep, voffB);
        PG8_WAIT_V(6); PG8_BAR;
    } else {
        PG8_STAGE(PG8_SB(0, 0), cB, voffB); PG8_STAGE(PG8_SA(0, 0), cA, voffA); PG8_STAGE(PG8_SB(0, 1), cB + hstepB, voffB); PG8_STAGE(PG8_SA(0, 1), cA + hstepA, voffA);
        if (wr == 1) PG8_BAR;
        PG8_WAIT_V(4); PG8_BAR;
        PG8_STAGE(PG8_SB(1, 0), cB + kstep, voffB); PG8_STAGE(PG8_SA(1, 0), cA + kstep, voffA); PG8_STAGE(PG8_SB(1, 1), cB + hstepB + kstep, voffB);
        PG8_WAIT_V(6); PG8_BAR;
    }
    for (;;) {
        const bool has_next = S.next(ui + 1, nxt);
        const char* nA = has_next ? (const char*)g.A + (size_t)nxt.pm * tstepA : cA; const char* nB = has_next ? (const char*)g.Bt + (size_t)nxt.pn * tstepB : cB;
        for (int t = 0; t < nt; t += 2) {
            const bool last = (t == nt - 2);
            const char* a1 = cA + (size_t)(t + 1) * kstep;
            const char* a2 = last ? nA : cA + (size_t)(t + 2) * kstep; const char* b2 = last ? nB : cB + (size_t)(t + 2) * kstep;
            const char* a3 = a2 + kstep; const char* b3 = b2 + kstep;
            if (last && has_next) S.a_ready(nxt);
            if constexpr (SP2) {
            const int fst = __builtin_amdgcn_readfirstlane(((t == 0) && (ui > 0)) ? 1 : 0);
            PG8_LDB(B0, 0, 0); PG8_LDB(B1, 0, 1); PG8_SCHED; PG8_LDA(At, 0, 0); PG8_STAGE(PG8_SA(1, 1), a1 + hstepA, voffA);
            PG8_WAIT_VF(); PG8_WAIT_L(0); PG8_BAR; PG8_MMA(0, 0, At, B0); PG8_MMA(0, 1, At, B1); PG8_BAR; PG8_SCHED;
            PG8_LDA(At, 0, 1); PG8_STAGE(PG8_SB(0, 0), b2, voffB); PG8_STAGE(PG8_SB(0, 1), b2 + hstepB, voffB); PG8_STAGE(PG8_SA(0, 0), a2, voffA);
            PG8_WAIT_VF(); PG8_WAIT_L(0); PG8_BAR; PG8_MMA(1, 0, At, B0); PG8_MMA(1, 1, At, B1); PG8_BAR; PG8_SCHED;
            PG8_LDB(B0, 1, 0); PG8_LDB(B1, 1, 1); PG8_SCHED; PG8_LDA(At, 1, 0); PG8_STAGE(PG8_SA(0, 1), a2 + hstepA, voffA);
            PG8_WAIT_V(8); PG8_WAIT_L(0); PG8_BAR; PG8_MMA(0, 0, At, B0); PG8_MMA(0, 1, At, B1); PG8_BAR; PG8_SCHED;
            PG8_LDA(At, 1, 1); PG8_STAGE(PG8_SB(1, 0), b3, voffB); PG8_STAGE(PG8_SB(1, 1), b3 + hstepB, voffB); PG8_STAGE(PG8_SA(1, 0), a3, voffA);
            PG8_WAIT_V(8); PG8_WAIT_L(0); PG8_BAR; PG8_MMA(1, 0, At, B0); PG8_MMA(1, 1, At, B1); PG8_BAR; PG8_SCHED;
            } else {
            PG8_LDB(B0, 0, 0); PG8_SCHED; PG8_LDA(At, 0, 0); PG8_STAGE(PG8_SA(1, 1), a1 + hstepA, voffA);
            PG8_WAIT_L(8); PG8_BAR; PG8_WAIT_L(0); PG8_MMA(0, 0, At, B0); PG8_BAR; PG8_SCHED;
            PG8_LDB(B1, 0, 1); PG8_STAGE(PG8_SB(0, 0), b2, voffB);
            PG8_BAR; PG8_WAIT_L(0); PG8_MMA(0, 1, At, B1); PG8_BAR;
            PG8_LDA(At, 0, 1); PG8_STAGE(PG8_SA(0, 0), a2, voffA);
            PG8_BAR; PG8_WAIT_L(0); PG8_MMA(1, 0, At, B0); PG8_BAR; PG8_SCHED;
            PG8_STAGE(PG8_SB(0, 1), b2 + hstepB, voffB);
            PG8_WAIT_V(6); PG8_BAR; PG8_MMA(1, 1, At, B1); PG8_BAR;
            PG8_LDB(B0, 1, 0); PG8_SCHED; PG8_LDA(At, 1, 0); PG8_STAGE(PG8_SA(0, 1), a2 + hstepA, voffA);
            PG8_WAIT_L(8); PG8_BAR; PG8_WAIT_L(0); PG8_MMA(0, 0, At, B0); PG8_BAR; PG8_SCHED;
            PG8_LDB(B1, 1, 1); PG8_STAGE(PG8_SB(1, 0), b3, voffB);
            PG8_BAR; PG8_WAIT_L(0); PG8_MMA(0, 1, At, B1); PG8_BAR;
            PG8_LDA(At, 1, 1); PG8_STAGE(PG8_SA(1, 0), a3, voffA);
            PG8_BAR; PG8_WAIT_L(0); PG8_MMA(1, 0, At, B0); PG8_BAR; PG8_SCHED;
            PG8_STAGE(PG8_SB(1, 1), b3 + hstepB, voffB);
            PG8_WAIT_V(6); PG8_BAR; PG8_MMA(1, 1, At, B1); PG8_BAR;
            }
        }
        if constexpr (ALIGN_EPI) { if (wr == 0) PG8_BAR; }
        if constexpr (FP8) { int le_; asm volatile("v_mbcnt_lo_u32_b32 %0, -1, 0\n\tv_mbcnt_hi_u32_b32 %0, -1, %0" : "=v"(le_));
            E(acc, cur, wr, wc, le_ & 15, le_ >> 4); }
        else E(acc, cur, wr, wc, fr, fq);
        S.done(cur);
        if (!has_next) break;
#pragma unroll
        for (int a = 0; a < 2; ++a)
#pragma unroll
            for (int b = 0; b < 2; ++b)
#pragma unroll
                for (int m = 0; m < 4; ++m)
#pragma unroll
                    for (int n = 0; n < 2; ++n) acc[a][b][m][n] = (f32x4){0.f, 0.f, 0.f, 0.f};
        cur = nxt; cA = nA; cB = nB; ++ui;
        if constexpr (ALIGN_EPI) { if (wr == 1) PG8_BAR; }
    }
    PG8_WAIT_V(0);
    if constexpr (!ALIGN_EPI) { if (wr == 0) PG8_BAR; }
    PG8_BAR;
#undef PG8_SA
#undef PG8_SB
#undef PG8_STAGE
#undef PG8_LDA
#undef PG8_LDB
#undef PG8_MMA
#undef PG8_WAIT_V
#undef PG8_WAIT_L
#undef PG8_WAIT_VF
#undef PG8_BAR
#undef PG8_SCHED
}
}
using pg8::hw_lane;
template <class T> __device__ __forceinline__ T mk_shfl(T v, int src) { static_assert(sizeof(T) == 4, "32-bit only"); return __builtin_bit_cast(T, __builtin_amdgcn_ds_bpermute(src << 2, __builtin_bit_cast(int, v))); }
template <class T> __device__ __forceinline__ T mk_shfl_xor(T v, int m) { static_assert(sizeof(T) == 4, "32-bit only"); return __builtin_bit_cast(T, __builtin_amdgcn_ds_bpermute((hw_lane() ^ m) << 2, __builtin_bit_cast(int, v))); }
#define __shfl mk_shfl
#define __shfl_xor mk_shfl_xor
namespace epi {
using pg8::f32x4; using pg8::u32x4; using pg8::u32x2; using pg8::Unit; using pg8::bf16_t; using pg8::cvt_pk_bf16;
constexpr int MROWS = 16384;
constexpr float RMS_EPS = 1e-6f;
__device__ __forceinline__ float bflo(unsigned u) { return __uint_as_float(u << 16); }
__device__ __forceinline__ float bfhi(unsigned u) { return __uint_as_float(u & 0xffff0000u); }
__device__ __forceinline__ void st16_wt(void* p, u32x4 v) { asm volatile("global_store_dwordx4 %0, %1, off sc1\n\ts_nop 1" :: "v"(p), "v"(v) : "memory");     }
__device__ __forceinline__ void st8_wt(void* p, u32x2 v) { asm volatile("global_store_dwordx2 %0, %1, off sc1\n\ts_nop 1" :: "v"(p), "v"(v) : "memory"); }
__device__ __forceinline__ void st4_wt(void* p, int v) { asm volatile("global_store_dword %0, %1, off sc1\n\ts_nop 1" :: "v"(p), "v"(v) : "memory"); }
__device__ __forceinline__ float xsum16(float a) { const unsigned u = __builtin_bit_cast(unsigned, a); const auto q = __builtin_amdgcn_permlane16_swap(u, u, false, false); return __uint_as_float((unsigned)q[0]) + __uint_as_float((unsigned)q[1]); }
__device__ __forceinline__ float xsum32(float a) { const unsigned u = __builtin_bit_cast(unsigned, a); const auto q = __builtin_amdgcn_permlane32_swap(u, u, false, false); return __uint_as_float((unsigned)q[0]) + __uint_as_float((unsigned)q[1]); }
__device__ __forceinline__ void row_rs8(const float* rowss, int row0, int fq, float (&r)[2][4]) {
#pragma unroll
    for (int ai = 0; ai < 2; ++ai) { f32x4 v[4];
#pragma unroll
        for (int m = 0; m < 4; ++m) v[m] = *(const f32x4*)(rowss + (size_t)(row0 + ai * 128 + m * 16) * 16 + 4 * fq);
        asm volatile("" : "+v"(v[0]), "+v"(v[1]), "+v"(v[2]), "+v"(v[3]));
#pragma unroll
        for (int m = 0; m < 4; ++m) { const f32x4 t = v[m]; float a = (t[0] + t[1]) + (t[2] + t[3]); a = xsum16(a); a = xsum32(a); r[ai][m] = __builtin_amdgcn_rsqf(a * (1.0f / 1024.0f) + RMS_EPS); } }
}
__device__ __forceinline__ float sigmoidf_(float v) { return __builtin_amdgcn_rcpf(1.0f + __builtin_amdgcn_exp2f(-1.4426950408889634f * v)); }

struct EpiSwiGLU {
    static constexpr int NST = 8;
    static constexpr bool PERM = true;
    bf16_t* H; int ldh; const float* rowss; float post  ;
    __device__ __forceinline__ void operator()(const f32x4 (&acc)[2][2][4][2], const Unit& u, int wr, int wc, int fr_, int fq_) const {
        int fr = fr_, fq = fq_; asm volatile("" : "+v"(fr), "+v"(fq));
        const int row0 = u.pm * 256 + wr * 64 + fr, col0 = u.pn * 128 + wc * 32 + 8 * fq;
        float rs[2][4]; row_rs8(rowss, row0, fq, rs);
#pragma unroll
        for (int ai = 0; ai < 2; ++ai)
#pragma unroll
            for (int m = 0; m < 4; ++m) { const int row = row0 + ai * 128 + m * 16; const float r = rs[ai][m] * post;
                float h[8];
#pragma unroll
                for (int n = 0; n < 2; ++n)
#pragma unroll
                    for (int i = 0; i < 4; ++i) { const float g = acc[ai][0][m][n][i] * r, up = acc[ai][1][m][n][i] * r; h[n * 4 + i] = g * sigmoidf_(g) * up; }
                u32x4 w; w.x = cvt_pk_bf16(h[0], h[1]); w.y = cvt_pk_bf16(h[2], h[3]); w.z = cvt_pk_bf16(h[4], h[5]); w.w = cvt_pk_bf16(h[6], h[7]);
                st16_wt(H + (size_t)row * ldh + col0, w); }
    }
};

struct EpiResidual {
    static constexpr int NST = 32;
    static constexpr bool PERM = false;
    float* out; bf16_t* xb; float* rowss; unsigned char* x8  ; float scale;
    __device__ __forceinline__ void operator()(const f32x4 (&acc)[2][2][4][2], const Unit& u, int wr, int wc, int fr, int fq) const {
        const int row0 = u.pm * 256 + wr * 64 + fr, col0 = u.pn * 256 + wc * 32 + 4 * fq;
        u32x2 nb[2][2];
#pragma unroll
        for (int bj = 0; bj < 2; ++bj)
#pragma unroll
            for (int n = 0; n < 2; ++n) nb[bj][n] = *(const u32x2*)(xb + (size_t)row0 * 1024 + col0 + bj * 128 + n * 16);
#pragma unroll
        for (int g = 0; g < 8; ++g) { const int ai = g >> 2, m = g & 3; const int row = row0 + ai * 128 + m * 16; const size_t off = (size_t)row * 1024 + col0; float ss = 0.f;
            u32x2 cb[2][2];
#pragma unroll
            for (int bj = 0; bj < 2; ++bj)
#pragma unroll
                for (int n = 0; n < 2; ++n) cb[bj][n] = nb[bj][n];
            if (g < 7) { const int g2 = g + 1; const size_t off2 = (size_t)(row0 + (g2 >> 2) * 128 + (g2 & 3) * 16) * 1024 + col0;
#pragma unroll
                for (int bj = 0; bj < 2; ++bj)
#pragma unroll
                    for (int n = 0; n < 2; ++n) nb[bj][n] = *(const u32x2*)(xb + off2 + bj * 128 + n * 16); }
#pragma unroll
            for (int bj = 0; bj < 2; ++bj)
#pragma unroll
                for (int n = 0; n < 2; ++n) { const u32x2 c = cb[bj][n];
                    f32x4 o; o[0] = __uint_as_float(c.x << 16); o[1] = __uint_as_float(c.x & 0xffff0000u); o[2] = __uint_as_float(c.y << 16); o[3] = __uint_as_float(c.y & 0xffff0000u);
                    o = o + acc[ai][bj][m][n] * scale;
                    u32x2 w; w.x = cvt_pk_bf16(o[0], o[1]); w.y = cvt_pk_bf16(o[2], o[3]);
                    *(u32x2*)(xb + off + bj * 128 + n * 16) = w;
                    o[0] = __uint_as_float(w.x << 16); o[1] = __uint_as_float(w.x & 0xffff0000u); o[2] = __uint_as_float(w.y << 16); o[3] = __uint_as_float(w.y & 0xffff0000u);
                    if (out != nullptr) *(f32x4*)(out + off + bj * 128 + n * 16) = o;
                    if (x8 != nullptr) { int q8 = __builtin_amdgcn_cvt_pk_fp8_f32(o[0], o[1], 0, false); q8 = __builtin_amdgcn_cvt_pk_fp8_f32(o[2], o[3], q8, true); *(int*)(x8 + off + bj * 128 + n * 16) = q8; }
                    ss += (o[0] * o[0] + o[1] * o[1]) + (o[2] * o[2] + o[3] * o[3]); }
            ss = xsum16(ss); ss = xsum32(ss);
            if (fq == 0) rowss[(size_t)row * 16 + (u.pn * 4 + wc)] = ss; }
    }
};

struct EpiQKV {
    static constexpr int NST = 16;
    static constexpr bool PERM = true;
    bf16_t* P; int ldp; const float* rowss; const float* qk_gain  ; float* widx; float ascale  ;
    __device__ __forceinline__ void operator()(const f32x4 (&acc)[2][2][4][2], const Unit& u, int wr, int wc, int fr_, int fq_) const {
        int fr = fr_, fq = fq_; asm volatile("" : "+v"(fr), "+v"(fq));
        const int hidx = 4 * u.pn + wc;
        int gi = -1; float post = 1.0f;
        constexpr float C2 = 0.125f * 1.4426950408889634f;
        if (hidx < 12) { gi = 0; post = C2; } else if (hidx < 24) { gi = 1; } else if (hidx < 36) { }
        else if (hidx < 44) { gi = 2; post = C2; } else if (hidx < 52) { gi = 3; } else if (hidx < 60) { }
        else if (hidx < 64) { gi = 4; post = C2; } else if (hidx == 64) { gi = 5; } else if (hidx == 65) { }
        else if (hidx < 74) { post = 0.125f; }
        f32x4 gn[2][2];
#pragma unroll
        for (int bj = 0; bj < 2; ++bj)
#pragma unroll
            for (int n = 0; n < 2; ++n) gn[bj][n] = (gi >= 0) ? *(const f32x4*)(qk_gain + gi * 64 + 32 * bj + 8 * fq + 4 * n) : (f32x4){1.f, 1.f, 1.f, 1.f};
        const int row0 = u.pm * 256 + wr * 64 + fr, col0 = 64 * hidx + 8 * fq;
        float rs[2][4]; row_rs8(rowss, row0, fq, rs);
#pragma unroll
        for (int ai = 0; ai < 2; ++ai)
#pragma unroll
            for (int m = 0; m < 4; ++m) { const int row = row0 + ai * 128 + m * 16; const float r = rs[ai][m] * ascale;
                f32x4 v[2][2]; float ss = 0.f;
#pragma unroll
                for (int bj = 0; bj < 2; ++bj)
#pragma unroll
                    for (int n = 0; n < 2; ++n) { v[bj][n] = acc[ai][bj][m][n] * r; const f32x4 t = v[bj][n]; ss += (t[0] * t[0] + t[1] * t[1]) + (t[2] * t[2] + t[3] * t[3]); }
                float mul = post;
                if (gi >= 0) { ss = xsum16(ss); ss = xsum32(ss); mul = post * __builtin_amdgcn_rsqf(ss * (1.0f / 64.0f) + RMS_EPS); }
#pragma unroll
                for (int bj = 0; bj < 2; ++bj) { const f32x4 a = v[bj][0] * gn[bj][0] * mul, b = v[bj][1] * gn[bj][1] * mul;
                    u32x4 w; w.x = cvt_pk_bf16(a[0], a[1]); w.y = cvt_pk_bf16(a[2], a[3]); w.z = cvt_pk_bf16(b[0], b[1]); w.w = cvt_pk_bf16(b[2], b[3]);
                    st16_wt(P + (size_t)row * ldp + col0 + 32 * bj, w); }
                if (hidx == 75 && fq == 0) { *(f32x4*)(widx + (size_t)row * 8) = v[0][0]; *(f32x4*)(widx + (size_t)row * 8 + 4) = v[0][1]; } asm volatile("" ::: "memory"); }
    }
};

struct EpiSigmoid {
    static constexpr int NST = 16;
    static constexpr bool PERM = true;
    bf16_t* G; int ldg; const float* rowss; float post  ;
    __device__ __forceinline__ void operator()(const f32x4 (&acc)[2][2][4][2], const Unit& u, int wr, int wc, int fr_, int fq_) const {
        int fr = fr_, fq = fq_; asm volatile("" : "+v"(fr), "+v"(fq));
        const int row0 = u.pm * 256 + wr * 64 + fr, col0 = u.pn * 256 + wc * 32 + 8 * fq;
        float rs[2][4]; row_rs8(rowss, row0, fq, rs);
#pragma unroll
        for (int ai = 0; ai < 2; ++ai)
#pragma unroll
            for (int m = 0; m < 4; ++m) { const int row = row0 + ai * 128 + m * 16; const float r = rs[ai][m] * post;
#pragma unroll
                for (int bj = 0; bj < 2; ++bj) { float h[8];
#pragma unroll
                    for (int n = 0; n < 2; ++n)
#pragma unroll
                        for (int i = 0; i < 4; ++i) h[n * 4 + i] = sigmoidf_(acc[ai][bj][m][n][i] * r);
                    u32x4 w; w.x = cvt_pk_bf16(h[0], h[1]); w.y = cvt_pk_bf16(h[2], h[3]); w.z = cvt_pk_bf16(h[4], h[5]); w.w = cvt_pk_bf16(h[6], h[7]);
                    st16_wt(G + (size_t)row * ldg + col0 + bj * 128, w); } }
    }
};

struct EpiMerge {
    static constexpr int NST = 16;
    static constexpr bool PERM = true;
    bf16_t* Y; const bf16_t* G  ; int ldg; int accum;
    __device__ __forceinline__ void operator()(const f32x4 (&acc)[2][2][4][2], const Unit& u, int wr, int wc, int fr, int fq) const {
        const int row0 = u.pm * 256 + wr * 64 + fr, col0 = u.pn * 256 + wc * 32 + 8 * fq;
        u32x4 ng[2], ny[2];
#pragma unroll
        for (int bj = 0; bj < 2; ++bj) { ng[bj] = *(const u32x4*)(G + (size_t)row0 * ldg + col0 + bj * 128); ny[bj] = (u32x4){0u, 0u, 0u, 0u}; if (accum) ny[bj] = *(const u32x4*)(Y + (size_t)row0 * 1024 + col0 + bj * 128); }
#pragma unroll
        for (int g = 0; g < 8; ++g) { const int ai = g >> 2, m = g & 3; const int row = row0 + ai * 128 + m * 16;
            u32x4 cg[2], cy[2];
#pragma unroll
            for (int bj = 0; bj < 2; ++bj) { cg[bj] = ng[bj]; cy[bj] = ny[bj]; }
            if (g < 7) { const int row2 = row0 + ((g + 1) >> 2) * 128 + ((g + 1) & 3) * 16;
#pragma unroll
                for (int bj = 0; bj < 2; ++bj) { ng[bj] = *(const u32x4*)(G + (size_t)row2 * ldg + col0 + bj * 128); if (accum) ny[bj] = *(const u32x4*)(Y + (size_t)row2 * 1024 + col0 + bj * 128); } }
#pragma unroll
            for (int bj = 0; bj < 2; ++bj) { const u32x4 gv = cg[bj], yo = cy[bj];
                bf16_t* yp = Y + (size_t)row * 1024 + col0 + bj * 128;
                const f32x4 a = acc[ai][bj][m][0], b = acc[ai][bj][m][1];
                float h[8];
                h[0] = bflo(yo.x) + bflo(gv.x) * a[0]; h[1] = bfhi(yo.x) + bfhi(gv.x) * a[1]; h[2] = bflo(yo.y) + bflo(gv.y) * a[2]; h[3] = bfhi(yo.y) + bfhi(gv.y) * a[3];
                h[4] = bflo(yo.z) + bflo(gv.z) * b[0]; h[5] = bfhi(yo.z) + bfhi(gv.z) * b[1]; h[6] = bflo(yo.w) + bflo(gv.w) * b[2]; h[7] = bfhi(yo.w) + bfhi(gv.w) * b[3];
                u32x4 w; w.x = cvt_pk_bf16(h[0], h[1]); w.y = cvt_pk_bf16(h[2], h[3]); w.z = cvt_pk_bf16(h[4], h[5]); w.w = cvt_pk_bf16(h[6], h[7]);
                *(u32x4*)yp = w; } }
    }
};
}
constexpr int NWAVES = 8;
constexpr int M = 16384, D = 1024, FF = 2816, T = 4096, NLAYER = 4;
constexpr int NIN = 7880, PP = 4864  , NGATE = 3072, GATE_COL0 = 4808;
constexpr float LOG2E = 1.4426950408889634f;
constexpr size_t MiB = 1u << 20;
constexpr size_t WS_CTL = 0, CTL_ZERO_BYTES = 1 * MiB;
constexpr size_t WS_BIASD = 1 * MiB;
constexpr size_t WS_ROWSS = 1 * MiB + 512 * 1024;
constexpr size_t WS_WIDX = 2 * MiB + 512 * 1024;
constexpr size_t WS_TAU = 3 * MiB;
constexpr size_t WS_W = 4 * MiB;
constexpr size_t O_GU1 = 0, O_DN1 = 11534336, O_QKV = 17301504, O_GATE = 27262976, O_BA = 33554432, O_BB = 34078720, O_BC = 35127296, O_OUT = 35651584, O_GU2 = 37748736, O_DN2 = 49283072, O_WEND = 55050240;
constexpr size_t WS_XB = 57 * MiB, WS_OATT = 89 * MiB, WS_Y = 121 * MiB, WS_PROJ = 153 * MiB, WS_HMID = WS_PROJ, WS_GATES = 305 * MiB, WS_OB = WS_Y  , WS_SCORES = 305 * MiB  , WS_OAP = 434 * MiB, WS_MASK = 461 * MiB  , WS_X8 = 469 * MiB  , WS_QKV8 = 485 * MiB  , WS_END = 490 * MiB;
static_assert(WS_W + O_WEND <= WS_XB && WS_PROJ + (size_t)M * PP * 2 <= WS_GATES && WS_GATES + (size_t)M * NGATE * 2 <= WS_END && WS_SCORES + 4 * (size_t)8454144 * 4 <= WS_OAP, "ws map");
constexpr int CW_TMO = 0, CW_CODE = 1, CW_BAR = 4096;

constexpr int RING_OFF = 0, RING_BYTES = 131072;
constexpr int MISC_OFF = 160768, LDS_BYTES = 161792;

#define GAS __attribute__((address_space(1)))
#define LAS __attribute__((address_space(3)))
typedef unsigned short bf16;
typedef unsigned v4u __attribute__((ext_vector_type(4)));
typedef unsigned v2u __attribute__((ext_vector_type(2)));
typedef float f32x4 __attribute__((ext_vector_type(4)));
typedef GAS unsigned gu32;
#define RLX_AGENT __ATOMIC_RELAXED, __HIP_MEMORY_SCOPE_AGENT
#define LDS_WAIT() asm volatile("s_waitcnt lgkmcnt(0)" ::: "memory")
#define VM_WAIT() asm volatile("s_waitcnt vmcnt(0)" ::: "memory")
__device__ __forceinline__ float bflo(unsigned u) { return __uint_as_float(u << 16); }
__device__ __forceinline__ float bfhi(unsigned u) { return __uint_as_float(u & 0xffff0000u); }
__device__ __forceinline__ unsigned f2bf(float f) { unsigned u = __builtin_bit_cast(unsigned, f); return (u + 0x7fffu + ((u >> 16) & 1u)) >> 16; }
__device__ __forceinline__ unsigned pk2(float lo, float hi) { return f2bf(lo) | (f2bf(hi) << 16); }
__device__ __forceinline__ float wave_sum(float v) {
#pragma unroll
    for (int o = 1; o < 64; o <<= 1) v += __shfl_xor(v, o);
    return v;
}
__device__ __forceinline__ float wave_max(float v) {
#pragma unroll
    for (int o = 1; o < 64; o <<= 1) v = fmaxf(v, __shfl_xor(v, o));
    return v;
}
__device__ __forceinline__ float dot8(v4u a, v4u b) {
    return ((bflo(a.x) * bflo(b.x) + bfhi(a.x) * bfhi(b.x)) + (bflo(a.y) * bflo(b.y) + bfhi(a.y) * bfhi(b.y))) + ((bflo(a.z) * bflo(b.z) + bfhi(a.z) * bfhi(b.z)) + (bflo(a.w) * bflo(b.w) + bfhi(a.w) * bfhi(b.w)));
}
__device__ __forceinline__ float dot64(const v4u (&q)[8], const bf16* kp) {
    const v4u* k = (const v4u*)kp; float s = 0.f;
#pragma unroll
    for (int i = 0; i < 8; ++i) s += dot8(q[i], k[i]);
    return s;
}
__device__ __forceinline__ int rel_bucket(int n) {
    if (n < 16) return n;
    int b = 16 + (int)(logf((float)n / 16.0f) / logf(128.0f) * 16.0f);
    return b < 31 ? b : 31;
}

struct Args { const float* in[19]; float* out; unsigned char* ws; int lo, hi, rem; };
struct Frame {
    LAS unsigned char* lds;
    volatile LAS unsigned* MISC;
    int tid, lane, wave, G, bx;
};

__device__ __forceinline__ void phase_prologue(Frame& F, const Args& A) {
    float* biasd = (float*)(A.ws + WS_BIASD); const float* rel_bias = A.in[1];
    const int plane = hw_lane(), ptid = F.wave * 64 + plane;
    for (int i = F.bx * 512 + ptid; i < 20 * 4096; i += F.G * 512) { const int h = i >> 12, d = i & 4095; biasd[i] = rel_bias[rel_bucket(d) * 20 + h] * LOG2E; }
    const float* x = A.in[0]; bf16* xb = (bf16*)(A.ws + WS_XB); float* rowss = (float*)(A.ws + WS_ROWSS);
    const int gw = F.bx * NWAVES + F.wave, NGW = F.G * NWAVES;
    for (int m = gw; m < M; m += NGW) {
        const f32x4* xr = (const f32x4*)(x + (size_t)m * D) + plane; float s = 0.f;
        unsigned long long* o8 = (unsigned long long*)(xb + (size_t)m * D) + plane;
#pragma unroll
        for (int j = 0; j < 4; ++j) { const f32x4 v = xr[64 * j]; s += (v.x * v.x + v.y * v.y) + (v.z * v.z + v.w * v.w);
            o8[64 * j] = (unsigned long long)pk2(v.x, v.y) | ((unsigned long long)pk2(v.z, v.w) << 32); }
        s = wave_sum(s);
        if (plane < 16) rowss[(size_t)m * 16 + plane] = (plane == 0) ? s : 0.f;
    }
}

typedef unsigned v2u_ __attribute__((ext_vector_type(2)));
__device__ __forceinline__ void cvt_item(const float* W, int ldw, int scol, bool valid, const float* gamma, bf16* WT, int K, int dstrow0, int k0, LAS unsigned char* scr, int lane, bool fp8 = false, float wscale = 1.0f) {
    const int n4 = lane & 31, kp = lane >> 5;
    const float* wp = W + (size_t)(k0 + 2 * kp) * ldw + scol;
    const float vs = valid ? wscale : 0.0f;
    LAS unsigned char* wa = scr + n4 * 528 + kp * 128;
#pragma unroll
    for (int hb = 0; hb < 2; ++hb) {
        f32x4 v0[8], v1[8]; float2 gm[8];
#pragma unroll
        for (int ii = 0; ii < 8; ++ii) { const int i = 8 * hb + ii; v0[ii] = *(const f32x4*)(wp + (size_t)(4 * i) * ldw); v1[ii] = *(const f32x4*)(wp + (size_t)(4 * i + 1) * ldw);
            gm[ii] = gamma ? *(const float2*)(gamma + k0 + 4 * i + 2 * kp) : make_float2(1.0f, 1.0f); }
#pragma unroll
        for (int ii = 0; ii < 8; ++ii) { const int i = 8 * hb + ii; const float g0 = gm[ii].x * vs, g1 = gm[ii].y * vs;
            v4u p; p.x = pk2(v0[ii].x * g0, v1[ii].x * g1); p.y = pk2(v0[ii].y * g0, v1[ii].y * g1); p.z = pk2(v0[ii].z * g0, v1[ii].z * g1); p.w = pk2(v0[ii].w * g0, v1[ii].w * g1);
            *(LAS v4u*)(wa + (i & 1) * 256 + (i >> 1) * 16) = p; }
    }
    LDS_WAIT(); asm volatile("" ::: "memory");
    const int c = lane & 7, m = lane >> 3;
    const LAS unsigned char* ra = scr + m * 528 + c * 16;
#pragma unroll
    for (int r = 0; r < 4; ++r) {
        const v4u r0 = *(const LAS v4u*)(ra + r * 4224), r1 = *(const LAS v4u*)(ra + r * 4224 + 128), r2 = *(const LAS v4u*)(ra + r * 4224 + 256), r3 = *(const LAS v4u*)(ra + r * 4224 + 384);
        if (!fp8) {
        bf16* op = WT + (size_t)(dstrow0 + 4 * (m + 8 * r)) * K + k0 + 8 * c;
        *(v4u*)(op) = (v4u){r0.x, r1.x, r2.x, r3.x}; *(v4u*)(op + K) = (v4u){r0.y, r1.y, r2.y, r3.y};
        *(v4u*)(op + 2 * (size_t)K) = (v4u){r0.z, r1.z, r2.z, r3.z}; *(v4u*)(op + 3 * (size_t)K) = (v4u){r0.w, r1.w, r2.w, r3.w}; }
        else {
            unsigned char* op = (unsigned char*)WT + (size_t)(dstrow0 + 4 * (m + 8 * r)) * K + k0 + 8 * c;
            auto q4 = [](unsigned a, unsigned b) { int q = __builtin_amdgcn_cvt_pk_fp8_f32(__uint_as_float(a << 16), __uint_as_float(a & 0xffff0000u), 0, false);
                                                  return (unsigned)__builtin_amdgcn_cvt_pk_fp8_f32(__uint_as_float(b << 16), __uint_as_float(b & 0xffff0000u), q, true); };
            *(v2u_*)(op) = (v2u_){q4(r0.x, r1.x), q4(r2.x, r3.x)}; *(v2u_*)(op + K) = (v2u_){q4(r0.y, r1.y), q4(r2.y, r3.y)};
            *(v2u_*)(op + 2 * (size_t)K) = (v2u_){q4(r0.z, r1.z), q4(r2.z, r3.z)}; *(v2u_*)(op + 3 * (size_t)K) = (v2u_){q4(r0.w, r1.w), q4(r2.w, r3.w)}; } }
    LDS_WAIT(); asm volatile("" ::: "memory");
}
constexpr int CV_SETA0 = 0, CV_SETA1 = 1056, CV_SETA2 = 1664, CV_SETA3 = 2304;
constexpr int CV_SETB0 = 1056, CV_SETB1 = 1664, CV_SETB2 = 2304, CV_SETB3 = 3360;
__device__ __forceinline__ void phase_convert(Frame& F, const Args& A, int L, int a0, int a1, int b0, int b1, int gw, int NGW) {
    const int lane = hw_lane();
    LAS unsigned char* scr = F.lds + RING_OFF + F.wave * 17408;
    unsigned char* wb = A.ws + WS_W;
    const int n4 = lane & 31;
    constexpr int I0 = 704, I1 = 352, I2 = 608, I3 = 384, I4 = 32, I5 = 64, I6 = 32, I7 = 128, I8 = 704, I9 = 352;
    constexpr int NITEMS = I0 + I1 + I2 + I3 + I4 + I5 + I6 + I7 + I8 + I9;
    const int na = a1 - a0, ntot = na + (b1 - b0);
    for (int ix = gw; ix < ntot; ix += NGW) {
        int r = ix < na ? a0 + ix : b0 + (ix - na);
        if (r < I0 || (r >= I0 + I1 + I2 + I3 + I4 + I5 + I6 + I7 && r < NITEMS - I9)) {
            const bool second = r >= I0; if (second) r -= (I0 + I1 + I2 + I3 + I4 + I5 + I6 + I7);
            const int kb = r / 44, nb = r % 44, n0 = 128 * nb, tile = n0 >> 8, l = n0 & 255;
            const float* Wg = (second ? A.in[16] : A.in[3]) + (size_t)L * D * FF; const float* Wu = (second ? A.in[17] : A.in[4]) + (size_t)L * D * FF;
            const float* gam = (second ? A.in[15] : A.in[2]) + (size_t)L * D;
            cvt_item(l < 128 ? Wg : Wu, FF, 128 * tile + 4 * n4, true, gam, (bf16*)(wb + (second ? O_GU2 : O_GU1)), D, n0, 64 * kb, scr, lane, second, second ? 32.0f : 1.0f);
            continue; }
        r -= I0;
        if (r < I1) { const int kb = r / 8, nb = r % 8; cvt_item(A.in[5] + (size_t)L * FF * D, D, 128 * nb + 4 * n4, true, nullptr, (bf16*)(wb + O_DN1), FF, 128 * nb, 64 * kb, scr, lane); continue; } r -= I1;
        if (r < I2) { const int kb = r / 38, nb = r % 38, n0 = 128 * nb, tile = n0 >> 8, bj = (n0 & 255) >> 7, scol = 256 * tile + 32 * bj + 64 * (n4 >> 3) + 4 * (n4 & 7);
            const bool f8 = ((QKV_F8MASK >> tile) & 1u) != 0u;
            cvt_item(A.in[7] + (size_t)L * D * NIN, NIN, scol, scol < 4808, A.in[6] + (size_t)L * D, f8 ? (bf16*)(A.ws + WS_QKV8) : (bf16*)(wb + O_QKV), D, n0, 64 * kb, scr, lane, f8, f8 ? 32.0f : 1.0f); continue; } r -= I2;
        if (r < I3) { const int kb = r / 24, nb = r % 24; cvt_item(A.in[7] + (size_t)L * D * NIN, NIN, GATE_COL0 + 128 * nb + 4 * n4, true, A.in[6] + (size_t)L * D, (bf16*)(wb + O_GATE), D, 128 * nb, 64 * kb, scr, lane, true, 32.0f); continue; } r -= I3;
        if (r < I4) { const int kb = r / 8, nb = r % 8; cvt_item(A.in[11] + (size_t)L * 256 * D, D, 128 * nb + 4 * n4, true, nullptr, (bf16*)(wb + O_BA), 256, 128 * nb, 64 * kb, scr, lane); continue; } r -= I4;
        if (r < I5) { const int kb = r / 8, nb = r % 8; cvt_item(A.in[12] + (size_t)L * 512 * D, D, 128 * nb + 4 * n4, true, nullptr, (bf16*)(wb + O_BB), 512, 128 * nb, 64 * kb, scr, lane); continue; } r -= I5;
        if (r < I6) { const int kb = r / 8, nb = r % 8; cvt_item(A.in[13] + (size_t)L * 256 * D, D, 128 * nb + 4 * n4, true, nullptr, (bf16*)(wb + O_BC), 256, 128 * nb, 64 * kb, scr, lane); continue; } r -= I6;
        if (r < I7) { const int kb = r / 8, nb = r % 8; cvt_item(A.in[14] + (size_t)L * D * D, D, 128 * nb + 4 * n4, true, nullptr, (bf16*)(wb + O_OUT), D, 128 * nb, 64 * kb, scr, lane); continue; } r -= I7;
        r -= I8;
        { const int kb = r / 8, nb = r % 8; cvt_item(A.in[18] + (size_t)L * FF * D, D, 128 * nb + 4 * n4, true, nullptr, (bf16*)(wb + O_DN2), FF, 128 * nb, 64 * kb, scr, lane); }
    }
}

constexpr int COL_AQ = 0, COL_AK = 768, COL_AV = 1536, COL_BQ = 2304, COL_BK = 2816, COL_BV = 3328, COL_CQ = 3840, COL_CK = 4096, COL_CV = 4160, COL_IQ = 4224, COL_IK = 4736;
__device__ __forceinline__ void load_q(v4u (&q)[8], const bf16* p) {
#pragma unroll
    for (int i = 0; i < 8; ++i) q[i] = ((const v4u*)p)[i];
}
#ifdef MK_DEBUG_KERNELS
__device__ __forceinline__ void oracle_A(unsigned char* ws, int gw, int NGW, int lane) {
    const bf16* P = (const bf16*)(ws + WS_PROJ); const float* biasd = (const float*)(ws + WS_BIASD); bf16* O = (bf16*)(ws + WS_OATT);
    for (int it = gw; it < M * 4; it += NGW) {
        const int row = it >> 2, hs = it & 3, b = row >> 12, t = row & 4095;
        float mrun = -INFINITY, l = 0.f, o = 0.f;
        for (int g = 0; g < 3; ++g) {
            const int dil = (g == 0) ? 1 : (g == 1 ? 4 : 16), head = 4 * g + hs, i = t / dil, r = t % dil;
            v4u q[8]; load_q(q, P + (size_t)row * PP + COL_AQ + head * 64);
            const int jlo = (i - 128) < 0 ? 0 : (i - 128), nk = i - jlo + 1;
            for (int c0 = 0; c0 < nk; c0 += 64) {
                const int jj = c0 + lane; const bool valid = jj < nk; const int j = jlo + (valid ? jj : 0);
                const size_t krow = (size_t)b * T + (size_t)j * dil + r;
                float s = -INFINITY;
                if (valid) s = dot64(q, P + krow * PP + COL_AK + head * 64) + biasd[head * 4096 + (i - j) * dil];
                const float mnew = fmaxf(mrun, wave_max(s)); const float alpha = __builtin_amdgcn_exp2f(mrun - mnew);
                const float p = valid ? __builtin_amdgcn_exp2f(s - mnew) : 0.f;
                l = l * alpha + wave_sum(p); o *= alpha; mrun = mnew;
                const int kn = (nk - c0) < 64 ? (nk - c0) : 64;
                for (int kk = 0; kk < kn; ++kk) { const float pk = __shfl(p, kk); const size_t vrow = (size_t)b * T + (size_t)(jlo + c0 + kk) * dil + r;
                    o += pk * bflo((unsigned)P[vrow * PP + COL_AV + head * 64 + lane]); }
            }
        }
        O[(size_t)row * 1024 + hs * 64 + lane] = (bf16)f2bf(o / l);
    }
}
__device__ __forceinline__ void oracle_B_map(const bf16* P, const float* biasd, int row, int h, int mp, int lane, float& r0, float& r1) {
    const int b = row >> 12, t = row & 4095;
    v4u q[8]; load_q(q, P + (size_t)row * PP + COL_BQ + (mp * 4 + h) * 64);
    float mrun = -INFINITY, l = 0.f, o0 = 0.f, o1 = 0.f;
    for (int c0 = 0; c0 <= t; c0 += 64) {
        const int j = c0 + lane; const bool valid = j <= t; const size_t krow = (size_t)b * T + (valid ? j : 0);
        float s = -INFINITY;
        if (valid) s = dot64(q, P + krow * PP + COL_BK + (mp * 4 + h) * 64) + biasd[(12 + h) * 4096 + (t - j)];
        const float mnew = fmaxf(mrun, wave_max(s)); const float alpha = __builtin_amdgcn_exp2f(mrun - mnew);
        const float p = valid ? __builtin_amdgcn_exp2f(s - mnew) : 0.f;
        l = l * alpha + wave_sum(p); o0 *= alpha; o1 *= alpha; mrun = mnew;
        const int kn = (t + 1 - c0) < 64 ? (t + 1 - c0) : 64;
        for (int kk = 0; kk < kn; ++kk) { const float pk = __shfl(p, kk); const bf16* vp = P + ((size_t)b * T + c0 + kk) * PP + COL_BV + h * 128;
            o0 += pk * bflo((unsigned)vp[lane]); o1 += pk * bflo((unsigned)vp[64 + lane]); }
    }
    r0 = o0 / l; r1 = o1 / l;
}
__device__ __forceinline__ void oracle_B(unsigned char* ws, int gw, int NGW, const float* lv, const float* dn, int L, int lane) {
    const bf16* P = (const bf16*)(ws + WS_PROJ); const float* biasd = (const float*)(ws + WS_BIASD); bf16* O = (bf16*)(ws + WS_OATT);
    const float lam_init = 0.8f - 0.6f * expf(-0.3f * (float)L);
    const float lam = expf(wave_sum(lv[lane] * lv[64 + lane])) - expf(wave_sum(lv[128 + lane] * lv[192 + lane])) + lam_init;
    for (int it = gw; it < M * 4; it += NGW) {
        const int row = it >> 2, h = it & 3;
        float a0, a1, b0, b1;
        oracle_B_map(P, biasd, row, h, 0, lane, a0, a1);
        oracle_B_map(P, biasd, row, h, 1, lane, b0, b1);
        const float d0 = a0 - lam * b0, d1 = a1 - lam * b1;
        const float inv = __builtin_amdgcn_rsqf(wave_sum(d0 * d0 + d1 * d1) * (1.0f / 128.0f) + 1e-6f) * (1.0f - lam_init);
        O[(size_t)row * 1024 + 256 + h * 128 + lane] = (bf16)f2bf(d0 * inv * dn[lane]);
        O[(size_t)row * 1024 + 256 + h * 128 + 64 + lane] = (bf16)f2bf(d1 * inv * dn[64 + lane]);
    }
}
__device__ __forceinline__ void oracle_C(unsigned char* ws, int gw, int NGW, LAS unsigned char* ldsw, int lane) {
    const bf16* P = (const bf16*)(ws + WS_PROJ); const float* biasd = (const float*)(ws + WS_BIASD); bf16* O = (bf16*)(ws + WS_OATT);
    const float* widx = (const float*)(ws + WS_WIDX);
    LAS float* sc = (LAS float*)(ldsw);
    LAS unsigned short* sel = (LAS unsigned short*)(ldsw + 16384);
    LAS float* qi = (LAS float*)(ldsw + 16384 + 512);
    for (int row = gw; row < M; row += NGW) {
        const int b = row >> 12, t = row & 4095, N = t + 1;
#pragma unroll
        for (int i = 0; i < 8; ++i) qi[i * 64 + lane] = bflo((unsigned)P[(size_t)row * PP + COL_IQ + i * 64 + lane]);
        float w[8];
#pragma unroll
        for (int h = 0; h < 8; ++h) w[h] = widx[(size_t)row * 8 + h] * 0.35355339059327373f;
        LDS_WAIT();
#pragma unroll 1
        for (int c0 = 0; c0 < N; c0 += 64) {
            const int j = c0 + lane; const bool valid = j < N;
            const v4u* kp = (const v4u*)(P + ((size_t)b * T + (valid ? j : 0)) * PP + COL_IK);
            float dsum[8];
#pragma unroll
            for (int h = 0; h < 8; ++h) dsum[h] = 0.f;
#pragma unroll 2
            for (int i = 0; i < 8; ++i) { const v4u kv = kp[i];
                const float k0 = bflo(kv.x), k1 = bfhi(kv.x), k2 = bflo(kv.y), k3 = bfhi(kv.y), k4 = bflo(kv.z), k5 = bfhi(kv.z), k6 = bflo(kv.w), k7 = bfhi(kv.w);
#pragma unroll
                for (int h = 0; h < 8; ++h) { const f32x4 qa = *(const LAS f32x4*)(qi + h * 64 + i * 8), qb = *(const LAS f32x4*)(qi + h * 64 + i * 8 + 4);
                    dsum[h] += ((qa.x * k0 + qa.y * k1) + (qa.z * k2 + qa.w * k3)) + ((qb.x * k4 + qb.y * k5) + (qb.z * k6 + qb.w * k7)); } }
            float score = 0.f;
#pragma unroll
            for (int h = 0; h < 8; ++h) score += w[h] * fmaxf(dsum[h], 0.f);
            if (j < 4096) sc[j] = valid ? score : -INFINITY;
        }
        LDS_WAIT();
        int cnt = 0;
        if (N <= 256) { for (int n = lane; n < N; n += 64) sel[n] = (unsigned short)n; cnt = N; }
        else {
            const int N4 = (N + 3) & ~3;
#pragma unroll 1
            for (int c0 = 0; c0 < N; c0 += 64) {
                const int j = c0 + lane; const bool valid = j < N; const float sj = valid ? sc[j] : INFINITY;
                int rank = 0;
                for (int jp = 0; jp < N4; jp += 4) { const f32x4 v = *(const LAS f32x4*)(sc + jp);
                    rank += (v.x > sj || (v.x == sj && jp < j)) ? 1 : 0; rank += (v.y > sj || (v.y == sj && jp + 1 < j)) ? 1 : 0;
                    rank += (v.z > sj || (v.z == sj && jp + 2 < j)) ? 1 : 0; rank += (v.w > sj || (v.w == sj && jp + 3 < j)) ? 1 : 0; }
                const bool s = valid && rank < 256;
                const unsigned long long bal = __ballot(s);
                const int pos = cnt + __popcll(bal & ((1ull << lane) - 1ull));
                if (s && pos < 256) sel[pos] = (unsigned short)j;
                cnt += __popcll(bal);
            }
            cnt = cnt > 256 ? 256 : cnt;
        }
        LDS_WAIT();
#pragma unroll 1
        for (int h = 0; h < 4; ++h) {
            v4u q[8]; load_q(q, P + (size_t)row * PP + COL_CQ + h * 64);
            float s[4]; float mx = -INFINITY;
#pragma unroll
            for (int c = 0; c < 4; ++c) { const int n = lane + 64 * c; const bool valid = n < cnt; const int key = valid ? (int)sel[n] : 0;
                s[c] = valid ? dot64(q, P + ((size_t)b * T + key) * PP + COL_CK) + biasd[(16 + h) * 4096 + (t - key)] : -INFINITY; mx = fmaxf(mx, s[c]); }
            mx = wave_max(mx);
            float p[4], ls = 0.f;
#pragma unroll
            for (int c = 0; c < 4; ++c) { p[c] = (lane + 64 * c < cnt) ? __builtin_amdgcn_exp2f(s[c] - mx) : 0.f; ls += p[c]; }
            ls = wave_sum(ls);
            float o = 0.f;
#pragma unroll
            for (int c = 0; c < 4; ++c) { const int kn = (cnt - 64 * c) < 64 ? (cnt - 64 * c) : 64;
                for (int kk = 0; kk < kn; ++kk) { const float pk = __shfl(p[c], kk); const int key = (int)sel[64 * c + kk];
                    o += pk * bflo((unsigned)P[((size_t)b * T + key) * PP + COL_CV + lane]); } }
            O[(size_t)row * 1024 + 768 + h * 64 + lane] = (bf16)f2bf(o / ls);
        }
        LDS_WAIT();
    }
}

#endif
namespace fa {
typedef short bf16x8 __attribute__((ext_vector_type(8)));
typedef short v4i16_t __attribute__((ext_vector_type(4)));
typedef float f32x16 __attribute__((ext_vector_type(16)));
typedef unsigned u32x4 __attribute__((ext_vector_type(4)));
constexpr int KPITCH = 144;
constexpr int KSTAGE = 64 * KPITCH;
template <int NDB> struct Geo { static constexpr int VPITCH = (NDB == 4) ? 320 : 192, VSTAGE = 64 * VPITCH, OFF_K = 0, OFF_V = 2 * KSTAGE, OFF_BIAS = OFF_V + 2 * VSTAGE, LDS_END = OFF_BIAS + 16384; };
__device__ __forceinline__ float fma_s(float a, float b, float c) { float d; asm("v_fma_f32 %0, %1, %2, %3" : "=v"(d) : "v"(a), "v"(b), "v"(c)); return d; }
__device__ __forceinline__ float add_s(float a, float b) { float d; asm("v_add_f32 %0, %1, %2" : "=v"(d) : "v"(a), "v"(b)); return d; }
__device__ __forceinline__ int crow(int r, int hi) { return (r & 3) + 8 * (r >> 2) + 4 * hi; }

struct Unit {
    const bf16* P;
    int colQ, colK, colV;
    long rowbase;
    int stride, rofs;
    int qi0;
    int kt0, kt1;
    const float* biasd;
    const float* scores;
    const unsigned long long* mask;
    const float2* tau;
};

template <int NDB, int MODE>
__device__ __forceinline__ void run(LAS unsigned char* lds, const Unit& U, int tid, f32x16 (&o)[NDB], float& mrun_out, float& lsum_out) {
    typedef Geo<NDB> G;
    const int lane = tid & 63, wid = __builtin_amdgcn_readfirstlane(tid >> 6), q32 = lane & 31, hi = lane >> 5;
    { LAS float* bl = (LAS float*)(lds + G::OFF_BIAS);
#pragma unroll
      for (int i = 0; i < 2; ++i) { const f32x4 v = *(const f32x4*)(U.biasd + (tid + 512 * i) * 4); *(LAS f32x4*)(bl + (tid + 512 * i) * 4) = v; } }
    const int qi = U.qi0 + 32 * wid + q32;
    bf16x8 qr[4];
    { const bf16* qp = U.P + (size_t)(U.rowbase + (long)qi * U.stride + U.rofs) * PP + U.colQ + 8 * hi;
#pragma unroll
      for (int d0 = 0; d0 < 4; ++d0) qr[d0] = *(const bf16x8*)(qp + 16 * d0); }
#pragma unroll
    for (int db = 0; db < NDB; ++db)
#pragma unroll
        for (int r = 0; r < 16; ++r) o[db][r] = 0.f;
    float mrun = -1.0e30f, lsum = 0.f;
    float tauf = 0.f; int icut = 0; const float* srow = nullptr;
    if (MODE == 2) { const float2 tq = U.tau[qi]; tauf = tq.x; icut = __float_as_int(tq.y); const size_t bi = (size_t)(qi >> 5); srow = U.scores + 512 * bi * (bi + 1) + (size_t)(qi & 31) * 32 * (bi + 1); }
    const int krow = tid >> 3, kch = tid & 7;
    u32x4 kst; u32x4 vst[NDB / 2];
    auto load_tile = [&](int kt) {
        { const long pos = (long)(64 * kt + krow) * U.stride + U.rofs; kst = *(const u32x4*)(U.P + (size_t)(U.rowbase + pos) * PP + U.colK + 8 * kch); }
#pragma unroll
        for (int i = 0; i < NDB / 2; ++i) { const int idx = tid + 512 * i, vr = idx / (NDB * 4), vc = idx % (NDB * 4);
            const long pos = (long)(64 * kt + vr) * U.stride + U.rofs; vst[i] = *(const u32x4*)(U.P + (size_t)(U.rowbase + pos) * PP + U.colV + 8 * vc); }
    };
    auto store_tile = [&](int buf) {
        *(LAS u32x4*)(lds + G::OFF_K + buf * KSTAGE + krow * KPITCH + kch * 16) = kst;
#pragma unroll
        for (int i = 0; i < NDB / 2; ++i) { const int idx = tid + 512 * i, vr = idx / (NDB * 4), vc = idx % (NDB * 4);
            *(LAS u32x4*)(lds + G::OFF_V + buf * G::VSTAGE + vr * G::VPITCH + vc * 16) = vst[i]; }
    };
    load_tile(U.kt0); store_tile(0);
    __syncthreads();
    const LAS float* bl = (const LAS float*)(lds + G::OFF_BIAS);
    const int qlo = U.qi0 + 32 * wid, qhi = qlo + 31;
    for (int kt = U.kt0; kt < U.kt1; ++kt) {
        const int buf = (kt - U.kt0) & 1;
        if (kt + 1 < U.kt1) load_tile(kt + 1);
        const int k0 = 64 * kt;
        bool need = (k0 <= qhi);
        if (MODE == 1) need = need && (k0 + 63 >= qlo - 128);
        if (need) {
            f32x16 p0, p1;
#pragma unroll
            for (int r = 0; r < 16; ++r) { p0[r] = 0.f; p1[r] = 0.f; }
            const LAS unsigned char* kb = lds + G::OFF_K + buf * KSTAGE + q32 * KPITCH + hi * 16;
#pragma unroll
            for (int d0 = 0; d0 < 4; ++d0) {
                const bf16x8 ka = *(const LAS bf16x8*)(kb + d0 * 32), kc = *(const LAS bf16x8*)(kb + 32 * KPITCH + d0 * 32);
                p0 = __builtin_amdgcn_mfma_f32_32x32x16_bf16(ka, qr[d0], p0, 0, 0, 0);
                p1 = __builtin_amdgcn_mfma_f32_32x32x16_bf16(kc, qr[d0], p1, 0, 0, 0);
                if (d0 & 1) asm volatile("" ::: "memory");
            }
            const bool edge = (MODE == 2) || (k0 + 63 > qlo) || (MODE == 1 && k0 < qhi - 128 + 0);
            float mx = -INFINITY;
            f32x4 sc0[4], sc1[4];
            if (MODE == 2) {
#pragma unroll
                for (int rg = 0; rg < 4; ++rg) { sc0[rg] = *(const f32x4*)(srow + k0 + 8 * rg + 4 * hi); sc1[rg] = *(const f32x4*)(srow + k0 + 32 + 8 * rg + 4 * hi); } }
#pragma unroll
            for (int r = 0; r < 16; ++r) {
                const int j0 = k0 + crow(r, hi), j1 = j0 + 32; const int d0_ = qi - j0, d1_ = qi - j1;
                float b0 = bl[(d0_ < 0 ? 0 : d0_) * U.stride], b1 = bl[(d1_ < 0 ? 0 : d1_) * U.stride];
                float s0 = p0[r] + b0, s1 = p1[r] + b1;
                if (edge) { bool v0 = d0_ >= 0, v1 = d1_ >= 0; if (MODE == 1) { v0 = v0 && d0_ <= 128; v1 = v1 && d1_ <= 128; }
                    if (MODE == 2) { const float a0 = sc0[r >> 2][r & 3] + 0.0f, a1 = sc1[r >> 2][r & 3] + 0.0f;
                        v0 = v0 && (a0 > tauf || (a0 == tauf && j0 <= icut)); v1 = v1 && (a1 > tauf || (a1 == tauf && j1 <= icut)); }
                    s0 = v0 ? s0 : -INFINITY; s1 = v1 ? s1 : -INFINITY; }
                p0[r] = s0; p1[r] = s1; mx = fmaxf(mx, fmaxf(s0, s1));
                if ((r & 3) == 3) asm volatile("" ::: "memory");
            }
            mx = fmaxf(mx, __shfl_xor(mx, 32));
            const float mnew = fmaxf(mrun, mx);
            if (__any(mnew > mrun)) {
                const float alpha = __builtin_amdgcn_exp2f(mrun - mnew);
                lsum *= alpha;
#pragma unroll
                for (int r = 0; r < 16; ++r) { const float ar = __shfl(alpha, crow(r, hi));
#pragma unroll
                    for (int db = 0; db < NDB; ++db) o[db][r] *= ar; }
                mrun = mnew;
            }
            float ps = 0.f;
#pragma unroll
            for (int r = 0; r < 16; ++r) { p0[r] = __builtin_amdgcn_exp2f(p0[r] - mrun); p1[r] = __builtin_amdgcn_exp2f(p1[r] - mrun); ps += p0[r] + p1[r]; }
            lsum += ps;
            const LAS unsigned char* vb = lds + G::OFF_V + buf * G::VSTAGE + (4 * hi + ((lane & 15) >> 2)) * G::VPITCH + (16 * ((lane >> 4) & 1) + 4 * (lane & 3)) * 2;
#pragma unroll
            for (int s = 0; s < 4; ++s) {
                u32x4 pw;
                if (s < 2) { pw.x = pg8::cvt_pk_bf16(p0[8 * s + 0], p0[8 * s + 1]); pw.y = pg8::cvt_pk_bf16(p0[8 * s + 2], p0[8 * s + 3]); pw.z = pg8::cvt_pk_bf16(p0[8 * s + 4], p0[8 * s + 5]); pw.w = pg8::cvt_pk_bf16(p0[8 * s + 6], p0[8 * s + 7]); }
                else { const int s2 = s - 2; pw.x = pg8::cvt_pk_bf16(p1[8 * s2 + 0], p1[8 * s2 + 1]); pw.y = pg8::cvt_pk_bf16(p1[8 * s2 + 2], p1[8 * s2 + 3]); pw.z = pg8::cvt_pk_bf16(p1[8 * s2 + 4], p1[8 * s2 + 5]); pw.w = pg8::cvt_pk_bf16(p1[8 * s2 + 6], p1[8 * s2 + 7]); }
                const bf16x8 pa = __builtin_bit_cast(bf16x8, pw);
                const LAS unsigned char* vs = vb + (32 * (s >> 1) + 16 * (s & 1)) * G::VPITCH;
#pragma unroll
                for (int db = 0; db < NDB; ++db) {
                    const v4i16_t lo = __builtin_amdgcn_ds_read_tr16_b64_v4i16((LAS v4i16_t*)(vs + db * 64));
                    const v4i16_t hv = __builtin_amdgcn_ds_read_tr16_b64_v4i16((LAS v4i16_t*)(vs + 8 * G::VPITCH + db * 64));
                    const bf16x8 vf = (bf16x8){lo[0], lo[1], lo[2], lo[3], hv[0], hv[1], hv[2], hv[3]};
                    o[db] = __builtin_amdgcn_mfma_f32_32x32x16_bf16(pa, vf, o[db], 0, 0, 0);
                }
                asm volatile("" ::: "memory");
            }
        }
        if (kt + 1 < U.kt1) store_tile(buf ^ 1);
        __syncthreads();
    }
    lsum += __shfl_xor(lsum, 32);
    mrun_out = mrun; lsum_out = lsum;
}

__device__ __forceinline__ float msel(unsigned nx, int c, float s) { const unsigned t = (unsigned)(((int)(nx << (31 - c))) >> 31); return __uint_as_float((t & 0xff800000u) | (~t & __float_as_uint(s))); }
template <int NDB> struct Geo2 { static constexpr int KB = 8192, VB = NDB * 4096, STAGE = KB + VB, OFF_BIAS = 3 * STAGE, BIAS_PAD = 128  , OFF_Q = OFF_BIAS + 16384 + 4 * BIAS_PAD  , LDS_END = OFF_Q + 32768, NPT = 1 + NDB / 2  ; };
template <int NDB, int MODE>
__device__ __forceinline__ void run2(LAS unsigned char* lds, const Unit& U, int tid, f32x16 (&o)[NDB], float& mrun_out, float& lsum_out) {
    typedef Geo2<NDB> G;
    constexpr bool QLDS = false;
    const int lane = tid & 63, wid = __builtin_amdgcn_readfirstlane(tid >> 6), q32 = lane & 31, hi = lane >> 5;
    const int qi = U.qi0 + 32 * wid + q32;
    const int krw = 8 * wid + (lane >> 3);
    const bf16* gbase = U.P + (size_t)U.rowbase * PP;
    const unsigned ksrc = (unsigned)((krw * U.stride + U.rofs) * PP + U.colK + 8 * ((lane & 7) ^ (krw & 7)));
    unsigned vsrc0, vsrc1 = 0u;
    if (NDB == 2) { vsrc0 = (unsigned)((krw * U.stride + U.rofs) * PP + U.colV + 8 * ((lane & 7) ^ (4 * ((krw >> 1) & 1)))); }
    else { const int r0 = 4 * wid + (lane >> 4), r1 = r0 + 32;
        vsrc0 = (unsigned)((r0 * U.stride + U.rofs) * PP + U.colV + 8 * ((lane & 15) ^ (4 * (r0 & 3))));
        vsrc1 = (unsigned)((r1 * U.stride + U.rofs) * PP + U.colV + 8 * ((lane & 15) ^ (4 * (r1 & 3)))); }
    const unsigned tstep = (unsigned)(64 * U.stride * PP);
    auto dma_tile = [&](int kt, int stg) {
        LAS unsigned char* sb = lds + stg * G::STAGE;
        const bf16* tb = gbase + (size_t)kt * tstep;
        __builtin_amdgcn_global_load_lds((const unsigned*)(tb + ksrc), (LAS unsigned*)(sb + wid * 1024), 16, 0, 0);
        __builtin_amdgcn_global_load_lds((const unsigned*)(tb + vsrc0), (LAS unsigned*)(sb + G::KB + wid * 1024), 16, 0, 0);
        if (NDB == 4) __builtin_amdgcn_global_load_lds((const unsigned*)(tb + vsrc1), (LAS unsigned*)(sb + G::KB + (wid + 8) * 1024), 16, 0, 0);
    };
    f32x4 bt[2]; float bw = -INFINITY;
    if (MODE == 1) { const int dsub = tid - G::BIAS_PAD; if (dsub >= 0 && dsub <= 128) bw = U.biasd[dsub * U.stride]; }
    else {
#pragma unroll
        for (int i = 0; i < 2; ++i) bt[i] = *(const f32x4*)(U.biasd + (tid + 512 * i) * 4); }
    bf16x8 qr[4];
    { const bf16* qp = U.P + (size_t)(U.rowbase + (long)qi * U.stride + U.rofs) * PP + U.colQ + 8 * hi;
#pragma unroll
      for (int d0 = 0; d0 < 4; ++d0) qr[d0] = *(const bf16x8*)(qp + 16 * d0); }
    const unsigned long long* mrow = nullptr;
    if (MODE == 2) mrow = U.mask + (size_t)qi * 64;
    if (QLDS) {
#pragma unroll
        for (int d0 = 0; d0 < 4; ++d0) *(LAS bf16x8*)(lds + G::OFF_Q + wid * 4096 + d0 * 1024 + lane * 16) = qr[d0]; }
    dma_tile(U.kt0, 0);
    const bool two = U.kt0 + 1 < U.kt1;
    if (two) dma_tile(U.kt0 + 1, 1);
    { LAS float* blw = (LAS float*)(lds + G::OFF_BIAS) + G::BIAS_PAD;
      if (MODE == 1) blw[tid - G::BIAS_PAD] = bw;
      else {
#pragma unroll
        for (int i = 0; i < 2; ++i) *(LAS f32x4*)(blw + (tid + 512 * i) * 4) = bt[i];
        if (tid < G::BIAS_PAD / 4) *(LAS f32x4*)(blw - G::BIAS_PAD + 4 * tid) = (f32x4){-INFINITY, -INFINITY, -INFINITY, -INFINITY}; } }
#pragma unroll
    for (int db = 0; db < NDB; ++db)
#pragma unroll
        for (int r = 0; r < 16; ++r) o[db][r] = 0.f;
    constexpr bool SEED = true;
    constexpr bool FIXREF = true;
    float mrun = SEED ? 0.f : -1.0e30f, lsum = 0.f;
    f32x16 negm;
#pragma unroll
    for (int r = 0; r < 16; ++r) negm[r] = 0.f;
    if (two) { if (G::NPT == 2) asm volatile("s_waitcnt vmcnt(2) lgkmcnt(0)" ::: "memory"); else asm volatile("s_waitcnt vmcnt(3) lgkmcnt(0)" ::: "memory"); }
    else asm volatile("s_waitcnt vmcnt(0) lgkmcnt(0)" ::: "memory");
    __builtin_amdgcn_s_barrier(); asm volatile("" ::: "memory");
    const LAS float* bl = (const LAS float*)(lds + G::OFF_BIAS) + G::BIAS_PAD;
    const int qlo = U.qi0 + 32 * wid, qhi = qlo + 31;
    int koff[4];
#pragma unroll
    for (int d0 = 0; d0 < 4; ++d0) koff[d0] = q32 * 128 + (((2 * d0 + hi) ^ (q32 & 7)) * 16);
    const int qp_ = (lane & 15) >> 2, xin = 2 * ((lane >> 4) & 1) + ((lane & 3) >> 1), win = 8 * (lane & 1);
    int voff[NDB];
#pragma unroll
    for (int db = 0; db < NDB; ++db) {
        if (NDB == 2) voff[db] = (4 * hi + qp_) * 128 + ((4 * (db ^ ((qp_ >> 1) & 1)) + xin) * 16) + win;
        else voff[db] = (4 * hi + qp_) * 256 + ((4 * (db ^ qp_) + xin) * 16) + win;
    }
    constexpr int VROW = NDB * 64;
    int stg = 0;
    u32x4 nmw0, nmw1;
    if (MODE == 2) { const u32x4* mp = (const u32x4*)(mrow + 4 * (U.kt0 >> 2)); nmw0 = mp[0]; nmw1 = mp[1]; }
    for (int kt = U.kt0; kt < U.kt1; ++kt) {
        const bool more = kt + 2 < U.kt1;
        if (more) dma_tile(kt + 2, (stg + 2) % 3);
        const int k0 = 64 * kt;
        bool need = (k0 <= qhi);
        if (MODE == 1) need = need && (k0 + 63 >= qlo - 128);
        u32x4 mw0, mw1;
        if (MODE == 2) { mw0 = nmw0; mw1 = nmw1;
            if (kt + 1 < U.kt1) { const u32x4* mp = (const u32x4*)(mrow + 4 * ((kt + 1) >> 2)); nmw0 = mp[0]; nmw1 = mp[1]; } }
        if (need) {
            const LAS unsigned char* sb = lds + stg * G::STAGE;
            f32x16 p0, p1;
#pragma unroll
            for (int d0 = 0; d0 < 4; ++d0) {
                const bf16x8 ka = *(const LAS bf16x8*)(sb + koff[d0]), kc = *(const LAS bf16x8*)(sb + koff[d0] + 4096);
                const bf16x8 qd = QLDS ? *(const LAS bf16x8*)(lds + G::OFF_Q + wid * 4096 + d0 * 1024 + lane * 16) : qr[d0];
                p0 = __builtin_amdgcn_mfma_f32_32x32x16_bf16(ka, qd, d0 == 0 ? negm : p0, 0, 0, 0);
                p1 = __builtin_amdgcn_mfma_f32_32x32x16_bf16(kc, qd, d0 == 0 ? negm : p1, 0, 0, 0);
            }
            const bool edge = (MODE == 2) || (k0 + 63 > qlo) || (MODE == 1 && k0 < qhi - 128);
            const bool farc = (MODE != 1) && (qlo - (k0 + 63) >= 2048);
            unsigned nx[4] = {0u, 0u, 0u, 0u};
            if (MODE == 2) { const int f = kt & 3; const int sh = 16 * (f & 1) + hi;
                const unsigned w0 = (f & 2) ? mw0.y : mw0.x, w1 = (f & 2) ? mw0.w : mw0.z, w2 = (f & 2) ? mw1.y : mw1.x, w3 = (f & 2) ? mw1.w : mw1.z;
                nx[0] = ~(w0 >> sh); nx[1] = ~(w1 >> sh); nx[2] = ~(w2 >> sh); nx[3] = ~(w3 >> sh); }
            float mx = -INFINITY;
            if (farc) { const float bc = bl[2048];
#pragma unroll
                for (int r = 0; r < 16; ++r) { float s0 = p0[r] + bc; asm("" : "+v"(s0)); float s1 = p1[r] + bc; asm("" : "+v"(s1));
                    if (MODE == 2) { s0 = msel(nx[r & 3], 2 * (r >> 2), s0); s1 = msel(nx[r & 3], 2 * (r >> 2) + 8, s1); }
                    p0[r] = s0; p1[r] = s1; mx = fmaxf(fmaxf(mx, s0), s1); } }
            else {
                const int dbase = qi - k0 - 4 * hi;
                const LAS float* bb = bl + (dbase - 59);
                asm volatile("" : "+v"(bb));
#pragma unroll
                for (int r = 0; r < 16; ++r) {
                    const int cr = (r & 3) + 8 * (r >> 2); const int d0_ = dbase - cr, d1_ = d0_ - 32;
                    float s0 = p0[r] + bb[59 - cr]; asm("" : "+v"(s0));
                    float s1 = p1[r] + bb[27 - cr]; asm("" : "+v"(s1));
                    if (MODE == 2) { s0 = msel(nx[r & 3], 2 * (r >> 2), s0); s1 = msel(nx[r & 3], 2 * (r >> 2) + 8, s1); }
                    p0[r] = s0; p1[r] = s1; mx = fmaxf(fmaxf(mx, s0), s1);
                    if (NDB == 4 && (r & 3) == 3) asm volatile("" ::: "memory");
                }
            }
            if (!FIXREF) mx = fmaxf(mx, __shfl_xor(mx, 32));
            if (!FIXREF && __any(SEED ? (mx > 8.0f) : (mx > mrun + 8.0f))) {
                const float mrel = SEED ? fmaxf(mx, 0.f) : fmaxf(mx - mrun, 0.f);
                const float alpha = __builtin_amdgcn_exp2f(-mrel);
                lsum *= alpha;
#pragma unroll
                for (int r = 0; r < 16; ++r) { const float ar = __shfl(alpha, crow(r, hi));
#pragma unroll
                    for (int db = 0; db < NDB; ++db) o[db][r] *= ar; }
                mrun = SEED ? mrun + mrel : fmaxf(mrun, mx);
                if (SEED) {
#pragma unroll
                    for (int r = 0; r < 16; ++r) { p0[r] -= mrel; p1[r] -= mrel; negm[r] -= mrel; } }
            }
            float ps = 0.f;
            const float msub = SEED ? 0.f : mrun;
#pragma unroll
            for (int r = 0; r < 16; ++r) { p0[r] = __builtin_amdgcn_exp2f(p0[r] - msub); p1[r] = __builtin_amdgcn_exp2f(p1[r] - msub); ps += p0[r] + p1[r]; }
            lsum += ps;
            const LAS unsigned char* vbs = sb + G::KB;
#pragma unroll
            for (int s = 0; s < 4; ++s) {
                u32x4 pw;
                if (s < 2) { pw.x = pg8::cvt_pk_bf16(p0[8 * s + 0], p0[8 * s + 1]); pw.y = pg8::cvt_pk_bf16(p0[8 * s + 2], p0[8 * s + 3]); pw.z = pg8::cvt_pk_bf16(p0[8 * s + 4], p0[8 * s + 5]); pw.w = pg8::cvt_pk_bf16(p0[8 * s + 6], p0[8 * s + 7]); }
                else { const int s2 = s - 2; pw.x = pg8::cvt_pk_bf16(p1[8 * s2 + 0], p1[8 * s2 + 1]); pw.y = pg8::cvt_pk_bf16(p1[8 * s2 + 2], p1[8 * s2 + 3]); pw.z = pg8::cvt_pk_bf16(p1[8 * s2 + 4], p1[8 * s2 + 5]); pw.w = pg8::cvt_pk_bf16(p1[8 * s2 + 6], p1[8 * s2 + 7]); }
                const bf16x8 pa = __builtin_bit_cast(bf16x8, pw);
                const int rowb = (32 * (s >> 1) + 16 * (s & 1)) * VROW;
#pragma unroll
                for (int db = 0; db < NDB; ++db) {
                    const v4i16_t lo = __builtin_amdgcn_ds_read_tr16_b64_v4i16((LAS v4i16_t*)(vbs + rowb + voff[db]));
                    const v4i16_t hv = __builtin_amdgcn_ds_read_tr16_b64_v4i16((LAS v4i16_t*)(vbs + rowb + 8 * VROW + voff[db]));
                    const bf16x8 vf = (bf16x8){lo[0], lo[1], lo[2], lo[3], hv[0], hv[1], hv[2], hv[3]};
                    o[db] = __builtin_amdgcn_mfma_f32_32x32x16_bf16(pa, vf, o[db], 0, 0, 0);
                }
                if (NDB == 4) asm volatile("" ::: "memory");
            }
        }
        if (more) { if (G::NPT == 2) asm volatile("s_waitcnt vmcnt(2) lgkmcnt(0)" ::: "memory"); else asm volatile("s_waitcnt vmcnt(3) lgkmcnt(0)" ::: "memory"); }
        else asm volatile("s_waitcnt vmcnt(0) lgkmcnt(0)" ::: "memory");
        __builtin_amdgcn_s_barrier(); asm volatile("" ::: "memory");
        stg = (stg == 2) ? 0 : stg + 1;
    }
    lsum += __shfl_xor(lsum, 32);
    mrun_out = mrun; lsum_out = lsum;
}
}
__device__ __forceinline__ void phase_attn_B(Frame& F, const Args& A) {
    int tid_ = F.wave * 64 + hw_lane(); const int tid = tid_, lane = tid & 63, wid = __builtin_amdgcn_readfirstlane(tid >> 6), q32 = lane & 31, hi = lane >> 5;
    const int v = (F.bx % 8) * (F.G / 8) + F.bx / 8;
    const bf16* P = (const bf16*)(A.ws + WS_PROJ); bf16* OB = (bf16*)(A.ws + WS_OB); const float* biasd = (const float*)(A.ws + WS_BIASD);
    for (int pv = v; pv < 256; pv += F.G) {
        const int combo = pv >> 3, s = pv & 7, b = combo >> 3, h = (combo >> 1) & 3, mp = combo & 1;
#pragma unroll 1
        for (int half = 0; half < 2; ++half) {
            const int qb = half ? s : 15 - s;
            fa::Unit U; U.P = P; U.colQ = COL_BQ + (mp * 4 + h) * 64; U.colK = COL_BK + (mp * 4 + h) * 64; U.colV = COL_BV + h * 128; U.rowbase = (long)b * T; U.stride = 1; U.rofs = 0;
            U.qi0 = 256 * qb; U.kt0 = 0; U.kt1 = 4 * (qb + 1); U.biasd = biasd + (12 + h) * 4096; U.scores = nullptr; U.tau = nullptr; U.mask = nullptr;
            fa::f32x16 o[4]; float mrun, lsum;
            fa::run2<4, 0>(F.lds + RING_OFF, U, tid, o, mrun, lsum);
            const float inv = 1.0f / lsum;
            bf16* orow = OB + (size_t)(U.rowbase + U.qi0 + 32 * wid) * 1024 + h * 256 + mp * 128 + q32;
#pragma unroll
            for (int r = 0; r < 16; ++r) { int hi_ = hi; asm volatile("" : "+v"(hi_)); const int qq = fa::crow(r, hi_); const float ir = __shfl(inv, qq);
#pragma unroll
                for (int db = 0; db < 4; ++db) orow[(size_t)qq * 1024 + 32 * db] = (bf16)f2bf(o[db][r] * ir); }
        }
    }
}
__device__ __forceinline__ void phase_combine_B(Frame& F, const Args& A, int L) {
    const int lane = hw_lane();
    const bf16* OB = (const bf16*)(A.ws + WS_OB); bf16* O = (bf16*)(A.ws + WS_OATT);
    const float* lv = A.in[9] + (size_t)L * 256; const float* dn = A.in[10] + (size_t)L * 128;
    const float lam_init = 0.8f - 0.6f * expf(-0.3f * (float)L);
    const float lam = expf(wave_sum(lv[lane] * lv[64 + lane])) - expf(wave_sum(lv[128 + lane] * lv[192 + lane])) + lam_init;
    const float g0 = dn[lane], g1 = dn[64 + lane];
    const int gw = F.bx * NWAVES + F.wave, NGW = F.G * NWAVES;
    for (int it0 = gw; it0 < M * 4; it0 += 4 * NGW) {
        unsigned short x[4][4];
#pragma unroll
        for (int u = 0; u < 4; ++u) { const int itr = it0 + u * NGW, it = itr < M * 4 ? itr : it0; const bf16* p = OB + (size_t)(it >> 2) * 1024 + (it & 3) * 256;
            x[u][0] = p[lane]; x[u][1] = p[64 + lane]; x[u][2] = p[128 + lane]; x[u][3] = p[192 + lane]; }
#pragma unroll
        for (int u = 0; u < 4; ++u) { const int it = it0 + u * NGW, row = it >> 2, h = it & 3; if (it >= M * 4) break;
            const float d0 = bflo((unsigned)x[u][0]) - lam * bflo((unsigned)x[u][2]), d1 = bflo((unsigned)x[u][1]) - lam * bflo((unsigned)x[u][3]);
            const float inv = __builtin_amdgcn_rsqf(wave_sum(d0 * d0 + d1 * d1) * (1.0f / 128.0f) + 1e-6f) * (1.0f - lam_init);
            O[(size_t)row * 1024 + 256 + h * 128 + lane] = (bf16)f2bf(d0 * inv * g0);
            O[(size_t)row * 1024 + 256 + h * 128 + 64 + lane] = (bf16)f2bf(d1 * inv * g1); }
    }
}
constexpr size_t SC_BATCH = 8454144;
__device__ __forceinline__ size_t sc_rowoff(int t) { const size_t i = (size_t)(t >> 5); return 512 * i * (i + 1) + (size_t)(t & 31) * 32 * (i + 1); }
typedef float f32x4v __attribute__((ext_vector_type(4)));
__device__ __forceinline__ void c1_decode(int f, int& b, int& qb, int& kt) { b = f / 1056; const int rem = f - 1056 * b; qb = 0; while ((qb + 1) * (qb + 2) <= rem) ++qb; kt = rem - qb * (qb + 1); }
__device__ __forceinline__ void phase_C1(Frame& F, const Args& A) {
    int tid_ = F.wave * 64 + hw_lane(); const int tid = tid_, lane = tid & 63, wid = __builtin_amdgcn_readfirstlane(tid >> 6), q16 = lane & 15, g = lane >> 4;
    const int v = (F.bx % 8) * (F.G / 8) + F.bx / 8;
    const bf16* P = (const bf16*)(A.ws + WS_PROJ); float* SC = (float*)(A.ws + WS_SCORES); const float* WIDX = (const float*)(A.ws + WS_WIDX);
    float* dummy = (float*)(A.ws + WS_TAU + 512 * 1024) + (size_t)F.bx * 256 + lane * 4;
    constexpr int NTOT = 4 * 1056;
    const int f0 = (int)(((long)v * NTOT) / F.G), f1 = (int)(((long)(v + 1) * NTOT) / F.G);
    if (f0 >= f1) return;
    LAS unsigned char* lds = F.lds + RING_OFF;
    const unsigned ksrc = (unsigned)((8 * wid + (lane >> 3)) * PP + COL_IK + 8 * ((lane & 7) ^ (lane >> 3)));
    auto dma = [&](int b_, int kt_, int stg_) { __builtin_amdgcn_global_load_lds((const unsigned*)(P + (size_t)((long)b_ * T + 64 * kt_) * PP + ksrc), (LAS unsigned*)(lds + stg_ * 8192 + wid * 1024), 16, 0, 0); };
    auto advance = [](int& b_, int& qb_, int& kt_) { ++kt_; if (kt_ >= 2 * (qb_ + 1)) { kt_ = 0; ++qb_; if (qb_ >= 32) { qb_ = 0; ++b_; } } };
    int b, qb, kt; c1_decode(f0, b, qb, kt);
    int b2 = b, qb2 = qb, kt2 = kt;
    dma(b, kt, 0);
    if (f0 + 1 < f1) advance(b2, qb2, kt2);
    dma(b2, kt2, 1);
    if (f0 + 2 < f1) advance(b2, qb2, kt2);
    asm volatile("s_waitcnt vmcnt(1)" ::: "memory");
    __builtin_amdgcn_s_barrier(); asm volatile("" ::: "memory");
    int f = f0, stg = 0;
    const int kx = q16 & 7;
    while (f < f1) {
        fa::bf16x8 qf[8][2]; float wq[8];
        { const size_t row = (size_t)b * T + 128 * qb + 16 * wid + q16;
#pragma unroll
          for (int h = 0; h < 8; ++h) { wq[h] = WIDX[row * 8 + h] * 0.35355339059327373f;
#pragma unroll
              for (int ks = 0; ks < 2; ++ks) qf[h][ks] = *(const fa::bf16x8*)(P + row * PP + COL_IQ + h * 64 + 32 * ks + 8 * g); } }
        asm volatile("" : "+v"(qf[0][0]), "+v"(qf[0][1]), "+v"(qf[1][0]), "+v"(qf[1][1]), "+v"(qf[2][0]), "+v"(qf[2][1]), "+v"(qf[3][0]), "+v"(qf[3][1]),
                          "+v"(qf[4][0]), "+v"(qf[4][1]), "+v"(qf[5][0]), "+v"(qf[5][1]), "+v"(qf[6][0]), "+v"(qf[6][1]), "+v"(qf[7][0]), "+v"(qf[7][1]),
                          "+v"(wq[0]), "+v"(wq[1]), "+v"(wq[2]), "+v"(wq[3]), "+v"(wq[4]), "+v"(wq[5]), "+v"(wq[6]), "+v"(wq[7]));
        int fend = f + (2 * (qb + 1) - kt); fend = fend < f1 ? fend : f1;
        const int tq0 = 128 * qb + 16 * wid;
        float* srow = SC + (size_t)b * SC_BATCH + sc_rowoff(tq0 + q16);
#pragma unroll 1
        for (; f < fend; ++f) {
            dma(b2, kt2, stg >= 1 ? stg - 1 : 2);
            const int k0 = 64 * kt;
            const LAS unsigned char* sb = lds + stg * 8192;
#pragma unroll 1
            for (int kb = 0; kb < 4; ++kb) {
                const int kbase = k0 + 16 * kb;
                const LAS unsigned char* kp = sb + (16 * kb + q16) * 128;
                const fa::bf16x8 kf0 = *(const LAS fa::bf16x8*)(kp + ((g ^ kx) << 4)), kf1 = *(const LAS fa::bf16x8*)(kp + (((4 + g) ^ kx) << 4));
                f32x4v p[8];
#pragma unroll
                for (int h = 0; h < 8; ++h) p[h] = __builtin_amdgcn_mfma_f32_16x16x32_bf16(kf0, qf[h][0], (f32x4v){0.f, 0.f, 0.f, 0.f}, 0, 0, 0);
#pragma unroll
                for (int h = 0; h < 8; ++h) p[h] = __builtin_amdgcn_mfma_f32_16x16x32_bf16(kf1, qf[h][1], p[h], 0, 0, 0);
                __builtin_amdgcn_sched_barrier(0);
                f32x4v sc = {0.f, 0.f, 0.f, 0.f};
#pragma unroll
                for (int h = 0; h < 8; ++h) {
#pragma unroll
                    for (int r = 0; r < 4; ++r) { const int pb = __float_as_int(p[h][r]); sc[r] = fa::fma_s(wq[h], __int_as_float(pb > 0 ? pb : 0), sc[r]); }
                }
                float* dst = (kbase > tq0 + 15) ? dummy : srow + kbase + 4 * g;
                *(f32x4v*)dst = sc;
            }
            asm volatile("s_waitcnt vmcnt(9) lgkmcnt(0)" ::: "memory");
            __builtin_amdgcn_s_barrier(); asm volatile("" ::: "memory");
            stg = (stg == 2) ? 0 : stg + 1;
            ++kt; if (f + 3 < f1) advance(b2, qb2, kt2);
        }
        if (kt >= 2 * (qb + 1)) { kt = 0; ++qb; if (qb >= 32) { qb = 0; ++b; } }
    }
    asm volatile("s_waitcnt vmcnt(0)" ::: "memory");
    __builtin_amdgcn_s_barrier(); asm volatile("" ::: "memory");
}

__device__ __forceinline__ void phase_select(Frame& F, const Args& A) {
    unsigned char* ws_ = A.ws;
    const int lane = hw_lane();
    const float* SC = (const float*)(ws_ + WS_SCORES); float2* TAU = (float2*)(ws_ + WS_TAU); unsigned long long* MASKW = (unsigned long long*)(ws_ + WS_MASK);
    LAS unsigned char* wl = F.lds + RING_OFF + F.wave * 18688;
    LAS unsigned* keys = (LAS unsigned*)wl;
    LAS unsigned* hist = (LAS unsigned*)(wl + 16384);
    const int gw = F.bx * NWAVES + F.wave, NGW = F.G * NWAVES;
    const unsigned long long ltmask = (1ull << lane) - 1ull;
    f32x4 nsv[16];
    auto issue_row = [&](int row_) { const int b_ = row_ >> 12, t_ = row_ & 4095; const float* sr = SC + (size_t)b_ * SC_BATCH + sc_rowoff(t_); const int rl = 32 * ((t_ >> 5) + 1);
#pragma unroll
        for (int i = 0; i < 16; ++i) { const int j0 = 256 * i + 4 * lane; nsv[i] = *(const f32x4*)(sr + (j0 + 4 <= rl ? j0 : rl - 4)); } };
    auto row_of = [&](int it_) { const int p_ = gw + NGW * (it_ >> 1); const int tt_ = p_ & 2047; return ((p_ >> 11) << 12) + ((it_ & 1) ? 4095 - tt_ : tt_); };
    const int nit = (gw < M / 2) ? 2 * ((M / 2 - 1 - gw) / NGW + 1) : 0;
    if (nit > 0) issue_row(row_of(0));
#pragma unroll 1
    for (int it = 0; it < nit; ++it) {
        const int row = row_of(it);
        const int t = row & 4095, N = t + 1;
        f32x4 sv[16];
#pragma unroll
        for (int i = 0; i < 16; ++i) sv[i] = nsv[i];
        if (it + 1 < nit) issue_row(row_of(it + 1));
        const int nc = (N + 255) >> 8;
        float tauf; int icut; bool tie = false;
        if (N <= 256) { tauf = -INFINITY; icut = 0; }
        else {
        int l4 = 4 * lane; asm volatile("" : "+v"(l4));
        float mn = fminf(fminf(sv[0][0], sv[0][1]), fminf(sv[0][2], sv[0][3])), mx = fmaxf(fmaxf(sv[0][0], sv[0][1]), fmaxf(sv[0][2], sv[0][3]));
        if (nc >= 3) { mn = fminf(mn, fminf(fminf(sv[1][0], sv[1][1]), fminf(sv[1][2], sv[1][3]))); mx = fmaxf(mx, fmaxf(fmaxf(sv[1][0], sv[1][1]), fmaxf(sv[1][2], sv[1][3]))); }
#pragma unroll
        for (int o = 32; o >= 1; o >>= 1) { mn = fminf(mn, __shfl_xor(mn, o)); mx = fmaxf(mx, __shfl_xor(mx, o)); }
        const float scale = (mx > mn) ? 511.0f / (mx - mn) : 0.0f;
        const float boff = -mn * scale;
        { unsigned zz = 0u; asm volatile("" : "+v"(zz)); const v4u z4 = (v4u){zz, zz, zz, zz};
          *(LAS v4u*)(hist + 4 * lane) = z4; *(LAS v4u*)(hist + 256 + 4 * lane) = z4; if (lane < 2) *(LAS v4u*)(hist + 512 + 4 * lane) = z4; }
        LDS_WAIT();
#pragma unroll
        for (int i = 0; i < 16; ++i) { if (i < nc - 1) {
#pragma unroll
                for (int e = 0; e < 4; ++e) { int bk = (int)__builtin_fmaf(sv[i][e], scale, boff); bk = bk < 0 ? 0 : bk; bk = bk > 511 ? 511 : bk;
                    __hip_atomic_fetch_add(hist + bk, 1u, __ATOMIC_RELAXED, __HIP_MEMORY_SCOPE_WORKGROUP); } }
            else if (i == nc - 1) {
#pragma unroll
                for (int e = 0; e < 4; ++e) { int bk = (int)__builtin_fmaf(sv[i][e], scale, boff); bk = bk < 0 ? 0 : bk; bk = bk > 511 ? 511 : bk; bk = (256 * i + l4 + e < N) ? bk : 512;
                    __hip_atomic_fetch_add(hist + bk, 1u, __ATOMIC_RELAXED, __HIP_MEMORY_SCOPE_WORKGROUP); } } }
        LDS_WAIT();
        int fbk, krem, cfb;
        { const v4u h0 = *(const LAS v4u*)(hist + 8 * lane), h1 = *(const LAS v4u*)(hist + 8 * lane + 4);
          const unsigned sl = h0.x + h0.y + h0.z + h0.w + h1.x + h1.y + h1.z + h1.w;
          unsigned suf = sl;
#pragma unroll
          for (int o = 1; o < 64; o <<= 1) { const unsigned other = (unsigned)__builtin_amdgcn_ds_bpermute(((lane + o) & 63) << 2, (int)suf); if (lane + o < 64) suf += other;     }
          unsigned cum = suf - sl;
          int fb = -1; unsigned fabove = 0u, fcnt = 0u; int l8 = 8 * lane; asm volatile("" : "+v"(l8));
          const unsigned cc[8] = {h1.w, h1.z, h1.y, h1.x, h0.w, h0.z, h0.y, h0.x};
#pragma unroll
          for (int i = 0; i < 8; ++i) { if (fb < 0 && cum < 256u && cum + cc[i] >= 256u) { fb = l8 + 7 - i; fabove = cum; fcnt = cc[i]; } cum += cc[i]; }
          const unsigned long long bal = __ballot(fb >= 0);
          const int src = __builtin_ctzll(bal);
          fbk = __shfl(fb, src); krem = 256 - (int)__shfl(fabove, src); cfb = (int)__shfl(fcnt, src); }
        if (cfb <= 64) {
            int l4b = 4 * lane; asm volatile("" : "+v"(l4b));
            unsigned cbase = 0u;
#pragma unroll
            for (int i = 0; i < 16; ++i) { if (i < nc) {
                bool hit[4]; bool anyh = false;
#pragma unroll
                for (int e = 0; e < 4; ++e) { int bk = (int)__builtin_fmaf(sv[i][e], scale, boff); bk = bk < 0 ? 0 : bk; bk = bk > 511 ? 511 : bk; hit[e] = (bk == fbk) && (256 * i + l4b + e < N); anyh = anyh || hit[e]; }
                if (__any(anyh)) {
#pragma unroll
                    for (int e = 0; e < 4; ++e) { const unsigned long long bm = __ballot(hit[e]);
                        if (hit[e]) { const unsigned pos = cbase + (unsigned)__popcll(bm & ltmask); keys[2 * pos] = __float_as_uint(sv[i][e]); keys[2 * pos + 1] = (unsigned)(256 * i + l4b + e); }
                        cbase += (unsigned)__popcll(bm); } } } }
            LDS_WAIT();
            const int cl = lane < cfb ? lane : 0;
            const float sl_ = __uint_as_float(keys[2 * cl]); const int il_ = (int)keys[2 * cl + 1];
            int rank = 0;
#pragma unroll 1
            for (int m = 0; m < cfb; ++m) { const float sm = __uint_as_float(__builtin_amdgcn_readlane(__float_as_uint(sl_), m)); const int im = __builtin_amdgcn_readlane(il_, m);
                rank += (sm > sl_ || (sm == sl_ && im < il_)) ? 1 : 0; }
            const unsigned long long hitl = __ballot(lane < cfb && rank == krem - 1);
            const int src = __builtin_ctzll(hitl);
            tauf = __shfl(sl_, src); icut = __shfl(il_, src);
            tie = __popcll(__ballot(lane < cfb && sl_ == tauf)) > 1;
            LDS_WAIT();
        } else {
            tie = true;
#pragma unroll
            for (int i = 0; i < 16; ++i) { const int j0 = 256 * i + 4 * lane; v4u u;
#pragma unroll
                for (int e = 0; e < 4; ++e) { const unsigned bits = __float_as_uint(sv[i][e]); const unsigned kk = (bits & 0x80000000u) ? ~bits : (bits | 0x80000000u); u[e] = (j0 + e < N) ? kk : 0u; }
                if (i < nc) *(LAS v4u*)(keys + j0) = u; }
            unsigned prefix = 0u, mask = 0u; int kr = 256;
#pragma unroll 1
            for (int pass = 0; pass < 4; ++pass) {
                const int shift = 24 - 8 * pass;
                { unsigned zz = 0u; asm volatile("" : "+v"(zz)); *(LAS v4u*)(hist + 4 * lane) = (v4u){zz, zz, zz, zz}; }
                LDS_WAIT();
#pragma unroll 1
                for (int c = 0; c < nc; ++c) { const v4u kq = *(const LAS v4u*)(keys + 256 * c + 4 * lane);
#pragma unroll
                    for (int e = 0; e < 4; ++e) { const unsigned kk = kq[e]; if (kk != 0u && (kk & mask) == prefix) __hip_atomic_fetch_add(hist + ((kk >> shift) & 255u), 1u, __ATOMIC_RELAXED, __HIP_MEMORY_SCOPE_WORKGROUP); } }
                LDS_WAIT();
                const v4u hc = *(const LAS v4u*)(hist + 4 * lane);
                const unsigned sl = hc.x + hc.y + hc.z + hc.w;
                unsigned suf = sl;
#pragma unroll
                for (int o = 1; o < 64; o <<= 1) { const unsigned other = (unsigned)__builtin_amdgcn_ds_bpermute(((lane + o) & 63) << 2, (int)suf); if (lane + o < 64) suf += other;     }
                unsigned cum = suf - sl;
                int fb = -1; unsigned fabove = 0u;
                { const unsigned cc[4] = {hc.w, hc.z, hc.y, hc.x};
#pragma unroll
                  for (int i = 0; i < 4; ++i) { if (fb < 0 && cum < (unsigned)kr && cum + cc[i] >= (unsigned)kr) { fb = 4 * lane + 3 - i; fabove = cum; } cum += cc[i]; } }
                const unsigned long long bal = __ballot(fb >= 0);
                const int src = __builtin_ctzll(bal);
                const int bin = __shfl(fb, src); const unsigned above = __shfl(fabove, src);
                prefix |= (unsigned)bin << shift; mask |= 0xFFu << shift; kr -= (int)above;
            }
            int eqseen = 0; icut = -1;
#pragma unroll 1
            for (int c = 0; c < nc; ++c) {
                const v4u kq = *(const LAS v4u*)(keys + 256 * c + 4 * lane);
                const bool e0 = kq.x == prefix, e1 = kq.y == prefix, e2 = kq.z == prefix, e3 = kq.w == prefix;
                const unsigned long long b0 = __ballot(e0), b1 = __ballot(e1), b2 = __ballot(e2), b3 = __ballot(e3);
                if ((b0 | b1 | b2 | b3) != 0ull) {
                    const int lower = eqseen + __popcll(b0 & ltmask) + __popcll(b1 & ltmask) + __popcll(b2 & ltmask) + __popcll(b3 & ltmask);
                    const int r0 = lower, r1 = r0 + (e0 ? 1 : 0), r2 = r1 + (e1 ? 1 : 0), r3 = r2 + (e2 ? 1 : 0);
                    int mine = -1;
                    if (e0 && r0 == kr - 1) mine = 0; if (e1 && r1 == kr - 1) mine = 1; if (e2 && r2 == kr - 1) mine = 2; if (e3 && r3 == kr - 1) mine = 3;
                    const unsigned long long hit = __ballot(mine >= 0);
                    if (hit) { const int src = __builtin_ctzll(hit); icut = 256 * c + 4 * src + __shfl(mine, src); }
                    eqseen += __popcll(b0) + __popcll(b1) + __popcll(b2) + __popcll(b3);
                }
            }
            const unsigned tb = (prefix & 0x80000000u) ? (prefix & 0x7fffffffu) : ~prefix;
            tauf = __uint_as_float(tb);
            LDS_WAIT();
        }
        }
        if (lane == 0) TAU[row] = make_float2(tauf, __int_as_float(icut));
        { unsigned mlo = 0u, mhi = 0u; int l4c = 4 * lane; asm volatile("" : "+v"(l4c));
#define SEL_PUT(bal_, idx_) do { const unsigned long long bq_ = (bal_); const unsigned blo = (unsigned)bq_, bhi = (unsigned)(bq_ >> 32); \
              asm volatile("s_nop 1\n\tv_writelane_b32 %0, %2, %4\n\tv_writelane_b32 %1, %3, %4" : "+v"(mlo), "+v"(mhi) : "s"(blo), "s"(bhi), "n"(idx_)); } while (0)
          if (!tie) {
#pragma unroll
            for (int i = 0; i < 16; ++i) { if (i < nc - 1) {
#pragma unroll
                for (int e = 0; e < 4; ++e) SEL_PUT(__ballot(sv[i][e] >= tauf), 4 * i + e); }
              else if (i == nc - 1) {
#pragma unroll
                for (int e = 0; e < 4; ++e) SEL_PUT(__ballot((256 * i + l4c + e < N) & (sv[i][e] >= tauf)), 4 * i + e); } }
          } else {
#pragma unroll
            for (int i = 0; i < 16; ++i) { if (i < nc) {
#pragma unroll
                for (int e = 0; e < 4; ++e) { const float sx = sv[i][e]; const int j = 256 * i + l4c + e;
                    SEL_PUT(__ballot((j < N) & ((sx > tauf) | ((sx == tauf) & (j <= icut)))), 4 * i + e); } } }
          }
#undef SEL_PUT
          MASKW[(size_t)row * 64 + lane] = ((unsigned long long)mhi << 32) | (unsigned long long)mlo; }
    }
}

__device__ __forceinline__ void phase_attn_C(Frame& F, const Args& A) {
    int tid_ = F.wave * 64 + hw_lane(); const int tid = tid_, lane = tid & 63, wid = __builtin_amdgcn_readfirstlane(tid >> 6), q32 = lane & 31, hi = lane >> 5;
    const int v = (F.bx % 8) * (F.G / 8) + F.bx / 8;
    const bf16* P = (const bf16*)(A.ws + WS_PROJ); bf16* OP = (bf16*)(A.ws + WS_OAP); float* ST = (float*)(A.ws + WS_OAP + 24 * MiB); const float* biasd = (const float*)(A.ws + WS_BIASD);
    for (int pv = v; pv < 256; pv += F.G) {
        const int combo = pv >> 3, s = pv & 7, b = combo >> 3, h = (combo >> 1) & 3, half = combo & 1;
#pragma unroll 1
        for (int which = 0; which < 2; ++which) {
            const int qb = which ? s : 15 - s, ntile = 4 * (qb + 1), kmid = ntile / 2;
            fa::Unit U; U.P = P; U.colQ = COL_CQ + h * 64; U.colK = COL_CK; U.colV = COL_CV; U.rowbase = (long)b * T; U.stride = 1; U.rofs = 0;
            U.qi0 = 256 * qb; U.kt0 = half ? kmid : 0; U.kt1 = half ? ntile : kmid; U.biasd = biasd + (16 + h) * 4096;
            U.scores = (const float*)(A.ws + WS_SCORES) + (size_t)b * SC_BATCH; U.tau = (const float2*)(A.ws + WS_TAU) + (size_t)b * T; U.mask = (const unsigned long long*)(A.ws + WS_MASK) + (size_t)b * T * 64;
            fa::f32x16 o[2]; float mrun, lsum;
            fa::run2<2, 2>(F.lds + RING_OFF, U, tid, o, mrun, lsum);
            const float inv = (lsum > 0.f) ? 1.0f / lsum : 0.f;
            const size_t prow0 = (size_t)half * M + (size_t)U.rowbase + U.qi0 + 32 * wid;
            if (hi == 0) *(float2*)(ST + ((prow0 + q32) * 4 + h) * 2) = make_float2(mrun, lsum);
#pragma unroll
            for (int r = 0; r < 16; ++r) { int hi_ = hi; asm volatile("" : "+v"(hi_)); const int qq = fa::crow(r, hi_); const float ir = __shfl(inv, qq);
#pragma unroll
                for (int db = 0; db < 2; ++db) OP[(prow0 + qq) * 256 + h * 64 + 32 * db + q32] = (bf16)f2bf(o[db][r] * ir); }
        }
    }
}
template <int NG, int OCOL> __device__ __forceinline__ void merge_partials(Frame& F, const Args& A) {
    const int lane = hw_lane();
    const bf16* OP = (const bf16*)(A.ws + WS_OAP); const float* ST = (const float*)(A.ws + WS_OAP + 24 * MiB); bf16* O = (bf16*)(A.ws + WS_OATT);
    const int gw = F.bx * NWAVES + F.wave, NGW = F.G * NWAVES;
    for (int it0 = gw; it0 < M * 4; it0 += 4 * NGW) {
        float2 st[4][NG]; unsigned short ov[4][NG];
#pragma unroll
        for (int u = 0; u < 4; ++u) { const int itr = it0 + u * NGW, it = itr < M * 4 ? itr : it0, row = it >> 2, h = it & 3;
#pragma unroll
            for (int g = 0; g < NG; ++g) { const size_t prow = (size_t)g * M + row; st[u][g] = *(const float2*)(ST + (prow * 4 + h) * 2); ov[u][g] = OP[prow * 256 + h * 64 + lane]; } }
#pragma unroll
        for (int u = 0; u < 4; ++u) { const int it = it0 + u * NGW, row = it >> 2, h = it & 3; if (it >= M * 4) break;
            float mm = st[u][0].x;
#pragma unroll
            for (int g = 1; g < NG; ++g) mm = fmaxf(mm, st[u][g].x);
            float num = 0.f, den = 0.f;
#pragma unroll
            for (int g = 0; g < NG; ++g) { const float w = __builtin_amdgcn_exp2f(st[u][g].x - mm) * st[u][g].y; num += w * bflo((unsigned)ov[u][g]); den += w; }
            O[(size_t)row * 1024 + OCOL + h * 64 + lane] = (bf16)f2bf(num / den); }
    }
}
__device__ __forceinline__ void phase_merge_C(Frame& F, const Args& A) { merge_partials<2, 768>(F, A); }

__device__ __forceinline__ void phase_attn_A(Frame& F, const Args& A) {
    int tid_ = F.wave * 64 + hw_lane(); const int tid = tid_, lane = tid & 63, wid = __builtin_amdgcn_readfirstlane(tid >> 6), q32 = lane & 31, hi = lane >> 5;
    const int v = (F.bx % 8) * (F.G / 8) + F.bx / 8;
    const bf16* P = (const bf16*)(A.ws + WS_PROJ); bf16* OP = (bf16*)(A.ws + WS_OAP); float* ST = (float*)(A.ws + WS_OAP + 24 * MiB); const float* biasd = (const float*)(A.ws + WS_BIASD);
    const int u0 = (int)(((long)v * 768) / F.G), u1 = (int)(((long)(v + 1) * 768) / F.G);
#pragma unroll 1
    for (int u = u0; u < u1; ++u) {
        const int b = u / 192, rem = u % 192, g = rem >> 6, hs = (rem >> 4) & 3, ri = rem & 15;
        const int dil = (g == 0) ? 1 : (g == 1 ? 4 : 16), res = (g == 0) ? 0 : (g == 1 ? (ri >> 2) : ri), iblk = (g == 0) ? ri : (g == 1 ? (ri & 3) : 0), head = 4 * g + hs;
        fa::Unit U; U.P = P; U.colQ = COL_AQ + head * 64; U.colK = COL_AK + head * 64; U.colV = COL_AV + head * 64; U.rowbase = (long)b * T; U.stride = dil; U.rofs = res;
        U.qi0 = 256 * iblk; U.kt0 = (iblk == 0) ? 0 : 4 * iblk - 2; U.kt1 = 4 * iblk + 4; U.biasd = biasd + head * 4096;
        fa::f32x16 o[2]; float mrun, lsum;
        fa::run2<2, 1>(F.lds + RING_OFF, U, tid, o, mrun, lsum);
        const float inv = 1.0f / lsum;
        const size_t prow0 = (size_t)g * M + (size_t)U.rowbase + res;
        if (hi == 0) { const size_t prow = prow0 + (size_t)(U.qi0 + 32 * wid + q32) * dil; *(float2*)(ST + (prow * 4 + hs) * 2) = make_float2(mrun, lsum); }
#pragma unroll
        for (int r = 0; r < 16; ++r) { int hi_ = hi; asm volatile("" : "+v"(hi_)); const int qq = fa::crow(r, hi_); const float ir = __shfl(inv, qq); const size_t prow = prow0 + (size_t)(U.qi0 + 32 * wid + qq) * dil;
#pragma unroll
            for (int db = 0; db < 2; ++db) OP[prow * 256 + hs * 64 + 32 * db + q32] = (bf16)f2bf(o[db][r] * ir); }
    }
}
__device__ __forceinline__ void phase_merge_A(Frame& F, const Args& A) { merge_partials<3, 0>(F, A); }
#define XB_TMO      128
#define XB_XCNT(j)  (256  + 64 * (j))
#define XB_XSUB(j)  (1280 + 64 * (j))
#define XB_XGEN(j)  (2304 + 64 * (j))
#define XB_TOP      3328
#define XB_TOPGEN   3392
#define XCD_BAR_WORDS 3456
#define XB_SPIN_CAP (1u << 24)

__device__ __forceinline__ unsigned xb_ld(unsigned* p)              { return __hip_atomic_load(p, __ATOMIC_RELAXED, __HIP_MEMORY_SCOPE_AGENT); }
__device__ __forceinline__ unsigned xb_add(unsigned* p, unsigned v) { return __hip_atomic_fetch_add(p, v, __ATOMIC_RELAXED, __HIP_MEMORY_SCOPE_AGENT); }
__device__ __forceinline__ unsigned xb_xcc_id() { return (unsigned)__builtin_amdgcn_s_getreg((3 << 11) | 20) & 0xFu; }
#define XB_SPIN(cond, bar) do { unsigned _sp = 0; while (cond) { __builtin_amdgcn_s_sleep(1); \
    if ((++_sp & 255u) == 0u) { if (xb_ld(&(bar)[XB_TMO])) break; if (_sp > XB_SPIN_CAP) { atomicAdd(&(bar)[XB_TMO], 1u); break; } } } } while (0)

struct XcdBarrier {
    unsigned* bar; unsigned x;
    volatile LAS unsigned* st;
};

__device__ __forceinline__ XcdBarrier xcd_barrier_post(unsigned* bar, volatile LAS unsigned* st, bool leader) {
    XcdBarrier b; b.bar = bar; b.x = xb_xcc_id(); b.st = st;
    if (leader) (void)xb_add(&bar[XB_XCNT(b.x)], 1u);
    return b;
}
__device__ __forceinline__ void xcd_barrier_complete(unsigned* bar, unsigned x, unsigned& nloc, unsigned& nx) {
    const unsigned G = gridDim.x * gridDim.y * gridDim.z;
    unsigned sum, cnt, mine, sp = 0u;
    for (;;) {
        sum = 0u; cnt = 0u; mine = 0u;
#pragma unroll
        for (unsigned j = 0; j < 16; ++j) { const unsigned c = xb_ld(&bar[XB_XCNT(j)]); sum += c; cnt += (c > 0u) ? 1u : 0u; mine = (j == x) ? c : mine; }
        if (sum == G) break;
        __builtin_amdgcn_s_sleep(1);
        if ((++sp & 255u) == 0u) { if (xb_ld(&bar[XB_TMO])) break; if (sp > XB_SPIN_CAP) { atomicAdd(&bar[XB_TMO], 1u); break; } }
    }
    nloc = mine > 0u ? mine : 1u; nx = cnt > 0u ? cnt : 1u;
}

__device__ __forceinline__ void xcd_barrier(const XcdBarrier& b, bool leader) {
    asm volatile("s_waitcnt vmcnt(0)" ::: "memory");
    __syncthreads();
    if (leader) {
        unsigned* bar = b.bar;
        __builtin_amdgcn_s_waitcnt(0);
        unsigned nloc = b.st[0], nx = b.st[1];
        if (nloc == 0u) { xcd_barrier_complete(bar, b.x, nloc, nx); b.st[0] = nloc; b.st[1] = nx; }
        const unsigned old = xb_add(&bar[XB_XSUB(b.x)], 1u);
        const unsigned gen = old / nloc;
        if (old + 1u == (gen + 1u) * nloc) {
            __builtin_amdgcn_fence(__ATOMIC_RELEASE, "agent");
            asm volatile("s_waitcnt vmcnt(0)" ::: "memory");
            const unsigned og = xb_add(&bar[XB_TOP], 1u);
            const unsigned tg = og / nx;
            if (og + 1u == (tg + 1u) * nx) xb_add(&bar[XB_TOPGEN], 1u);
            else XB_SPIN(xb_ld(&bar[XB_TOPGEN]) == tg, bar);
            __builtin_amdgcn_fence(__ATOMIC_ACQUIRE, "agent");
            xb_add(&bar[XB_XGEN(b.x)], 1u);
            asm volatile("s_waitcnt vmcnt(0)" ::: "memory");
        } else {
            XB_SPIN(xb_ld(&bar[XB_XGEN(b.x)]) == gen, bar);
            __builtin_amdgcn_fence(__ATOMIC_ACQUIRE, "agent");
            asm volatile("s_waitcnt vmcnt(0)" ::: "memory");
        }
    }
    __syncthreads();
}
#ifndef DUP_SUB
#define DUP_SUB 0
#endif
#ifndef DUP_PHASE
#define DUP_PHASE -1
#endif
#ifndef FAST_B
#define FAST_B 1
#endif
#ifndef GATE_ALIGN
#define GATE_ALIGN true
#endif
#ifndef MERGE_CALLS
#define MERGE_CALLS 3
#endif
#ifndef ORACLE_MASK
#define ORACLE_MASK 7
#endif
#ifndef PHASE_MASK
#define PHASE_MASK 0xfff
#endif
constexpr int NPH_LAYER = 12, NPHASE = 1 + NLAYER * NPH_LAYER;
__global__ void __launch_bounds__(NWAVES * 64, 2) mk_fwd(const Args A) {
    extern __shared__ __attribute__((aligned(16))) unsigned char lds[];
    Frame F;
    F.lds = (LAS unsigned char*)lds;
    F.MISC = (volatile LAS unsigned*)(F.lds + MISC_OFF);
    const int t0_ = threadIdx.x; F.tid = 0; F.wave = __builtin_amdgcn_readfirstlane(t0_ >> 6);
    F.G = gridDim.x; F.bx = blockIdx.x;
    gu32* const ctl = (gu32*)(A.ws + WS_CTL);
    for (int u = t0_; u < (LDS_BYTES - MISC_OFF) / 4; u += NWAVES * 64) ((LAS unsigned*)(F.lds + MISC_OFF))[u] = 0u;
    __syncthreads();
    const int lo = A.lo, hi = A.hi;
    XcdBarrier bar; bar.bar = (unsigned*)(ctl + CW_BAR); bar.x = 0; bar.st = nullptr;
    if (hi - lo > 1) bar = xcd_barrier_post((unsigned*)(ctl + CW_BAR), F.MISC + 8, F.wave == 0 && hw_lane() == 0);
#define IN(k) (lo <= (k) && (k) < hi)
#ifdef TIMING_PROBE
    unsigned long long tp_last = __builtin_amdgcn_s_memrealtime();
    unsigned long long* const tp_acc = (unsigned long long*)(A.ws + WS_CTL + 65536);
#define TP_MARK(slot) do { if (F.bx == 0 && F.wave == 0 && hw_lane() == 0) { const unsigned long long now_ = __builtin_amdgcn_s_memrealtime(); tp_acc[slot] += now_ - tp_last; tp_last = now_; } } while (0)
#else
#define TP_MARK(slot) do { } while (0)
#endif
#ifdef DUP_BARRIER
#define SEAM(k) do { if (IN(k) && IN((k) + 1)) { xcd_barrier(bar, F.wave == 0 && hw_lane() == 0); xcd_barrier(bar, F.wave == 0 && hw_lane() == 0); } } while (0)
#else
#define SEAM(k) do { if (IN(k) && IN((k) + 1)) xcd_barrier(bar, F.wave == 0 && hw_lane() == 0); } while (0)
#endif
    bf16* const XB = (bf16*)(A.ws + WS_XB); bf16* const PROJ = (bf16*)(A.ws + WS_PROJ); bf16* const HMID = (bf16*)(A.ws + WS_HMID); bf16* const GATES = (bf16*)(A.ws + WS_GATES);
    bf16* const OATT = (bf16*)(A.ws + WS_OATT); bf16* const Y = (bf16*)(A.ws + WS_Y); float* const ROWSS = (float*)(A.ws + WS_ROWSS); float* const WIDX = (float*)(A.ws + WS_WIDX);
    unsigned char* const wb = A.ws + WS_W;

    if (IN(0)) { phase_prologue(F, A); phase_convert(F, A, 0, CV_SETA0, CV_SETA1, CV_SETA2, CV_SETA3, F.bx * NWAVES + F.wave, F.G * NWAVES); } SEAM(0); TP_MARK(0);

    for (int L = 0; L < NLAYER; ++L) {
        const int g0 = 1 + L * NPH_LAYER;
        if (hi <= g0 || lo >= g0 + NPH_LAYER) continue;
        { int Gl = gridDim.x; asm volatile("" : "+s"(Gl)); F.G = Gl; }
        if (((PHASE_MASK >> 1) & 1) && IN(g0 + 1)) for (int rep = 0; rep < ((DUP_PHASE == 1) ? 2 : 1); ++rep) {
            pg8::Gemm g{XB, (const bf16*)(wb + O_GU1), M, 2 * FF, D, D}; int G_ = F.G, bxs_ = F.bx; asm volatile("" : "+s"(G_), "+s"(bxs_)); pg8::StaticOrder S; S.init(M, 2 * FF, G_, bxs_);
            epi::EpiSwiGLU E{HMID, FF, ROWSS, 1.0f};
            pg8::gemm_phase<epi::EpiSwiGLU, pg8::StaticOrder, true, true>(F.lds + RING_OFF, g, S, E, F.wave);
            { int bx_ = F.bx; asm volatile("" : "+s"(bx_)); const int rem = A.rem;
              if (bx_ >= rem) phase_convert(F, A, L, CV_SETB0, CV_SETB1, CV_SETB2, CV_SETB3, (bx_ - rem) * NWAVES + F.wave, (F.G - rem) * NWAVES); }
        } SEAM(g0 + 1); TP_MARK(2);
        if (((PHASE_MASK >> 2) & 1) && IN(g0 + 2)) for (int rep = 0; rep < ((DUP_PHASE == 2) ? 2 : 1); ++rep) {
            pg8::Gemm g{HMID, (const bf16*)(wb + O_DN1), M, D, FF, FF}; pg8::StaticOrder S; S.init(M, D, F.G, F.bx);
            epi::EpiResidual E{nullptr, XB, ROWSS, A.ws + WS_X8, rep ? 0.0f : 0.5f};
            pg8::gemm_phase<epi::EpiResidual, pg8::StaticOrder, false, true>(F.lds + RING_OFF, g, S, E, F.wave);
        } SEAM(g0 + 2); TP_MARK(3);
        if (((PHASE_MASK >> 3) & 1) && IN(g0 + 3)) for (int rep = 0; rep < ((DUP_PHASE == 3) ? 2 : 1); ++rep) {
            { pg8::Gemm g{XB, (const bf16*)(wb + O_QKV), M, PP, D, D}; pg8::SubsetOrder<false> S; S.init(M, F.G, F.bx);
              epi::EpiQKV E{PROJ, PP, ROWSS, A.in[8] + (size_t)L * 384, WIDX, 1.0f};
              pg8::gemm_phase<epi::EpiQKV, pg8::SubsetOrder<false>, true, true>(F.lds + RING_OFF, g, S, E, F.wave); }
            { int Kq = D / 2; asm volatile("" : "+s"(Kq));
              pg8::Gemm g{(const bf16*)(A.ws + WS_X8), (const bf16*)(A.ws + WS_QKV8), M, PP, Kq, Kq};
              pg8::SubsetOrder<true> S; S.init(M, F.G, (F.bx + F.G / 2) % F.G);
              epi::EpiQKV E{PROJ, PP, ROWSS, A.in[8] + (size_t)L * 384, WIDX, 1.0f / 32.0f};
              pg8::gemm_phase<epi::EpiQKV, pg8::SubsetOrder<true>, true, true, true>(F.lds + RING_OFF, g, S, E, F.wave); }
        } SEAM(g0 + 3); TP_MARK(4);
        if (((PHASE_MASK >> 4) & 1) && IN(g0 + 4)) for (int rep = 0; rep < ((DUP_PHASE == 4) ? 2 : 1); ++rep) {
            for (int r2 = 0; r2 < ((DUP_SUB == 1) ? 2 : 1); ++r2) phase_attn_B(F, A);
            for (int r2 = 0; r2 < ((DUP_SUB == 2) ? 2 : 1); ++r2) phase_attn_A(F, A);
            for (int r2 = 0; r2 < ((DUP_SUB == 3) ? 2 : 1); ++r2) phase_C1(F, A);
        } SEAM(g0 + 4); TP_MARK(5);
        if (((PHASE_MASK >> 5) & 1) && IN(g0 + 5)) for (int rep = 0; rep < ((DUP_PHASE == 5) ? 2 : 1); ++rep) {
            for (int r2 = 0; r2 < ((DUP_SUB == 4) ? 2 : 1); ++r2) phase_select(F, A);
            for (int r2 = 0; r2 < ((DUP_SUB == 5) ? 2 : 1); ++r2) phase_combine_B(F, A, L);
            for (int r2 = 0; r2 < ((DUP_SUB == 6) ? 2 : 1); ++r2) phase_merge_A(F, A);
        } SEAM(g0 + 5); TP_MARK(6);
        if (((PHASE_MASK >> 6) & 1) && IN(g0 + 6)) for (int rep = 0; rep < ((DUP_PHASE == 6) ? 2 : 1); ++rep) {
            phase_attn_C(F, A);
        } SEAM(g0 + 6); TP_MARK(7);
        if (((PHASE_MASK >> 7) & 1) && IN(g0 + 7)) for (int rep = 0; rep < ((DUP_PHASE == 7) ? 2 : 1); ++rep) {
            int Kq = D / 2; asm volatile("" : "+s"(Kq));
            pg8::Gemm g{(const bf16*)(A.ws + WS_X8), (const bf16*)(wb + O_GATE), M, NGATE, Kq, Kq}; pg8::StaticOrder S; S.init(M, NGATE, F.G, F.bx);
            epi::EpiSigmoid E{GATES, NGATE, ROWSS, 1.0f / 32.0f};
            pg8::gemm_phase<epi::EpiSigmoid, pg8::StaticOrder, GATE_ALIGN, true, true>(F.lds + RING_OFF, g, S, E, F.wave);
            __syncthreads();
            phase_merge_C(F, A);
        } SEAM(g0 + 7); TP_MARK(8);
        if (((PHASE_MASK >> 8) & 1) && IN(g0 + 8)) for (int rep = 0; rep < ((DUP_PHASE == 8) ? 2 : 1); ++rep) {
            pg8::StaticOrder S; S.init(M, D, F.G, F.bx);
            { pg8::Gemm g{OATT, (const bf16*)(wb + O_BA), M, D, 256, 1024}; epi::EpiMerge E{Y, GATES, NGATE, 0};
              pg8::gemm_phase<epi::EpiMerge, pg8::StaticOrder, false, true>(F.lds + RING_OFF, g, S, E, F.wave); }
#if MERGE_CALLS > 1
            { pg8::Gemm g{OATT + 256, (const bf16*)(wb + O_BB), M, D, 512, 1024}; epi::EpiMerge E{Y, GATES + 1024, NGATE, 1};
              pg8::gemm_phase<epi::EpiMerge, pg8::StaticOrder, false, true>(F.lds + RING_OFF, g, S, E, F.wave); }
            { pg8::Gemm g{OATT + 768, (const bf16*)(wb + O_BC), M, D, 256, 1024}; epi::EpiMerge E{Y, GATES + 2048, NGATE, 1};
              pg8::gemm_phase<epi::EpiMerge, pg8::StaticOrder, false, true>(F.lds + RING_OFF, g, S, E, F.wave); }
#endif
        } SEAM(g0 + 8); TP_MARK(9);
        if (((PHASE_MASK >> 9) & 1) && IN(g0 + 9)) for (int rep = 0; rep < ((DUP_PHASE == 9) ? 2 : 1); ++rep) {
            pg8::Gemm g{Y, (const bf16*)(wb + O_OUT), M, D, D, D}; pg8::StaticOrder S; S.init(M, D, F.G, F.bx);
            epi::EpiResidual E{nullptr, XB, ROWSS, A.ws + WS_X8, rep ? 0.0f : 1.0f};
            pg8::gemm_phase<epi::EpiResidual, pg8::StaticOrder, false, true>(F.lds + RING_OFF, g, S, E, F.wave);
        } SEAM(g0 + 9); TP_MARK(10);
        if (((PHASE_MASK >> 10) & 1) && IN(g0 + 10)) for (int rep = 0; rep < ((DUP_PHASE == 10) ? 2 : 1); ++rep) {
            int Kq = D / 2; asm volatile("" : "+s"(Kq));
            pg8::Gemm g{(const bf16*)(A.ws + WS_X8), (const bf16*)(wb + O_GU2), M, 2 * FF, Kq, Kq}; int G_ = F.G, bxs_ = F.bx; asm volatile("" : "+s"(G_), "+s"(bxs_)); pg8::StaticOrder S; S.init(M, 2 * FF, G_, bxs_);
            epi::EpiSwiGLU E{HMID, FF, ROWSS, 1.0f / 32.0f};
            pg8::gemm_phase<epi::EpiSwiGLU, pg8::StaticOrder, true, true, true>(F.lds + RING_OFF, g, S, E, F.wave);
            if (L + 1 < NLAYER) { int bx_ = F.bx; asm volatile("" : "+s"(bx_)); const int rem = A.rem;
              if (bx_ >= rem) phase_convert(F, A, L + 1, CV_SETA0, CV_SETA1, CV_SETA2, CV_SETA3, (bx_ - rem) * NWAVES + F.wave, (F.G - rem) * NWAVES); }
        } SEAM(g0 + 10); TP_MARK(11);
        if (((PHASE_MASK >> 11) & 1) && IN(g0 + 11)) for (int rep = 0; rep < ((DUP_PHASE == 11) ? 2 : 1); ++rep) {
            pg8::Gemm g{HMID, (const bf16*)(wb + O_DN2), M, D, FF, FF}; pg8::StaticOrder S; S.init(M, D, F.G, F.bx);
            epi::EpiResidual E{(L == NLAYER - 1) ? A.out : nullptr, XB, ROWSS, nullptr, rep ? 0.0f : 0.5f};
            pg8::gemm_phase<epi::EpiResidual, pg8::StaticOrder, false, true>(F.lds + RING_OFF, g, S, E, F.wave);
        } SEAM(g0 + 11); TP_MARK(12);
    }
#ifdef TIMING_PROBE
    {
        xcd_barrier(bar);
        unsigned long long tot = 0; for (int s_ = 0; s_ < 12; ++s_) if ((TIMING_PROBE >> s_) & 1) tot += __hip_atomic_load(tp_acc + s_, __ATOMIC_RELAXED, __HIP_MEMORY_SCOPE_AGENT);
        const float K = 1000.0f * (float)tot * 0.01f;
        for (size_t i = (size_t)F.bx * 512 + F.wave * 64 + hw_lane(); i < (size_t)M * D; i += (size_t)F.G * 512) A.out[i] = K;
    }
#endif
#undef IN
#undef SEAM
}

#ifdef MK_DEBUG_KERNELS
__global__ void __launch_bounds__(256) k_oracle_A(unsigned char* ws) { oracle_A(ws, blockIdx.x * 4 + (threadIdx.x >> 6), gridDim.x * 4, threadIdx.x & 63); }
__global__ void __launch_bounds__(256) k_oracle_B(unsigned char* ws, const float* lv, const float* dn, int L) { oracle_B(ws, blockIdx.x * 4 + (threadIdx.x >> 6), gridDim.x * 4, lv + (size_t)L * 256, dn + (size_t)L * 128, L, threadIdx.x & 63); }
__global__ void __launch_bounds__(128, 1) k_oracle_C(unsigned char* ws) { extern __shared__ __attribute__((aligned(16))) unsigned char olds[]; oracle_C(ws, blockIdx.x * 2 + (threadIdx.x >> 6), gridDim.x * 2, (LAS unsigned char*)olds + (threadIdx.x >> 6) * 18944, threadIdx.x & 63); }
__global__ void __launch_bounds__(256) k_fill(unsigned char* ws) { const bf16* P = (const bf16*)(ws + WS_PROJ); bf16* O = (bf16*)(ws + WS_OATT);
    for (size_t i = (size_t)blockIdx.x * 256 + threadIdx.x; i < (size_t)M * 1024; i += (size_t)gridDim.x * 256) { const size_t row = i >> 10, c = i & 1023; O[row * 1024 + c] = P[row * PP + c]; } }
#endif
extern "C" void kernel_launch(void* const* d_in, const int* in_sizes, int n_in, void* d_out, int out_size, void* d_ws, size_t ws_size, hipStream_t stream) {
    static int grid = 0;
    if (grid == 0) {
        if (n_in != 19 || in_sizes[0] != M * D || out_size != M * D || ws_size < WS_END) { fprintf(stderr, "kernel_launch: unexpected shapes / workspace (n_in %d, ws %zu)\n", n_in, ws_size); grid = -1; return; }
        int dev = 0, cus = 0, per_cu = 0;
        if (hipGetDevice(&dev) != hipSuccess || hipDeviceGetAttribute(&cus, hipDeviceAttributeMultiprocessorCount, dev) != hipSuccess) { grid = -1; return; }
        if (hipFuncSetAttribute((const void*)mk_fwd, hipFuncAttributeMaxDynamicSharedMemorySize, LDS_BYTES) != hipSuccess) { fprintf(stderr, "kernel_launch: hipFuncSetAttribute failed\n"); grid = -1; return; }
        if (hipOccupancyMaxActiveBlocksPerMultiprocessor(&per_cu, (const void*)mk_fwd, NWAVES * 64, LDS_BYTES) != hipSuccess || per_cu < 1) { fprintf(stderr, "kernel_launch: occupancy query says %d\n", per_cu); }
        (void)hipGetLastError();
        grid = cus;
    }
    if (grid < 0) return;
    (void)hipMemsetAsync((char*)d_ws + WS_CTL, 0, CTL_ZERO_BYTES, stream);
    Args a{};
    for (int i = 0; i < 19; ++i) a.in[i] = (const float*)d_in[i];
    a.out = (float*)d_out; a.ws = (unsigned char*)d_ws; a.rem = ((M / 256) * (2 * FF / 256)) % grid;
#if defined(MK_DEBUG_KERNELS) && defined(CHECK_MODE)
    for (int g = 0; g <= CHECK_UPTO; ++g) { a.lo = g; a.hi = g + 1; hipLaunchKernelGGL(mk_fwd, dim3(grid), dim3(NWAVES * 64), LDS_BYTES, stream, a);
        if (g >= 1 && (g - 1) % NPH_LAYER == 4) hipLaunchKernelGGL(k_fill, dim3(2048), dim3(256), 0, stream, a.ws); }
    a.lo = 0; a.hi = 0;
    hipLaunchKernelGGL(k_check, dim3(512), dim3(256), 0, stream, a, (int)CHECK_MODE, 0);
    hipLaunchKernelGGL(k_report, dim3(2048), dim3(256), 0, stream, a.ws, a.out);
#elif MK_N_LAUNCHES == 1 || !defined(MK_DEBUG_KERNELS)
    a.lo = 0; a.hi = NPHASE;
    hipLaunchKernelGGL(mk_fwd, dim3(grid), dim3(NWAVES * 64), LDS_BYTES, stream, a);
#else
    for (int g = 0; g < NPHASE; ++g) { a.lo = g; a.hi = g + 1; hipLaunchKernelGGL(mk_fwd, dim3(grid), dim3(NWAVES * 64), LDS_BYTES, stream, a);
        if (ORACLE_MASK && ((PHASE_MASK >> 4) & 1) && g >= 1 && (g - 1) % NPH_LAYER == 4) { const int L = (g - 1) / NPH_LAYER;
            if (ORACLE_MASK & 8) hipLaunchKernelGGL(k_fill, dim3(2048), dim3(256), 0, stream, a.ws);
            if (ORACLE_MASK & 1) hipLaunchKernelGGL(k_oracle_A, dim3(4096), dim3(256), 0, stream, a.ws);
            if ((ORACLE_MASK & 2) && !FAST_B) hipLaunchKernelGGL(k_oracle_B, dim3(4096), dim3(256), 0, stream, a.ws, a.in[9], a.in[10], L);
            if (ORACLE_MASK & 4) hipLaunchKernelGGL(k_oracle_C, dim3(4096), dim3(128), 2 * 18944, stream, a.ws); } }
#endif
}
```
